# Optimizing an MI355X kernel written in HIP

```python
import math, functools
import jax, jax.numpy as jnp
from jax import lax
import numpy as np

D_MODEL = 1024
BATCH = 8
SEQ = 2048
DEPTH = 1
DEC_BATCH = 32
DEC_SEQ = 4
PAST_LEN = 16384
PAGE_SIZE = 128

GLA_HEADS = 4
GLA_DV = D_MODEL // (2 * GLA_HEADS)
GLA_DK = GLA_DV // 2
GLA_RANK = 16
GLA_TAU = 16.0
GLA_CHUNK = 64
GLA_WIDTH = GLA_HEADS * GLA_DV
NSA_HEADS = 8
NSA_KV_HEADS = 2
NSA_GROUP = NSA_HEADS // NSA_KV_HEADS
NSA_HEAD_DIM = D_MODEL // (2 * NSA_HEADS)
NSA_WIDTH = NSA_HEADS * NSA_HEAD_DIM
CMP_BLK = 32
CMP_STRIDE = 16
CMP_HIDDEN = 2 * NSA_HEAD_DIM
SLC_BLK = 64
SLC_TOP_N = 16
WINDOW = 512
NSA_QBLK = 64
FORCE_BONUS = 1e4
NEG = -1e30
MIX_WIDTH = GLA_WIDTH + NSA_WIDTH
D_FF = -(-8 * D_MODEL // (3 * 256)) * 256
ALPHA = (2 * DEPTH) ** 0.25
BETA = (8 * DEPTH) ** -0.25
KV_W = 2 * NSA_KV_HEADS * NSA_HEAD_DIM
IN_SIZES = (GLA_HEADS * GLA_DK, GLA_HEADS * GLA_DK, GLA_WIDTH, GLA_RANK, GLA_WIDTH,
            NSA_WIDTH, KV_W, KV_W, KV_W, 3 * NSA_HEADS)
IN_WIDTH = sum(IN_SIZES)
IN_SPLITS = tuple(int(v) for v in np.cumsum(IN_SIZES)[:-1])

kernel_name = 'hybrid_gla_nsa_deepnorm_adaln_step'


def layer_norm(x, g, b, eps=1e-5):
    xf = x.astype(jnp.float32)
    mu = jnp.mean(xf, axis=-1, keepdims=True)
    xc = xf - mu
    var = jnp.mean(xc * xc, axis=-1, keepdims=True)
    return (xc * lax.rsqrt(var + eps) * g.astype(jnp.float32) + b.astype(jnp.float32)).astype(x.dtype)


def masked_softmax(s, mask):
    s = jnp.where(mask, s.astype(jnp.float32), NEG)
    e = jnp.where(mask, jnp.exp(s - jnp.max(s, axis=-1, keepdims=True)), 0.0)
    return e / jnp.maximum(jnp.sum(e, axis=-1, keepdims=True), 1e-30)


def gla_chunked(q, k, v, log_a, s0):
    f32 = jnp.float32
    B, L, H, _ = q.shape
    c = min(GLA_CHUNK, L)
    pad = (-L) % c

    def prep(t):
        t = jnp.pad(t.astype(f32), ((0, 0), (0, pad), (0, 0), (0, 0)))
        return t.reshape(B, -1, c, H, t.shape[-1]).transpose(1, 0, 3, 2, 4)

    qs, ks, vs, gs = prep(q), prep(k), prep(v), prep(log_a)
    causal = jnp.tril(jnp.ones((c, c), bool))[:, :, None]

    def step(S, inp):
        qc, kc, vc, gc = inp
        b = jnp.cumsum(gc, axis=2)
        o_inter = jnp.einsum('bhcd,bhde->bhce', qc * jnp.exp(b), S)
        diff = jnp.where(causal, b[:, :, :, None, :] - b[:, :, None, :, :], -jnp.inf)
        att = jnp.einsum('bhid,bhjd,bhijd->bhij', qc, kc, jnp.exp(diff))
        o = o_inter + jnp.einsum('bhij,bhje->bhie', att, vc)
        b_last = b[:, :, -1:, :]
        S = jnp.exp(b_last[:, :, 0, :])[..., None] * S + jnp.einsum('bhcd,bhce->bhde', kc * jnp.exp(b_last - b), vc)
        return S, o

    S, o = lax.scan(step, s0.astype(f32), (qs, ks, vs, gs))
    o = o.transpose(1, 0, 3, 2, 4).reshape(B, -1, H, o.shape[-1])[:, :L]
    return o, S


def compress_blocks(kv, pe, w1, b1, w2):
    B, T = kv.shape[:2]
    n_seg = T // CMP_STRIDE
    r = CMP_BLK // CMP_STRIDE
    nc = n_seg - r + 1
    seg = kv[:, :n_seg * CMP_STRIDE].reshape(B, n_seg, CMP_STRIDE, 2, NSA_KV_HEADS, NSA_HEAD_DIM)
    w1r = w1.reshape(2, r, CMP_STRIDE, NSA_HEAD_DIM, CMP_HIDDEN)
    proj = jnp.einsum('bnscgd,cmsdh->mbncgh', seg, w1r)
    pe_bias = jnp.einsum('pcd,cpdh->ch', pe, w1.reshape(2, CMP_BLK, NSA_HEAD_DIM, CMP_HIDDEN))
    h = sum(proj[m][:, m:m + nc] for m in range(r)) + (pe_bias + b1)[None, None, :, None, :]
    out = jnp.einsum('bncgh,chd->bncgd', jax.nn.gelu(h), w2)
    t_end = jnp.arange(nc, dtype=jnp.int32) * CMP_STRIDE + CMP_BLK - 1
    return out[:, :, 0], out[:, :, 1], t_end


def to_blocks(k):
    B, T = k.shape[:2]
    k = jnp.pad(k, ((0, 0), (0, (-T) % SLC_BLK), (0, 0), (0, 0)))
    return k.reshape(B, -1, SLC_BLK, NSA_KV_HEADS, NSA_HEAD_DIM).transpose(0, 3, 1, 2, 4)


def overlap_matrix(nc, nb):
    i = jnp.arange(nc)[:, None] * CMP_STRIDE
    j = jnp.arange(nb)[None, :] * SLC_BLK
    return ((i < j + SLC_BLK) & (i + CMP_BLK > j)).astype(jnp.float32)


def nsa_core(qg, tq, kc, vc, tc_end, kb, vb, kw, vw, tw, gates):
    f32 = jnp.float32
    B, Q, G, R, D = qg.shape
    nb = kb.shape[2]
    s_c = jnp.einsum('bqgrd,bngd->bqgrn', qg, kc.astype(f32))
    p_c = masked_softmax(s_c, (tc_end[None, :] <= tq[:, None])[None, :, None, None, :])
    o_c = jnp.einsum('bqgrn,bngd->bqgrd', p_c, vc.astype(f32))
    imp = jnp.einsum('bqgn,nj->bqgj', p_c.sum(axis=3), overlap_matrix(kc.shape[1], nb))
    j = jnp.arange(nb)[None, :]
    cur = (tq // SLC_BLK)[:, None]
    valid = j * SLC_BLK <= tq[:, None]
    forced = (j == 0) | (j == cur) | (j == cur - 1)
    score = jnp.where(valid[None, :, None, :], imp + FORCE_BONUS * forced[None, :, None, :].astype(f32), -jnp.inf)
    _, idx = lax.top_k(score, min(SLC_TOP_N, nb))
    take = jax.vmap(jax.vmap(lambda blocks, ids: blocks[ids]))
    idx_t = idx.transpose(0, 2, 1, 3)
    ks = take(kb, idx_t)
    vs = take(vb, idx_t)
    s_s = jnp.einsum('bqgrd,bgqnkd->bqgrnk', qg, ks.astype(f32))
    pos = idx[..., None] * SLC_BLK + jnp.arange(SLC_BLK)
    m_s = (pos <= tq[None, :, None, None, None]).reshape(B, Q, G, 1, -1)
    p_s = masked_softmax(s_s.reshape(B, Q, G, R, -1), m_s).reshape(s_s.shape)
    o_s = jnp.einsum('bqgrnk,bgqnkd->bqgrd', p_s, vs.astype(f32))
    s_w = jnp.einsum('bqgrd,bwgd->bqgrw', qg, kw.astype(f32))
    m_w = (tw[None, :] <= tq[:, None]) & (tw[None, :] > tq[:, None] - WINDOW) & (tw[None, :] >= 0)
    p_w = masked_softmax(s_w, m_w[None, :, None, None, :])
    o_w = jnp.einsum('bqgrw,bwgd->bqgrd', p_w, vw.astype(f32))
    g = gates.reshape(B, Q, G, R, 3)
    o = g[..., 0:1] * o_c + g[..., 1:2] * o_s + g[..., 2:3] * o_w
    return o.reshape(B, Q, G * R * D)


def nsa_prompt(q, kv_c, kv_s, kv_w, gates, pe, w1, b1, w2):
    B, L = q.shape[:2]
    qg = q.reshape(B, L, NSA_KV_HEADS, NSA_GROUP, NSA_HEAD_DIM).astype(jnp.float32) * NSA_HEAD_DIM ** -0.5
    kc, vc, tc_end = compress_blocks(kv_c, pe, w1, b1, w2)
    kb, vb = to_blocks(kv_s[:, :, 0]), to_blocks(kv_s[:, :, 1])
    kw_pad = jnp.pad(kv_w, ((0, 0), (WINDOW, 0), (0, 0), (0, 0), (0, 0)))
    qb = min(NSA_QBLK, L)

    def block(i):
        s0 = i * qb
        tq = s0 + jnp.arange(qb, dtype=jnp.int32)
        tw = s0 - WINDOW + jnp.arange(WINDOW + qb, dtype=jnp.int32)
        qi = lax.dynamic_slice_in_dim(qg, s0, qb, axis=1)
        gi = lax.dynamic_slice_in_dim(gates, s0, qb, axis=1)
        wi = lax.dynamic_slice_in_dim(kw_pad, s0, WINDOW + qb, axis=1)
        return nsa_core(qi, tq, kc, vc, tc_end, kb, vb, wi[:, :, 0], wi[:, :, 1], tw, gi)

    o = lax.map(block, jnp.arange(L // qb, dtype=jnp.int32))
    o = o.transpose(1, 0, 2, 3).reshape(B, L, NSA_WIDTH)
    return o, kv_w[:, L - min(WINDOW, L):]


def nsa_sample(cmp_past, slc_past, win_past, q, kv_c, kv_s, kv_w, gates, pe, w1, b1, w2):
    B, S = q.shape[:2]
    past_len = cmp_past.shape[1]
    qg = q.reshape(B, S, NSA_KV_HEADS, NSA_GROUP, NSA_HEAD_DIM).astype(jnp.float32) * NSA_HEAD_DIM ** -0.5
    kc, vc, tc_end = compress_blocks(jnp.concatenate([cmp_past, kv_c], axis=1), pe, w1, b1, w2)
    slc_all = jnp.concatenate([slc_past, kv_s], axis=1)
    kb, vb = to_blocks(slc_all[:, :, 0]), to_blocks(slc_all[:, :, 1])
    win_all = jnp.concatenate([win_past, kv_w], axis=1)
    wb = win_past.shape[1]
    tw = past_len - wb + jnp.arange(wb + S, dtype=jnp.int32)
    tq = past_len + jnp.arange(S, dtype=jnp.int32)
    o = nsa_core(qg, tq, kc, vc, tc_end, kb, vb, win_all[:, :, 0], win_all[:, :, 1], tw, gates)
    return o, win_all[:, S:]


def decoder_layer(x, c, s0, nsa_fn, w_ada, b_ada, w_in, gla_w_a2, gla_b_a, gla_norm_g, cmp_pe, cmp_w1, cmp_b1,
                  cmp_w2, w_o, ln1_g, ln1_b, w_ffn_in, w_ffn_out, ln2_g, ln2_b):
    f32 = jnp.float32
    B, L, _ = x.shape
    mod = jnp.einsum('bd,dm->bm', jax.nn.silu(c), w_ada) + b_ada
    sh1, sc1, ga1, sh2, sc2, ga2 = [m[:, None, :] for m in jnp.split(mod, 6, axis=-1)]
    u = x * (1 + sc1) + sh1
    z = jnp.einsum('bld,dp->blp', u, w_in)
    q_g, k_g, v_g, a_g, r_g, q_n, kv_c, kv_s, kv_w, g_n = jnp.split(z, IN_SPLITS, axis=-1)
    log_a = jax.nn.log_sigmoid((jnp.einsum('blr,rk->blk', a_g, gla_w_a2) + gla_b_a).astype(f32)) / GLA_TAU
    hs = (B, L, GLA_HEADS, -1)
    o_g, s_new = gla_chunked(q_g.reshape(hs) * GLA_DK ** -0.5, k_g.reshape(hs), v_g.reshape(hs), log_a.reshape(hs), s0)
    o_g = o_g * lax.rsqrt(jnp.mean(o_g * o_g, axis=-1, keepdims=True) + 1e-6) * gla_norm_g.astype(f32)
    o_g = o_g.reshape(B, L, GLA_WIDTH) * jax.nn.silu(r_g.astype(f32))
    kvs = (B, L, 2, NSA_KV_HEADS, NSA_HEAD_DIM)
    kv_c, kv_s, kv_w = kv_c.reshape(kvs), kv_s.reshape(kvs), kv_w.reshape(kvs)
    gates = jax.nn.sigmoid(g_n.astype(f32))
    o_n, win_new = nsa_fn(q_n.reshape(B, L, NSA_HEADS, NSA_HEAD_DIM), kv_c, kv_s, kv_w, gates,
                          cmp_pe, cmp_w1, cmp_b1, cmp_w2)
    mix = jnp.einsum('blm,md->bld', jnp.concatenate([o_g, o_n], axis=-1).astype(x.dtype), w_o)
    x = layer_norm(ALPHA * x + ga1 * mix, ln1_g, ln1_b)
    u2 = x * (1 + sc2) + sh2
    gate, up = jnp.split(jnp.einsum('bld,df->blf', u2, w_ffn_in), 2, axis=-1)
    ffn = jnp.einsum('blf,fd->bld', jax.nn.silu(gate) * up, w_ffn_out)
    x = layer_norm(ALPHA * x + ga2 * ffn, ln2_g, ln2_b)
    return x, s_new, kv_c, kv_s, win_new


def setup_inputs(seed: int = 0) -> dict:
    key = jax.random.key(seed)
    ks = jax.random.split(key, 32)
    f32 = jnp.float32

    def nrm(k, shape, s):
        return jax.random.normal(k, shape, f32) * s

    n_pages = PAST_LEN // PAGE_SIZE
    n_used = DEC_BATCH * n_pages
    n_pool = n_used + n_used // 4
    win_buf = min(WINDOW, PAST_LEN)
    kvt = (2, NSA_KV_HEADS, NSA_HEAD_DIM)
    perm = jax.random.permutation(ks[0], n_pool)
    page_table = perm[:n_used].reshape(DEC_BATCH, n_pages).astype(jnp.int32)
    return {
        'x_prompt': nrm(ks[1], (BATCH, SEQ, D_MODEL), 1.0),
        'x_sample': nrm(ks[2], (DEC_BATCH, DEC_SEQ, D_MODEL), 1.0),
        'state_gla': nrm(ks[3], (DEPTH, DEC_BATCH, GLA_HEADS, GLA_DK, GLA_DV), 1.0),
        'cache_cmp_kv': nrm(ks[4], (DEPTH, n_pool, PAGE_SIZE) + kvt, 1.0),
        'cache_slc_kv': nrm(ks[5], (DEPTH, n_pool, PAGE_SIZE) + kvt, 1.0),
        'cache_win_kv': nrm(ks[6], (DEPTH, DEC_BATCH, win_buf) + kvt, 1.0),
        'page_table': page_table,
        'c_prompt': nrm(ks[7], (BATCH, D_MODEL), 1.0),
        'c_sample': nrm(ks[8], (DEC_BATCH, D_MODEL), 1.0),
        'ln_in_g': 1.0 + nrm(ks[9], (D_MODEL,), 0.02),
        'ln_in_b': nrm(ks[10], (D_MODEL,), 0.02),
        'w_ada': nrm(ks[11], (DEPTH, D_MODEL, 6 * D_MODEL), D_MODEL ** -0.5),
        'b_ada': nrm(ks[12], (DEPTH, 6 * D_MODEL), 0.01),
        'w_in': nrm(ks[13], (DEPTH, D_MODEL, IN_WIDTH), D_MODEL ** -0.5),
        'gla_w_a2': nrm(ks[14], (DEPTH, GLA_RANK, GLA_HEADS * GLA_DK), GLA_RANK ** -0.5),
        'gla_b_a': nrm(ks[15], (DEPTH, GLA_HEADS * GLA_DK), 0.1),
        'gla_norm_g': 1.0 + nrm(ks[16], (DEPTH, GLA_DV), 0.02),
        'cmp_pe': nrm(ks[17], (DEPTH, CMP_BLK, 2, NSA_HEAD_DIM), 0.1),
        'cmp_w1': nrm(ks[18], (DEPTH, 2, CMP_BLK * NSA_HEAD_DIM, CMP_HIDDEN), (CMP_BLK * NSA_HEAD_DIM) ** -0.5),
        'cmp_b1': nrm(ks[19], (DEPTH, 2, CMP_HIDDEN), 0.01),
        'cmp_w2': nrm(ks[20], (DEPTH, 2, CMP_HIDDEN, NSA_HEAD_DIM), CMP_HIDDEN ** -0.5),
        'w_o': nrm(ks[21], (DEPTH, MIX_WIDTH, D_MODEL), BETA * MIX_WIDTH ** -0.5),
        'ln1_g': 1.0 + nrm(ks[22], (DEPTH, D_MODEL), 0.02),
        'ln1_b': nrm(ks[23], (DEPTH, D_MODEL), 0.02),
        'w_ffn_in': nrm(ks[24], (DEPTH, D_MODEL, 2 * D_FF), D_MODEL ** -0.5),
        'w_ffn_out': nrm(ks[25], (DEPTH, D_FF, D_MODEL), BETA * D_FF ** -0.5),
        'ln2_g': 1.0 + nrm(ks[26], (DEPTH, D_MODEL), 0.02),
        'ln2_b': nrm(ks[27], (DEPTH, D_MODEL), 0.02),
    }


def reference(x_prompt, x_sample, state_gla, cache_cmp_kv, cache_slc_kv, cache_win_kv, page_table, c_prompt,
              c_sample, ln_in_g, ln_in_b, w_ada, b_ada, w_in, gla_w_a2, gla_b_a, gla_norm_g, cmp_pe, cmp_w1,
              cmp_b1, cmp_w2, w_o, ln1_g, ln1_b, w_ffn_in, w_ffn_out, ln2_g, ln2_b):
    xp = layer_norm(x_prompt, ln_in_g, ln_in_b)
    xs = layer_norm(x_sample, ln_in_g, ln_in_b)
    db, n_pages = page_table.shape
    kvt = (2, NSA_KV_HEADS, NSA_HEAD_DIM)
    g_p, g_s, c_p, c_s, s_p, s_s, w_p, w_s = [], [], [], [], [], [], [], []
    for l in range(DEPTH):
        lw = (w_ada[l], b_ada[l], w_in[l], gla_w_a2[l], gla_b_a[l], gla_norm_g[l], cmp_pe[l], cmp_w1[l],
              cmp_b1[l], cmp_w2[l], w_o[l], ln1_g[l], ln1_b[l], w_ffn_in[l], w_ffn_out[l], ln2_g[l], ln2_b[l])
        s0 = jnp.zeros((xp.shape[0], GLA_HEADS, GLA_DK, GLA_DV), jnp.float32)
        xp, gp, cp, sp, wp = decoder_layer(xp, c_prompt, s0, nsa_prompt, *lw)
        cmp_past = cache_cmp_kv[l][page_table].reshape((db, n_pages * PAGE_SIZE) + kvt)
        slc_past = cache_slc_kv[l][page_table].reshape((db, n_pages * PAGE_SIZE) + kvt)
        fn = functools.partial(nsa_sample, cmp_past, slc_past, cache_win_kv[l])
        xs, gs, cs, ss, ws = decoder_layer(xs, c_sample, state_gla[l], fn, *lw)
        g_p.append(gp); g_s.append(gs); c_p.append(cp); c_s.append(cs)
        s_p.append(sp); s_s.append(ss); w_p.append(wp); w_s.append(ws)
    return (xp, xs, jnp.stack(g_p), jnp.stack(g_s), jnp.stack(c_p), jnp.stack(c_s), jnp.stack(s_p),
            jnp.stack(s_s), jnp.stack(w_p), jnp.stack(w_s))
```

```cpp
#include <hip/hip_runtime.h>
#include <cstdio>
#include <cstdint>
#include <cmath>
namespace nv {
constexpr int D = 1024, NB_P = 8, SEQ = 2048, NB_S = 32, SS = 4, PAST = 16384, PAGE = 128, NPAGES = 128;
constexpr int RP = NB_P * SEQ, RS = NB_S * SS, R = RP + RS;
constexpr int ZW = 2856;
constexpr int C_QG = 0, C_KG = 256, C_VG = 512, C_AG = 1024, C_RG = 1040, C_QN = 1552, C_KVC = 2064, C_KVS = 2320, C_KVW = 2576, C_GN = 2832;
constexpr int DFF = 2816;
constexpr float ALPHA = 1.189207115002721f;
constexpr long O_YP = 0, O_YS = 16777216, O_GSP = 16908288, O_GSS = 17170432, O_CKP = 18219008, O_CKS = 22413312, O_SKP = 22446080, O_SKS = 26640384,
               O_WKP = 26673152, O_WKS = 27721728, O_END = 31916032;

__device__ __forceinline__ float sigmoidf_(float x) { return 1.f / (1.f + expf(-x)); }
__device__ __forceinline__ float siluf_(float x) { return x / (1.f + expf(-x)); }
__device__ __forceinline__ float logsigmoidf_(float x) { return fminf(x, 0.f) - log1pf(expf(-fabsf(x))); }
__device__ __forceinline__ float gelu_tanh_(float x) { const float u = 0.7978845608028654f * (x + 0.044715f * x * x * x); return 0.5f * x * (1.f + tanhf(u)); }
__device__ __forceinline__ int mod_row(int r) { return r < RP ? r / SEQ : NB_P + (r - RP) / SS; }

__global__ void k_mod(const float* cp, const float* cs, const float* w_ada, const float* b_ada, float* mod) {
    const int col = blockIdx.x * 256 + threadIdx.x, row = blockIdx.y;
    const float* c = row < NB_P ? cp + row * D : cs + (row - NB_P) * D;
    float acc = 0.f;
    for (int k = 0; k < D; ++k) acc += siluf_(c[k]) * w_ada[(size_t)k * 6144 + col];
    mod[row * 6144 + col] = acc + b_ada[col];
}
__device__ __forceinline__ float block_sum256(float v, float* red) {
    const int tid = threadIdx.x;
    red[tid] = v; __syncthreads();
    for (int s = 128; s > 0; s >>= 1) { if (tid < s) red[tid] += red[tid + s]; __syncthreads(); }
    const float r = red[0]; __syncthreads(); return r;
}
__global__ void k_ln(const float* in_p, const float* in_s, const float* g, const float* b, const float* mod, int sh_off, int sc_off, float* out1, float* out2) {
    __shared__ float red[256];
    const int r = blockIdx.x, tid = threadIdx.x;
    const float* x = (in_s && r >= RP) ? in_s + (size_t)(r - RP) * D : in_p + (size_t)r * D;
    float v[4]; float s = 0.f;
#pragma unroll
    for (int j = 0; j < 4; ++j) { v[j] = x[tid + 256 * j]; s += v[j]; }
    const float mean = block_sum256(s, red) * (1.f / D);
    float q = 0.f;
#pragma unroll
    for (int j = 0; j < 4; ++j) { v[j] -= mean; q += v[j] * v[j]; }
    const float rstd = rsqrtf(block_sum256(q, red) * (1.f / D) + 1e-5f);
    const float* m = mod + mod_row(r) * 6144;
#pragma unroll
    for (int j = 0; j < 4; ++j) { const int c = tid + 256 * j; const float y = v[j] * rstd * g[c] + b[c];
        if (out1) out1[(size_t)r * D + c] = y;
        if (out2) out2[(size_t)r * D + c] = y * (1.f + m[sc_off + c]) + m[sh_off + c]; }
}
__global__ void __launch_bounds__(256) k_sgemm(const float* A, int lda, const float* B, int ldb, float* C, int ldc, int M, int N, int K) {
    __shared__ float As[16][65], Bs[16][65];
    const int tid = threadIdx.x, tx = tid & 15, ty = tid >> 4, m0 = blockIdx.y * 64, n0 = blockIdx.x * 64;
    float acc[4][4] = {};
    for (int k0 = 0; k0 < K; k0 += 16) {
        for (int i = tid; i < 64 * 16; i += 256) { const int m = i >> 4, k = i & 15; As[k][m] = A[(size_t)(m0 + m) * lda + k0 + k]; }
        for (int i = tid; i < 64 * 16; i += 256) { const int k = i >> 6, n = i & 63; Bs[k][n] = (n0 + n < N) ? B[(size_t)(k0 + k) * ldb + n0 + n] : 0.f; }
        __syncthreads();
#pragma unroll
        for (int k = 0; k < 16; ++k) { float a[4], bb[4];
#pragma unroll
            for (int i = 0; i < 4; ++i) { a[i] = As[k][ty * 4 + i]; bb[i] = Bs[k][tx * 4 + i]; }
#pragma unroll
            for (int i = 0; i < 4; ++i)
#pragma unroll
                for (int j = 0; j < 4; ++j) acc[i][j] += a[i] * bb[j]; }
        __syncthreads();
    }
#pragma unroll
    for (int i = 0; i < 4; ++i) {
#pragma unroll
    for (int j = 0; j < 4; ++j) { const int n = n0 + tx * 4 + j; if (n < N) C[(size_t)(m0 + ty * 4 + i) * ldc + n] = acc[i][j]; } }
}
__global__ void k_kvout(const float* Z, const float* cache_win, float* out) {
    const long i = (long)blockIdx.x * 256 + threadIdx.x;
    if (i < (long)RP * 256) { const int r = (int)(i >> 8), c = (int)(i & 255);
        out[O_CKP + i] = Z[(size_t)r * ZW + C_KVC + c]; out[O_SKP + i] = Z[(size_t)r * ZW + C_KVS + c];
        const int b = r / SEQ, t = r % SEQ; if (t >= SEQ - 512) out[O_WKP + ((long)b * 512 + (t - (SEQ - 512))) * 256 + c] = Z[(size_t)r * ZW + C_KVW + c]; }
    if (i < (long)RS * 256) { const int r = (int)(i >> 8), c = (int)(i & 255);
        out[O_CKS + i] = Z[(size_t)(RP + r) * ZW + C_KVC + c]; out[O_SKS + i] = Z[(size_t)(RP + r) * ZW + C_KVS + c]; }
    if (i < (long)NB_S * 512 * 256) { const int c = (int)(i & 255), j = (int)((i >> 8) & 511), b = (int)(i >> 17); const int src = j + SS;
        out[O_WKS + i] = src < 512 ? cache_win[((size_t)b * 512 + src) * 256 + c] : Z[(size_t)(RP + b * SS + (src - 512)) * ZW + C_KVW + c]; }
}
__global__ void k_loga(const float* Z, const float* w_a2, const float* b_a, float* loga) {
    const int r = blockIdx.x, c = threadIdx.x; float acc = b_a[c];
    for (int k = 0; k < 16; ++k) acc += Z[(size_t)r * ZW + C_AG + k] * w_a2[k * 256 + c];
    loga[(size_t)r * 256 + c] = logsigmoidf_(acc) * (1.f / 16.f);
}
__global__ void __launch_bounds__(128) k_gla(const float* Z, const float* loga, const float* init, const float* gamma, int row0, int L, float* att, float* state_out) {
    __shared__ float sa[64], sk[64], sq[64], red[128];
    const int seq = blockIdx.x >> 2, h = blockIdx.x & 3, dv = threadIdx.x;
    float S[64];
#pragma unroll
    for (int dk = 0; dk < 64; ++dk) S[dk] = init ? init[(((size_t)seq * 4 + h) * 64 + dk) * 128 + dv] : 0.f;
    for (int t = 0; t < L; ++t) { const size_t r = (size_t)row0 + (size_t)seq * L + t;
        if (dv < 64) { sa[dv] = expf(loga[r * 256 + h * 64 + dv]); sk[dv] = Z[r * ZW + C_KG + h * 64 + dv]; sq[dv] = Z[r * ZW + C_QG + h * 64 + dv] * 0.125f; }
        __syncthreads();
        const float v = Z[r * ZW + C_VG + h * 128 + dv]; float o = 0.f;
#pragma unroll
        for (int dk = 0; dk < 64; ++dk) { S[dk] = sa[dk] * S[dk] + sk[dk] * v; o += sq[dk] * S[dk]; }
        red[dv] = o * o; __syncthreads();
        for (int s = 64; s > 0; s >>= 1) { if (dv < s) red[dv] += red[dv + s]; __syncthreads(); }
        const float ms = red[0] * (1.f / 128.f); __syncthreads();
        const float rg = Z[r * ZW + C_RG + h * 128 + dv];
        att[r * D + h * 128 + dv] = o * rsqrtf(ms + 1e-6f) * gamma[dv] * siluf_(rg);
    }
#pragma unroll
    for (int dk = 0; dk < 64; ++dk) state_out[(((size_t)seq * 4 + h) * 64 + dk) * 128 + dv] = S[dk];
}
__global__ void __launch_bounds__(256) k_compress(const float* Z, const float* cache, const int* table, int sample, int nc, const float* pe, const float* w1, const float* b1, const float* w2, float* kcv) {
    __shared__ float xs[2][2048]; __shared__ float hs[2][128];
    const int g = blockIdx.x & 1, n = (blockIdx.x >> 1) % nc, b = (blockIdx.x >> 1) / nc, tid = threadIdx.x;
    for (int i = tid; i < 4096; i += 256) { const int c = i >> 11, p = (i >> 6) & 31, d = i & 63; const int t = 16 * n + p;
        float v;
        if (sample) v = cache[((size_t)table[b * NPAGES + (t >> 7)] * PAGE + (t & 127)) * 256 + c * 128 + g * 64 + d];
        else v = Z[((size_t)b * SEQ + t) * ZW + C_KVC + c * 128 + g * 64 + d];
        xs[c][p * 64 + d] = v + pe[(p * 2 + c) * 64 + d]; }
    __syncthreads();
    { const int c = tid >> 7, hid = tid & 127; float acc = b1[c * 128 + hid]; const float* w = w1 + (size_t)c * 2048 * 128 + hid;
      for (int k = 0; k < 2048; ++k) acc += xs[c][k] * w[(size_t)k * 128];
      hs[c][hid] = gelu_tanh_(acc); }
    __syncthreads();
    if (tid < 128) { const int c = tid >> 6, d = tid & 63; float acc = 0.f;
        for (int k = 0; k < 128; ++k) acc += hs[c][k] * w2[((size_t)c * 128 + k) * 64 + d];
        kcv[(((size_t)b * nc + n) * 2 + c) * 128 + g * 64 + d] = acc; }
}
template <class KP> __device__ __forceinline__ float attend(int NK, KP kp, float (*sc)[1024], const float (*q)[64], float* red) {
    const int tid = threadIdx.x, r = tid >> 6, l = tid & 63;
    for (int i = tid; i < NK; i += 256) { const float* k = kp(i);
        if (k) { float s0 = 0.f, s1 = 0.f, s2 = 0.f, s3 = 0.f;
            for (int d = 0; d < 64; ++d) { const float kv = k[d]; s0 += q[0][d] * kv; s1 += q[1][d] * kv; s2 += q[2][d] * kv; s3 += q[3][d] * kv; }
            sc[0][i] = s0; sc[1][i] = s1; sc[2][i] = s2; sc[3][i] = s3; }
        else { sc[0][i] = -1e30f; sc[1][i] = -1e30f; sc[2][i] = -1e30f; sc[3][i] = -1e30f; } }
    __syncthreads();
    float m = -1e30f; for (int i = l; i < NK; i += 64) m = fmaxf(m, sc[r][i]);
    for (int o = 32; o > 0; o >>= 1) m = fmaxf(m, __shfl_xor(m, o));
    float sum = 0.f;
    for (int i = l; i < NK; i += 64) { const float s = sc[r][i]; const float e = (s > -1e29f) ? expf(s - m) : 0.f; sc[r][i] = e; sum += e; }
    for (int o = 32; o > 0; o >>= 1) sum += __shfl_xor(sum, o);
    const float inv = 1.f / fmaxf(sum, 1e-30f);
    for (int i = l; i < NK; i += 64) sc[r][i] *= inv;
    __syncthreads();
    float o = 0.f;
    for (int i = 0; i < NK; ++i) { const float p = sc[r][i]; if (p != 0.f) { const float* k = kp(i); o += p * k[128 + l]; } }
    (void)red; return o;
}
__global__ void __launch_bounds__(256) k_nsa(const float* Z, const float* kcv_p, const float* kcv_s, const float* cache_slc, const float* cache_win, const int* table, float* att) {
    __shared__ float sc[4][1024]; __shared__ float q[4][64]; __shared__ float score[260]; __shared__ int sel[16]; __shared__ float red[256];
    const int g = blockIdx.x & 1, row = blockIdx.x >> 1, tid = threadIdx.x, r = tid >> 6, l = tid & 63;
    const bool sample = row >= RP;
    const int b = sample ? (row - RP) / SS : row / SEQ;
    const int tq = sample ? PAST + (row - RP) % SS : row % SEQ;
    const int nc = sample ? 1023 : 127, nb = sample ? 257 : 32;
    q[r][l] = Z[(size_t)row * ZW + C_QN + (g * 4 + r) * 64 + l] * 0.125f;
    __syncthreads();
    const float* kcv = sample ? kcv_s + (size_t)b * 1023 * 256 : kcv_p + (size_t)b * 127 * 256;
    auto kp_c = [&](int i) -> const float* { return (16 * i + 31 <= tq) ? kcv + (size_t)i * 256 + g * 64 : nullptr; };
    const float oc = attend(nc, kp_c, sc, q, red);
    for (int j = tid; j < nb; j += 256) { float imp = 0.f;
        for (int i = 4 * j - 1; i <= 4 * j + 3; ++i) if (i >= 0 && i < nc) imp += (sc[0][i] + sc[1][i]) + (sc[2][i] + sc[3][i]);
        const int cur = tq >> 6; const bool valid = j * 64 <= tq; const bool forced = (j == 0) || (j == cur) || (j == cur - 1);
        score[j] = valid ? imp + (forced ? 1e4f : 0.f) : -INFINITY; }
    __syncthreads();
    if (tid == 0) { for (int s = 0; s < 16; ++s) { int best = -1; float bv = 0.f;
            for (int j = 0; j < nb; ++j) { const float v = score[j]; if (v != v) continue; if (best < 0 || v > bv) { best = j; bv = v; } }
            sel[s] = best; score[best] = __builtin_nanf(""); } }
    __syncthreads();
    auto kp_s = [&](int i) -> const float* { const int pos = sel[i >> 6] * 64 + (i & 63); if (pos > tq) return nullptr;
        if (!sample) return Z + ((size_t)b * SEQ + pos) * ZW + C_KVS + g * 64;
        if (pos < PAST) return cache_slc + ((size_t)table[b * NPAGES + (pos >> 7)] * PAGE + (pos & 127)) * 256 + g * 64;
        return Z + (size_t)(RP + b * SS + (pos - PAST)) * ZW + C_KVS + g * 64; };
    const float os = attend(1024, kp_s, sc, q, red);
    __syncthreads();
    float ow;
    if (!sample) { auto kp_w = [&](int i) -> const float* { const int t = tq - 511 + i; return (t >= 0) ? Z + ((size_t)b * SEQ + t) * ZW + C_KVW + g * 64 : nullptr; };
        ow = attend(512, kp_w, sc, q, red); }
    else { auto kp_w = [&](int i) -> const float* { const int tw = PAST - 512 + i; if (tw > tq || tw <= tq - 512) return nullptr;
            return i < 512 ? cache_win + ((size_t)b * 512 + i) * 256 + g * 64 : Z + (size_t)(RP + b * SS + (i - 512)) * ZW + C_KVW + g * 64; };
        ow = attend(516, kp_w, sc, q, red); }
    const int h = g * 4 + r; const float* gn = Z + (size_t)row * ZW + C_GN + h * 3;
    att[(size_t)row * D + 512 + h * 64 + l] = sigmoidf_(gn[0]) * oc + sigmoidf_(gn[1]) * os + sigmoidf_(gn[2]) * ow;
}
__global__ void k_res_ln(const float* X, const float* Mx, const float* mod, int ga_off, const float* g, const float* b, int sh_off, int sc_off, float* out1, float* out2, float* outp, float* outs) {
    __shared__ float red[256];
    const int r = blockIdx.x, tid = threadIdx.x; const float* m = mod + mod_row(r) * 6144;
    float v[4]; float s = 0.f;
#pragma unroll
    for (int j = 0; j < 4; ++j) { const int c = tid + 256 * j; v[j] = ALPHA * X[(size_t)r * D + c] + m[ga_off + c] * Mx[(size_t)r * D + c]; s += v[j]; }
    const float mean = block_sum256(s, red) * (1.f / D);
    float q = 0.f;
#pragma unroll
    for (int j = 0; j < 4; ++j) { v[j] -= mean; q += v[j] * v[j]; }
    const float rstd = rsqrtf(block_sum256(q, red) * (1.f / D) + 1e-5f);
#pragma unroll
    for (int j = 0; j < 4; ++j) { const int c = tid + 256 * j; const float y = v[j] * rstd * g[c] + b[c];
        if (out1) out1[(size_t)r * D + c] = y;
        if (out2) out2[(size_t)r * D + c] = y * (1.f + m[sc_off + c]) + m[sh_off + c];
        if (outp) { if (r < RP) outp[(size_t)r * D + c] = y; else outs[(size_t)(r - RP) * D + c] = y; } }
}
__global__ void k_swiglu(const float* F1, float* HM) {
    const long i = (long)blockIdx.x * 256 + threadIdx.x; if (i >= (long)R * DFF) return;
    const int r = (int)(i / DFF), c = (int)(i % DFF);
    HM[i] = siluf_(F1[(size_t)r * 5632 + c]) * F1[(size_t)r * 5632 + DFF + c];
}

struct Bufs { float *MOD, *XN, *U, *Z, *LOGA, *KCVP, *KCVS, *ATT, *MIX, *X1, *F1, *HM; };
static inline Bufs carve(void* ws) { char* p = (char*)ws + (64u << 20); Bufs b; auto take = [&](size_t n) { float* r = (float*)p; p += ((n * 4 + 255) / 256) * 256; return r; };
    b.MOD = take(40 * 6144); b.XN = take((size_t)R * D); b.U = take((size_t)R * D); b.Z = take((size_t)R * ZW); b.LOGA = take((size_t)R * 256);
    b.KCVP = take(8 * 127 * 256); b.KCVS = take((size_t)32 * 1023 * 256); b.ATT = take((size_t)R * D); b.MIX = take((size_t)R * D); b.X1 = take((size_t)R * D);
    b.F1 = take((size_t)R * 5632); b.HM = take((size_t)R * DFF); return b; }

static void run(void* const* d_in, float* out, void* ws, hipStream_t st) {
    const float* xp = (const float*)d_in[0]; const float* xs = (const float*)d_in[1]; const float* state = (const float*)d_in[2];
    const float* c_cmp = (const float*)d_in[3]; const float* c_slc = (const float*)d_in[4]; const float* c_win = (const float*)d_in[5]; const int* table = (const int*)d_in[6];
    const float* cp = (const float*)d_in[7]; const float* cs = (const float*)d_in[8]; const float* ln_g = (const float*)d_in[9]; const float* ln_b = (const float*)d_in[10];
    const float* w_ada = (const float*)d_in[11]; const float* b_ada = (const float*)d_in[12]; const float* w_in = (const float*)d_in[13];
    const float* w_a2 = (const float*)d_in[14]; const float* b_a = (const float*)d_in[15]; const float* gamma = (const float*)d_in[16];
    const float* pe = (const float*)d_in[17]; const float* w1 = (const float*)d_in[18]; const float* b1 = (const float*)d_in[19]; const float* w2 = (const float*)d_in[20];
    const float* w_o = (const float*)d_in[21]; const float* ln1_g = (const float*)d_in[22]; const float* ln1_b = (const float*)d_in[23];
    const float* w_f1 = (const float*)d_in[24]; const float* w_f2 = (const float*)d_in[25]; const float* ln2_g = (const float*)d_in[26]; const float* ln2_b = (const float*)d_in[27];
    Bufs B = carve(ws);
    k_mod<<<dim3(24, 40), 256, 0, st>>>(cp, cs, w_ada, b_ada, B.MOD);
    k_ln<<<R, 256, 0, st>>>(xp, xs, ln_g, ln_b, B.MOD, 0, 1024, B.XN, B.U);
    k_sgemm<<<dim3((ZW + 63) / 64, R / 64), 256, 0, st>>>(B.U, D, w_in, ZW, B.Z, ZW, R, ZW, D);
    k_kvout<<<RP, 256, 0, st>>>(B.Z, c_win, out);
    k_loga<<<R, 256, 0, st>>>(B.Z, w_a2, b_a, B.LOGA);
    k_gla<<<NB_P * 4, 128, 0, st>>>(B.Z, B.LOGA, nullptr, gamma, 0, SEQ, B.ATT, out + O_GSP);
    k_gla<<<NB_S * 4, 128, 0, st>>>(B.Z, B.LOGA, state, gamma, RP, SS, B.ATT, out + O_GSS);
    k_compress<<<NB_P * 127 * 2, 256, 0, st>>>(B.Z, nullptr, nullptr, 0, 127, pe, w1, b1, w2, B.KCVP);
    k_compress<<<NB_S * 1023 * 2, 256, 0, st>>>(B.Z, c_cmp, table, 1, 1023, pe, w1, b1, w2, B.KCVS);
    k_nsa<<<R * 2, 256, 0, st>>>(B.Z, B.KCVP, B.KCVS, c_slc, c_win, table, B.ATT);
    k_sgemm<<<dim3(D / 64, R / 64), 256, 0, st>>>(B.ATT, D, w_o, D, B.MIX, D, R, D, D);
    k_res_ln<<<R, 256, 0, st>>>(B.XN, B.MIX, B.MOD, 2048, ln1_g, ln1_b, 3072, 4096, B.X1, B.U, nullptr, nullptr);
    k_sgemm<<<dim3(5632 / 64, R / 64), 256, 0, st>>>(B.U, D, w_f1, 5632, B.F1, 5632, R, 5632, D);
    k_swiglu<<<(int)(((long)R * DFF + 255) / 256), 256, 0, st>>>(B.F1, B.HM);
    k_sgemm<<<dim3(D / 64, R / 64), 256, 0, st>>>(B.HM, DFF, w_f2, D, B.MIX, D, R, D, DFF);
    k_res_ln<<<R, 256, 0, st>>>(B.X1, B.MIX, B.MOD, 5120, ln2_g, ln2_b, 0, 0, nullptr, nullptr, out + O_YP, out + O_YS);
}
}
extern "C" void kernel_launch(void* const* d_in, const int* in_sizes, int n_in, void* d_out, int out_size, void* d_ws, size_t ws_size, hipStream_t stream) {
    (void)in_sizes; (void)n_in; (void)out_size; (void)ws_size;
    nv::run(d_in, (float*)d_out, d_ws, stream);
}
```

```cpp
#include <hip/hip_runtime.h>
#include <cstdio>
#include <cstdint>
#include <cmath>
namespace fc {
constexpr int D = 1024, RP = 16384, RS = 128, R = RP + RS, MP = 16640;
constexpr int ZN = 3072;
constexpr int PZ_QG = 0, PZ_KG = 256, PZ_VG = 512, PZ_RG = 1024, PZ_QN = 1536, PZ_KVC = 2048, PZ_KVS = 2304, PZ_KVW = 2560, PZ_AG = 2816, PZ_GN = 2832;
constexpr int DFF = 2816, F1N = 5632;
constexpr float ALPHA = 1.189207115002721f;
constexpr long O_YP = 0, O_YS = 16777216, O_GSP = 16908288, O_GSS = 17170432, O_CKP = 18219008, O_CKS = 22413312, O_SKP = 22446080, O_SKS = 26640384,
               O_WKP = 26673152, O_WKS = 27721728, O_END = 31916032;
}
namespace pg8 {
#define PG8_LAS __attribute__((address_space(3)))
typedef unsigned short bf16_t;
typedef short bf16x8 __attribute__((ext_vector_type(8)));
typedef float f32x4 __attribute__((ext_vector_type(4)));
typedef unsigned u32x4 __attribute__((ext_vector_type(4)));
constexpr int BM = 256, BK = 64, HALF = 128, HTB = HALF * BK * 2  , STAGE_BYTES = 8 * HTB, NXCD = 8, WGM = 8;

__host__ __device__ __forceinline__ int lds_byte(int r, int c) { const int st = (r >> 4) * 2 + (c >> 5), rr = r & 15, cc = c & 31, ob = rr * 64 + cc * 2; return st * 1024 + (ob ^ (((ob >> 9) & 1) << 5)); }
__host__ __device__ __forceinline__ void stage_rc(int b, int& R, int& C) { const int st = b / 1024, sb = b % 1024, swz = sb ^ (((sb >> 9) & 1) << 5); R = (st >> 1) * 16 + swz / 64; C = (st & 1) * 32 + (swz % 64) / 2; }
__host__ __device__ __forceinline__ int perm32(int rho) { const int n = rho >> 4, i = rho & 15; return 8 * (i >> 2) + 4 * n + (i & 3); }

struct Unit { int pm, pn; };
struct Gemm { const bf16_t* A; const bf16_t* Bt; int M, N, K; };

struct StaticOrder {
    int nM, nN, nwg, G, c;
    __host__ __device__ void init(int M, int N, int G_, int c_) { nM = M / BM; nN = N / BM; nwg = nM * nN; G = G_; c = c_; }
    __host__ __device__ bool next(int i, Unit& u) const {
        const long L = (long)i * G + c; if (L >= nwg) return false;
        int wgid = (int)L; { const int q = nwg / NXCD, r = nwg % NXCD, xcd = wgid % NXCD, off = wgid / NXCD; wgid = (xcd < r ? xcd * (q + 1) : r * (q + 1) + (xcd - r) * q) + off; }
        const int nig = WGM * nN, gid = wgid / nig, fm = gid * WGM, gsz = (nM - fm) < WGM ? (nM - fm) : WGM;
        u.pm = fm + ((wgid % nig) % gsz); u.pn = (wgid % nig) / gsz; return true;
    }
    __device__ __forceinline__ void a_ready(const Unit&) const {}
    __device__ __forceinline__ void done(const Unit&) const {}
};

__device__ __forceinline__ unsigned cvt_pk_bf16(float lo, float hi) { unsigned r; asm volatile("v_cvt_pk_bf16_f32 %0, %1, %2" : "=v"(r) : "v"(lo), "v"(hi)); return r; }
typedef float f32x2 __attribute__((ext_vector_type(2)));
__device__ __forceinline__ f32x2 gelu_pk(f32x2 v) {
    const f32x2 av = __builtin_elementwise_abs(v), d = av * 0.2316418882f + 1.0f;
    f32x2 t; t.x = __builtin_amdgcn_rcpf(d.x); t.y = __builtin_amdgcn_rcpf(d.y);
    f32x2 q = t * 0.5307027145f + (-0.7265760135f); q = q * t + 0.7107068705f; q = q * t + (-0.142248368f); q = q * t + 0.127414796f; q = q * t;
    const f32x2 s = (v * v) * (-0.72134752044f);
    f32x2 e; e.x = __builtin_amdgcn_exp2f(s.x); e.y = __builtin_amdgcn_exp2f(s.y);
    const f32x2 m = v * (q * e), r = v - m;
    f32x2 o; o.x = v.x < 0.f ? m.x : r.x; o.y = v.y < 0.f ? m.y : r.y; return o;
}

template <int ACT  > struct EpiBf16 {
    static constexpr bool PERM = true, AFTER_DRAIN = false; static_assert(ACT == 0 || ACT == 1, "EpiBf16: ACT is 0 (none) or 1 (gelu_pk)");
    bf16_t* O; int ldc; const float* bias; int split_cols; size_t split_stride; float scale0;
    __device__ __forceinline__ void operator()(const f32x4 (&acc)[2][2][4][2], const Unit& u, int wr, int wc, int fr, int fq) const {
        const int row0 = u.pm * BM + wr * 64 + fr; int colt = u.pn * BM; bf16_t* base = O;
        float sc = 1.f; if (split_cols) { const int t = colt / split_cols; base += (size_t)t * split_stride; colt -= t * split_cols; if (t == 0) sc = scale0; }
        const int col0 = colt + wc * 32 + 8 * fq, bcol0 = u.pn * BM + wc * 32 + 8 * fq;
        f32x4 bv[2][2];
#pragma unroll
        for (int bj = 0; bj < 2; ++bj)
#pragma unroll
            for (int n = 0; n < 2; ++n) bv[bj][n] = bias ? *(const f32x4*)(bias + bcol0 + bj * HALF + 4 * n) : (f32x4){0.f, 0.f, 0.f, 0.f};
#pragma unroll
        for (int ai = 0; ai < 2; ++ai)
#pragma unroll
            for (int m = 0; m < 4; ++m) { bf16_t* rowp = base + (size_t)(row0 + ai * HALF + m * 16) * ldc + col0;
#pragma unroll
                for (int bj = 0; bj < 2; ++bj) { f32x4 v0 = acc[ai][bj][m][0] + bv[bj][0], v1 = acc[ai][bj][m][1] + bv[bj][1];
                    if (ACT == 1) { f32x2 a = gelu_pk((f32x2){v0[0], v0[1]}), b = gelu_pk((f32x2){v0[2], v0[3]}), c = gelu_pk((f32x2){v1[0], v1[1]}), d = gelu_pk((f32x2){v1[2], v1[3]});
                        v0 = (f32x4){a.x, a.y, b.x, b.y}; v1 = (f32x4){c.x, c.y, d.x, d.y}; }
                    v0 = v0 * sc; v1 = v1 * sc; u32x4 w; w.x = cvt_pk_bf16(v0[0], v0[1]); w.y = cvt_pk_bf16(v0[2], v0[3]); w.z = cvt_pk_bf16(v1[0], v1[1]); w.w = cvt_pk_bf16(v1[2], v1[3]);
                    *(u32x4*)(rowp + bj * HALF) = w; } }
    }
};
struct EpiZ {
    static constexpr bool PERM = true, AFTER_DRAIN = false;
    bf16_t* ZB; float* out; float* narrow; bf16_t* pcmp;
    __device__ __forceinline__ void operator()(const f32x4 (&acc)[2][2][4][2], const Unit& u, int wr, int wc, int fr, int fq) const {
        const int pn = u.pn; const float sc = (pn == 0 || pn == 6 || pn == 7) ? 0.125f : 1.0f;
        const int row0 = u.pm * BM + wr * 64 + fr, cc0 = wc * 32 + 8 * fq;
        if (pn >= 12) {
            const int c = pn - 12; bf16_t* base = pcmp + (size_t)c * 65536 * 256 + ((size_t)(u.pm - 65 - 256 * c) * BM + wr * 64 + fr) * 256 + cc0;
#pragma unroll
            for (int ai = 0; ai < 2; ++ai)
#pragma unroll
                for (int m = 0; m < 4; ++m)
#pragma unroll
                    for (int bj = 0; bj < 2; ++bj) { const f32x4 v0 = acc[ai][bj][m][0], v1 = acc[ai][bj][m][1];
                        u32x4 w; w.x = cvt_pk_bf16(v0[0], v0[1]); w.y = cvt_pk_bf16(v0[2], v0[3]); w.z = cvt_pk_bf16(v1[0], v1[1]); w.w = cvt_pk_bf16(v1[2], v1[3]);
                        *(u32x4*)(base + (size_t)(ai * HALF + m * 16) * 256 + bj * HALF) = w; }
            return; }
#pragma unroll
        for (int ai = 0; ai < 2; ++ai)
#pragma unroll
            for (int m = 0; m < 4; ++m) { const int row = row0 + ai * HALF + m * 16; bf16_t* rowp = ZB + (size_t)row * fc::ZN + pn * BM + cc0;
                float* fdst = nullptr;
                if (pn >= 8 && pn <= 10 && row < fc::R) {
                    if (row < fc::RP) { const int b = row >> 11, t = row & 2047;
                        if (pn == 8) fdst = out + fc::O_CKP + (size_t)row * 256; else if (pn == 9) fdst = out + fc::O_SKP + (size_t)row * 256;
                        else if (t >= 1536) fdst = out + fc::O_WKP + ((size_t)b * 512 + (t - 1536)) * 256; }
                    else { const int rr = row - fc::RP;
                        if (pn == 8) fdst = out + fc::O_CKS + (size_t)rr * 256; else if (pn == 9) fdst = out + fc::O_SKS + (size_t)rr * 256;
                        else fdst = out + fc::O_WKS + ((size_t)(rr >> 2) * 512 + 508 + (rr & 3)) * 256; } }
#pragma unroll
                for (int bj = 0; bj < 2; ++bj) { const f32x4 v0 = acc[ai][bj][m][0] * sc, v1 = acc[ai][bj][m][1] * sc;
                    u32x4 w; w.x = cvt_pk_bf16(v0[0], v0[1]); w.y = cvt_pk_bf16(v0[2], v0[3]); w.z = cvt_pk_bf16(v1[0], v1[1]); w.w = cvt_pk_bf16(v1[2], v1[3]);
                    *(u32x4*)(rowp + bj * HALF) = w;
                    if (fdst) { *(f32x4*)(fdst + cc0 + bj * HALF) = v0; *(f32x4*)(fdst + cc0 + bj * HALF + 4) = v1; }
                    if (pn == 11 && bj == 0 && cc0 < 64) { *(f32x4*)(narrow + (size_t)row * 64 + cc0) = v0; *(f32x4*)(narrow + (size_t)row * 64 + cc0 + 4) = v1; } } }
    }
};
struct EpiF32 {
    static constexpr bool PERM = false, AFTER_DRAIN = false;
    float* O; int ldc;
    __device__ __forceinline__ void operator()(const f32x4 (&acc)[2][2][4][2], const Unit& u, int wr, int wc, int fr, int fq) const {
        const int row0 = u.pm * BM + wr * 64 + fr, col0 = u.pn * BM + wc * 32 + 4 * fq;
#pragma unroll
        for (int ai = 0; ai < 2; ++ai)
#pragma unroll
            for (int m = 0; m < 4; ++m) { float* rowp = O + (size_t)(row0 + ai * HALF + m * 16) * ldc + col0;
#pragma unroll
                for (int bj = 0; bj < 2; ++bj)
#pragma unroll
                    for (int n = 0; n < 2; ++n) *(f32x4*)(rowp + bj * HALF + n * 16) = acc[ai][bj][m][n]; }
    }
};
struct EpiSwiglu {
    static constexpr bool PERM = true, AFTER_DRAIN = false;
    bf16_t* HM;
    __device__ __forceinline__ void operator()(const f32x4 (&acc)[2][2][4][2], const Unit& u, int wr, int wc, int fr, int fq) const {
        const int row0 = u.pm * BM + wr * 64 + fr, col0 = u.pn * HALF + wc * 32 + 8 * fq;
#pragma unroll
        for (int ai = 0; ai < 2; ++ai)
#pragma unroll
            for (int m = 0; m < 4; ++m) { float o[8];
#pragma unroll
                for (int n = 0; n < 2; ++n)
#pragma unroll
                    for (int e = 0; e < 4; ++e) { const float g = acc[ai][0][m][n][e], up = acc[ai][1][m][n][e]; o[n * 4 + e] = g * __builtin_amdgcn_rcpf(1.0f + __builtin_amdgcn_exp2f(-1.4426950408889634f * g)) * up; }
                u32x4 w; w.x = cvt_pk_bf16(o[0], o[1]); w.y = cvt_pk_bf16(o[2], o[3]); w.z = cvt_pk_bf16(o[4], o[5]); w.w = cvt_pk_bf16(o[6], o[7]);
                *(u32x4*)(HM + (size_t)(row0 + ai * HALF + m * 16) * fc::DFF + col0) = w; }
    }
};
struct ComboOrder {
    StaticOrder so; int G, c;
    __device__ void init(int G_, int c_) { so.init(fc::MP, fc::ZN, G_, c_); G = G_; c = c_; }
    __device__ bool next(int i, Unit& u) const { const long L = (long)i * G + c; if (L < 780) return so.next(i, u); if (L >= 780 + 512) return false;
        const int j = (int)L - 780, cc = j >> 8, t = j & 255; u.pm = 65 + cc * 256 + t; u.pn = 12 + cc; return true; }
    __device__ __forceinline__ void a_ready(const Unit&) const {}
    __device__ __forceinline__ void done(const Unit&) const {}
};
template <class Epi, class Sched, bool ALIGN_EPI = false, bool SP2 = false>
__device__ __forceinline__ void gemm_phase(PG8_LAS unsigned char* lds, const Gemm g, const Sched& S, const Epi& E) {
    const int tid = threadIdx.x, wid = __builtin_amdgcn_readfirstlane(tid >> 6), lane = tid & 63, wr = wid >> 2, wc = wid & 3, fr = lane & 15, fq = lane >> 4;
    const int K = g.K, nt = K / BK;
    unsigned voffA[2], voffB[2];
#pragma unroll
    for (int i = 0; i < 2; ++i) { int R, C; stage_rc(tid * 16 + i * 8192, R, C); const int Rb = Epi::PERM ? ((R & ~31) + perm32(R & 31)) : R;
        voffA[i] = (unsigned)(R * K + C) * 2u; voffB[i] = (unsigned)(Rb * K + C) * 2u; }
    const size_t kstep = (size_t)(BK * 2);
    const size_t hstep = (size_t)HALF * K * 2;
    const size_t tstep = 2 * hstep;
    const unsigned ldsw = (unsigned)wid * 1024u;
    const int aoff = lds_byte(wr * 64 + fr, fq * 8), boff = lds_byte(wc * 32 + fr, fq * 8);
#define PG8_SA(b, h) (((b) * 2 + (h)) * HTB)
#define PG8_SB(b, h) ((4 + (b) * 2 + (h)) * HTB)
#define PG8_STAGE(bufoff, gbase, voff) do { _Pragma("unroll") for (int _i = 0; _i < 2; ++_i) \
        __builtin_amdgcn_global_load_lds((const unsigned*)((const char*)(gbase) + (voff)[_i]), (PG8_LAS unsigned*)(lds + (bufoff) + ldsw + _i * 8192), 16, 0, 0); } while (0)
#define PG8_LDA(dst, b, h) do { _Pragma("unroll") for (int m = 0; m < 4; ++m) _Pragma("unroll") for (int k = 0; k < 2; ++k) dst[m][k] = *(const PG8_LAS bf16x8*)(lds + PG8_SA(b, h) + aoff + m * 2048 + k * 1024); } while (0)
#define PG8_LDB(dst, b, h) do { _Pragma("unroll") for (int n = 0; n < 2; ++n) _Pragma("unroll") for (int k = 0; k < 2; ++k) dst[n][k] = *(const PG8_LAS bf16x8*)(lds + PG8_SB(b, h) + boff + n * 2048 + k * 1024); } while (0)
#define PG8_MMA(ai, bj, At, Bt) do { __builtin_amdgcn_s_setprio(1); _Pragma("unroll") for (int m = 0; m < 4; ++m) _Pragma("unroll") for (int n = 0; n < 2; ++n) _Pragma("unroll") for (int k = 0; k < 2; ++k) \
        acc[ai][bj][m][n] = __builtin_amdgcn_mfma_f32_16x16x32_bf16(Bt[n][k], At[m][k], acc[ai][bj][m][n], 0, 0, 0); __builtin_amdgcn_s_setprio(0); } while (0)
#define PG8_WAIT_V(n) asm volatile("s_waitcnt vmcnt(" #n ")" ::: "memory")
#define PG8_WAIT_L(n) asm volatile("s_waitcnt lgkmcnt(" #n ")" ::: "memory")
#define PG8_BAR __builtin_amdgcn_s_barrier()
#define PG8_SCHED __builtin_amdgcn_sched_barrier(0)
    Unit cur, nxt; int ui = 0;
    if (!S.next(0, cur)) return;
    f32x4 acc[2][2][4][2];
#pragma unroll
    for (int a = 0; a < 2; ++a)
#pragma unroll
        for (int b = 0; b < 2; ++b)
#pragma unroll
            for (int m = 0; m < 4; ++m)
#pragma unroll
                for (int n = 0; n < 2; ++n) acc[a][b][m][n] = (f32x4){0.f, 0.f, 0.f, 0.f};
    bf16x8 At[4][2], B0[2][2], B1[2][2];
    const char* cA = (const char*)g.A + (size_t)cur.pm * tstep; const char* cB = (const char*)g.Bt + (size_t)cur.pn * tstep;
    S.a_ready(cur);
    if constexpr (SP2) {
        PG8_STAGE(PG8_SB(0, 0), cB, voffB); PG8_STAGE(PG8_SB(0, 1), cB + hstep, voffB); PG8_STAGE(PG8_SA(0, 0), cA, voffA); PG8_STAGE(PG8_SA(0, 1), cA + hstep, voffA);
        if (wr == 1) PG8_BAR;
        PG8_WAIT_V(2); PG8_BAR;
        PG8_STAGE(PG8_SB(1, 0), cB + kstep, voffB); PG8_STAGE(PG8_SA(1, 0), cA + kstep, voffA); PG8_STAGE(PG8_SB(1, 1), cB + hstep + kstep, voffB);
        PG8_WAIT_V(6); PG8_BAR;
    } else {
        PG8_STAGE(PG8_SB(0, 0), cB, voffB); PG8_STAGE(PG8_SA(0, 0), cA, voffA); PG8_STAGE(PG8_SB(0, 1), cB + hstep, voffB); PG8_STAGE(PG8_SA(0, 1), cA + hstep, voffA);
        if (wr == 1) PG8_BAR;
        PG8_WAIT_V(4); PG8_BAR;
        PG8_STAGE(PG8_SB(1, 0), cB + kstep, voffB); PG8_STAGE(PG8_SA(1, 0), cA + kstep, voffA); PG8_STAGE(PG8_SB(1, 1), cB + hstep + kstep, voffB);
        PG8_WAIT_V(6); PG8_BAR;
    }
    for (;;) {
        const bool has_next = S.next(ui + 1, nxt);
        const char* nA = has_next ? (const char*)g.A + (size_t)nxt.pm * tstep : cA; const char* nB = has_next ? (const char*)g.Bt + (size_t)nxt.pn * tstep : cB;
        for (int t = 0; t < nt; t += 2) {
            const bool last = (t == nt - 2);
            const char* a1 = cA + (size_t)(t + 1) * kstep;
            const char* a2 = last ? nA : cA + (size_t)(t + 2) * kstep; const char* b2 = last ? nB : cB + (size_t)(t + 2) * kstep;
            const char* a3 = a2 + kstep; const char* b3 = b2 + kstep;
            if (last && has_next) S.a_ready(nxt);
            if constexpr (SP2) {
            PG8_LDB(B0, 0, 0); PG8_LDB(B1, 0, 1); PG8_SCHED; PG8_LDA(At, 0, 0); PG8_STAGE(PG8_SA(1, 1), a1 + hstep, voffA);
            PG8_WAIT_V(8); PG8_WAIT_L(0); PG8_BAR; PG8_MMA(0, 0, At, B0); PG8_MMA(0, 1, At, B1); PG8_BAR; PG8_SCHED;
            PG8_LDA(At, 0, 1); PG8_STAGE(PG8_SB(0, 0), b2, voffB); PG8_STAGE(PG8_SB(0, 1), b2 + hstep, voffB); PG8_STAGE(PG8_SA(0, 0), a2, voffA);
            PG8_WAIT_V(8); PG8_WAIT_L(0); PG8_BAR; PG8_MMA(1, 0, At, B0); PG8_MMA(1, 1, At, B1); PG8_BAR; PG8_SCHED;
            PG8_LDB(B0, 1, 0); PG8_LDB(B1, 1, 1); PG8_SCHED; PG8_LDA(At, 1, 0); PG8_STAGE(PG8_SA(0, 1), a2 + hstep, voffA);
            PG8_WAIT_V(8); PG8_WAIT_L(0); PG8_BAR; PG8_MMA(0, 0, At, B0); PG8_MMA(0, 1, At, B1); PG8_BAR; PG8_SCHED;
            PG8_LDA(At, 1, 1); PG8_STAGE(PG8_SB(1, 0), b3, voffB); PG8_STAGE(PG8_SB(1, 1), b3 + hstep, voffB); PG8_STAGE(PG8_SA(1, 0), a3, voffA);
            PG8_WAIT_V(8); PG8_WAIT_L(0); PG8_BAR; PG8_MMA(1, 0, At, B0); PG8_MMA(1, 1, At, B1); PG8_BAR; PG8_SCHED;
            } else {
            PG8_LDB(B0, 0, 0); PG8_SCHED; PG8_LDA(At, 0, 0); PG8_STAGE(PG8_SA(1, 1), a1 + hstep, voffA);
            PG8_WAIT_L(8); PG8_BAR; PG8_WAIT_L(0); PG8_MMA(0, 0, At, B0); PG8_BAR; PG8_SCHED;
            PG8_LDB(B1, 0, 1); PG8_STAGE(PG8_SB(0, 0), b2, voffB);
            PG8_BAR; PG8_WAIT_L(0); PG8_MMA(0, 1, At, B1); PG8_BAR;
            PG8_LDA(At, 0, 1); PG8_STAGE(PG8_SA(0, 0), a2, voffA);
            PG8_BAR; PG8_WAIT_L(0); PG8_MMA(1, 0, At, B0); PG8_BAR; PG8_SCHED;
            PG8_STAGE(PG8_SB(0, 1), b2 + hstep, voffB);
            PG8_WAIT_V(6); PG8_BAR; PG8_MMA(1, 1, At, B1); PG8_BAR;
            PG8_LDB(B0, 1, 0); PG8_SCHED; PG8_LDA(At, 1, 0); PG8_STAGE(PG8_SA(0, 1), a2 + hstep, voffA);
            PG8_WAIT_L(8); PG8_BAR; PG8_WAIT_L(0); PG8_MMA(0, 0, At, B0); PG8_BAR; PG8_SCHED;
            PG8_LDB(B1, 1, 1); PG8_STAGE(PG8_SB(1, 0), b3, voffB);
            PG8_BAR; PG8_WAIT_L(0); PG8_MMA(0, 1, At, B1); PG8_BAR;
            PG8_LDA(At, 1, 1); PG8_STAGE(PG8_SA(1, 0), a3, voffA);
            PG8_BAR; PG8_WAIT_L(0); PG8_MMA(1, 0, At, B0); PG8_BAR; PG8_SCHED;
            PG8_STAGE(PG8_SB(1, 1), b3 + hstep, voffB);
            PG8_WAIT_V(6); PG8_BAR; PG8_MMA(1, 1, At, B1); PG8_BAR;
            }
        }
        if constexpr (ALIGN_EPI) { if (wr == 0) PG8_BAR; }
        if constexpr (!Epi::AFTER_DRAIN) { E(acc, cur, wr, wc, fr, fq); S.done(cur); }
        if (!has_next) break;
#pragma unroll
        for (int a = 0; a < 2; ++a)
#pragma unroll
            for (int b = 0; b < 2; ++b)
#pragma unroll
                for (int m = 0; m < 4; ++m)
#pragma unroll
                    for (int n = 0; n < 2; ++n) acc[a][b][m][n] = (f32x4){0.f, 0.f, 0.f, 0.f};
        cur = nxt; cA = nA; cB = nB; ++ui;
        if constexpr (ALIGN_EPI) { if (wr == 1) PG8_BAR; }
    }
    PG8_WAIT_V(0);
    if constexpr (!ALIGN_EPI) { if (wr == 0) PG8_BAR; }
    PG8_BAR;
    if constexpr (Epi::AFTER_DRAIN) { E.fused(acc, cur, wr, wc, fr, fq, lds, wid, lane); S.done(cur); }
#undef PG8_SA
#undef PG8_SB
#undef PG8_STAGE
#undef PG8_LDA
#undef PG8_LDB
#undef PG8_MMA
#undef PG8_WAIT_V
#undef PG8_WAIT_L
#undef PG8_BAR
#undef PG8_SCHED
}
}
#define GAS __attribute__((address_space(1)))
#define LAS __attribute__((address_space(3)))
typedef unsigned short bf16;
typedef unsigned v4u __attribute__((ext_vector_type(4)));
typedef float f32x4 __attribute__((ext_vector_type(4)));
typedef short bf16x8 __attribute__((ext_vector_type(8)));
typedef GAS unsigned gu32;
typedef GAS unsigned long long gu64;
#define RLX_AGENT __ATOMIC_RELAXED, __HIP_MEMORY_SCOPE_AGENT
#define LDS_WAIT() asm volatile("s_waitcnt lgkmcnt(0)" ::: "memory")
#define VM_WAIT() asm volatile("s_waitcnt vmcnt(0)" ::: "memory")
__device__ __forceinline__ unsigned long long rt() { return __builtin_amdgcn_s_memrealtime(); }
__device__ __forceinline__ unsigned f2bf(float f) { unsigned u = __builtin_bit_cast(unsigned, f); return (u + 0x7fffu + ((u >> 16) & 1u)) >> 16; }
__device__ __forceinline__ unsigned pk2(float lo, float hi) { return f2bf(lo) | (f2bf(hi) << 16); }
#define XB_TMO      128
#define XB_XCNT(j)  (256  + 64 * (j))
#define XB_XSUB(j)  (1280 + 64 * (j))
#define XB_XGEN(j)  (2304 + 64 * (j))
#define XB_TOP      3328
#define XB_TOPGEN   3392
#define XCD_BAR_WORDS 3456
#define XB_SPIN_CAP (1u << 18)

__device__ __forceinline__ unsigned xb_ld(unsigned* p)              { return __hip_atomic_load(p, __ATOMIC_RELAXED, __HIP_MEMORY_SCOPE_AGENT); }
__device__ __forceinline__ unsigned xb_add(unsigned* p, unsigned v) { return __hip_atomic_fetch_add(p, v, __ATOMIC_RELAXED, __HIP_MEMORY_SCOPE_AGENT); }
__device__ __forceinline__ unsigned xb_xcc_id() { return (unsigned)__builtin_amdgcn_s_getreg((3 << 11) | 20) & 0xFu; }
#define XB_SPIN(cond, bar) do { unsigned _sp = 0; while (cond) { __builtin_amdgcn_s_sleep(1); \
    if ((++_sp & 255u) == 0u) { if (xb_ld(&(bar)[XB_TMO])) break; if (_sp > XB_SPIN_CAP) { atomicAdd(&(bar)[XB_TMO], 1u); break; } } } } while (0)

struct XcdBarrier {
    unsigned* bar; unsigned x;
    volatile LAS unsigned* st;
};

__device__ __forceinline__ XcdBarrier xcd_barrier_post(unsigned* bar, volatile LAS unsigned* st) {
    XcdBarrier b; b.bar = bar; b.x = xb_xcc_id(); b.st = st;
    if (threadIdx.x == 0) (void)xb_add(&bar[XB_XCNT(b.x)], 1u);
    return b;
}
__device__ __forceinline__ void xcd_barrier_complete(unsigned* bar, unsigned x, unsigned& nloc, unsigned& nx) {
    const unsigned G = gridDim.x * gridDim.y * gridDim.z;
    unsigned sum, cnt, mine, sp = 0u;
    for (;;) {
        sum = 0u; cnt = 0u; mine = 0u;
#pragma unroll
        for (unsigned j = 0; j < 16; ++j) { const unsigned c = xb_ld(&bar[XB_XCNT(j)]); sum += c; cnt += (c > 0u) ? 1u : 0u; mine = (j == x) ? c : mine; }
        if (sum == G) break;
        __builtin_amdgcn_s_sleep(1);
        if ((++sp & 255u) == 0u) { if (xb_ld(&bar[XB_TMO])) break; if (sp > XB_SPIN_CAP) { atomicAdd(&bar[XB_TMO], 1u); break; } }
    }
    nloc = mine > 0u ? mine : 1u; nx = cnt > 0u ? cnt : 1u;
}

__device__ __forceinline__ void xcd_barrier(const XcdBarrier& b) {
    asm volatile("s_waitcnt vmcnt(0)" ::: "memory");
    __syncthreads();
    if (threadIdx.x == 0) {
        unsigned* bar = b.bar;
        __builtin_amdgcn_s_waitcnt(0);
        unsigned nloc = b.st[0], nx = b.st[1];
        if (nloc == 0u) { xcd_barrier_complete(bar, b.x, nloc, nx); b.st[0] = nloc; b.st[1] = nx; }
        const unsigned old = xb_add(&bar[XB_XSUB(b.x)], 1u);
        const unsigned gen = old / nloc;
        if (old + 1u == (gen + 1u) * nloc) {
            __builtin_amdgcn_fence(__ATOMIC_RELEASE, "agent");
            asm volatile("s_waitcnt vmcnt(0)" ::: "memory");
            const unsigned og = xb_add(&bar[XB_TOP], 1u);
            const unsigned tg = og / nx;
            if (og + 1u == (tg + 1u) * nx) xb_add(&bar[XB_TOPGEN], 1u);
            else XB_SPIN(xb_ld(&bar[XB_TOPGEN]) == tg, bar);
            __builtin_amdgcn_fence(__ATOMIC_ACQUIRE, "agent");
            xb_add(&bar[XB_XGEN(b.x)], 1u);
            asm volatile("s_waitcnt vmcnt(0)" ::: "memory");
        } else {
            XB_SPIN(xb_ld(&bar[XB_XGEN(b.x)]) == gen, bar);
            __builtin_amdgcn_fence(__ATOMIC_ACQUIRE, "agent");
            asm volatile("s_waitcnt vmcnt(0)" ::: "memory");
        }
    }
    __syncthreads();
}
namespace fk {
using namespace fc;
constexpr int NWAVES = 8, NTHR = 512;
constexpr size_t MiB = 1u << 20;
constexpr size_t WS_CTL = 0, CTL_ZERO_BYTES = 1 * MiB;
constexpr int CW_BAR = 4096;
constexpr size_t FB = 1536 * MiB;
constexpr size_t WS_WT_IN = FB + 0 * MiB;
constexpr size_t WS_W1R = FB + 6 * MiB;
constexpr size_t WS_WT_O = FB + 8 * MiB;
constexpr size_t WS_WT_F1 = FB + 10 * MiB;
constexpr size_t WS_WT_F2 = FB + 21 * MiB;
constexpr size_t WS_MODP = FB + 27 * MiB;
constexpr size_t WS_MODF = FB + 35 * MiB;
constexpr size_t WS_STATS = FB + 36 * MiB;
constexpr size_t WS_CBIAS = FB + 36 * MiB + 512 * 1024;
constexpr size_t WS_W2T = FB + 36 * MiB + 768 * 1024;
constexpr size_t WS_NARROW = FB + 37 * MiB;
constexpr size_t WS_U = FB + 42 * MiB;
constexpr size_t WS_ACMP = WS_U + (size_t)MP * 1024 * 2;
constexpr size_t WS_ZB = FB + 331 * MiB;
constexpr size_t WS_PCMP = FB + 429 * MiB;
constexpr size_t WS_KCVP = FB + 493 * MiB;
constexpr size_t WS_KCVS = FB + 494 * MiB;
constexpr size_t WS_KC = FB + 41 * MiB + 256 * 1024;
constexpr size_t WS_VTC = FB + 41 * MiB + 512 * 1024;
constexpr size_t WS_GLAS = FB + 526 * MiB;
constexpr size_t WS_GLAD = FB + 558 * MiB;
constexpr size_t WS_ATT = FB + 559 * MiB;
constexpr size_t WS_H1 = FB + 592 * MiB;
constexpr size_t WS_X1 = FB + 657 * MiB;
constexpr size_t WS_HM = FB + 722 * MiB;
constexpr size_t WS_VTS = FB + 812 * MiB;
constexpr size_t WS_VTW = FB + 816 * MiB;
constexpr size_t WS_END = FB + 820 * MiB;
constexpr int RING_OFF = 0, RING_BYTES = 131072, LDSCTL_OFF = RING_BYTES, MISC_OFF = LDSCTL_OFF + 320, LDS_BYTES = 147456;


struct Args { const void* in[28]; float* out; unsigned char* ws; int ph_lo, ph_hi, li, pad; };
struct Frame { LAS unsigned char* lds; gu32* ctl; int tid, lane, wave, vcu, G; };

template <int X> __device__ __forceinline__ float xor_f(float v) {
    if constexpr (X == 32) { auto rr = __builtin_amdgcn_permlane32_swap(__float_as_uint(v), __float_as_uint(v), false, false); const unsigned me = __float_as_uint(v); return __uint_as_float(rr[0] == me ? rr[1] : rr[0]); }
    else return __int_as_float(__builtin_amdgcn_ds_swizzle(__float_as_int(v), (X << 10) | 0x1f));
}
__device__ __forceinline__ float swap32_sum(float v) { auto rr = __builtin_amdgcn_permlane32_swap(__float_as_uint(v), __float_as_uint(v), false, false); return __uint_as_float(rr[0]) + __uint_as_float(rr[1]); }
__device__ __forceinline__ float swap32_max(float v) { auto rr = __builtin_amdgcn_permlane32_swap(__float_as_uint(v), __float_as_uint(v), false, false); return fmaxf(__uint_as_float(rr[0]), __uint_as_float(rr[1])); }
__device__ __forceinline__ float wave_sum(float v) { v += xor_f<1>(v); v += xor_f<2>(v); v += xor_f<4>(v); v += xor_f<8>(v); v += xor_f<16>(v); return swap32_sum(v); }
__device__ __forceinline__ float wave_max(float v) { v = fmaxf(v, xor_f<1>(v)); v = fmaxf(v, xor_f<2>(v)); v = fmaxf(v, xor_f<4>(v)); v = fmaxf(v, xor_f<8>(v)); v = fmaxf(v, xor_f<16>(v)); return swap32_max(v); }
__device__ __forceinline__ float silu_f(float x) { return x / (1.f + __expf(-x)); }
__device__ __forceinline__ int mod_row(int r) { return r < RP ? (r >> 11) : 8 + ((r - RP) >> 2); }

template <class SrcCol> __device__ __forceinline__ void transpose_item(const float* W, int K, int N, bf16* WT, int n0, int k0, LAS float* scr, int lane, SrcCol src) {
    const int sc = src(n0 + (lane & 31));
#pragma unroll 8
    for (int i = 0; i < 32; ++i) { const int kk = 2 * i + (lane >> 5); scr[kk * 33 + (lane & 31)] = sc >= 0 ? W[(size_t)(k0 + kk) * N + sc] : 0.f; }
    LDS_WAIT(); asm volatile("" ::: "memory");
    const int c = lane & 7;
#pragma unroll
    for (int j = 0; j < 4; ++j) { const int n = (lane >> 3) + 8 * j; const LAS float* s = scr + (8 * c) * 33 + n;
        v4u o; o.x = pk2(s[0 * 33], s[1 * 33]); o.y = pk2(s[2 * 33], s[3 * 33]); o.z = pk2(s[4 * 33], s[5 * 33]); o.w = pk2(s[6 * 33], s[7 * 33]);
        *(GAS v4u*)(WT + (size_t)(n0 + n) * K + k0 + 8 * c) = o; }
    LDS_WAIT(); asm volatile("" ::: "memory");
}
__device__ __forceinline__ int src_win(int n) { return n < 1024 ? n : (n < 2816 ? n + 16 : (n < 2832 ? 1024 + (n - 2816) : (n < 2856 ? n : -1))); }
__device__ __forceinline__ int src_f1(int n) { return ((n >> 7) & 1) * DFF + (n >> 8) * 128 + (n & 127); }

__device__ __forceinline__ void p0_prologue(Frame& F, const Args& a) {
    const float* w_in = (const float*)a.in[13]; const float* w_o = (const float*)a.in[21]; const float* w_f1 = (const float*)a.in[24]; const float* w_f2 = (const float*)a.in[25];
    const float* w1 = (const float*)a.in[18]; const float* b1 = (const float*)a.in[19]; const float* pe = (const float*)a.in[17];
    unsigned char* ws = a.ws;
    {
        LAS float* sl = (LAS float*)(F.lds + RING_OFF);
        const float* cp = (const float*)a.in[7]; const float* cs = (const float*)a.in[8]; const float* w_ada = (const float*)a.in[11];
        float* modp = (float*)(ws + WS_MODP);
        for (int j = blockIdx.x; j < 256; j += F.G) { const int cg = j & 31, kg = j >> 5;
            for (int i = F.tid; i < 40 * 128; i += NTHR) { const int r = i >> 7, k = i & 127; const float c = r < 8 ? cp[r * D + kg * 128 + k] : cs[(r - 8) * D + kg * 128 + k]; sl[i] = silu_f(c); }
            __syncthreads();
            float acc[40];
#pragma unroll
            for (int r = 0; r < 40; ++r) acc[r] = 0.f;
            const int col = F.tid % 192, kh = F.tid / 192;
            if (F.tid < 384) { const float* wp = w_ada + (size_t)(kg * 128 + kh * 64) * 6144 + cg * 192 + col;
                for (int k = 0; k < 64; ++k) { const float w = wp[(size_t)k * 6144];
#pragma unroll
                    for (int r = 0; r < 40; ++r) acc[r] += sl[r * 128 + kh * 64 + k] * w; } }
            __syncthreads();
            LAS float* cb = sl + 40 * 128;
            if (F.tid >= 192 && F.tid < 384) {
#pragma unroll
                for (int r = 0; r < 40; ++r) cb[r * 192 + col] = acc[r]; }
            __syncthreads();
            if (F.tid < 192) {
#pragma unroll
                for (int r = 0; r < 40; ++r) modp[((size_t)kg * 40 + r) * 6144 + cg * 192 + col] = acc[r] + cb[r * 192 + col]; }
            __syncthreads();
        }
    }
    LAS float* scr = (LAS float*)(F.lds + RING_OFF + F.wave * 16384);
    const int gw = F.vcu * NWAVES + F.wave, NGW = F.G * NWAVES;
    constexpr int I_IN = 16 * 96, I_O = 16 * 32, I_F1 = 16 * 176, I_F2 = 44 * 32, I_W1 = 4 * 16 * 4;
    constexpr int NITEMS = I_IN + I_O + I_F1 + I_F2 + I_W1;
    for (int it = gw; it < NITEMS; it += NGW) { int r = it;
        if (r < I_IN) { transpose_item(w_in, 1024, 2856, (bf16*)(ws + WS_WT_IN), (r % 96) * 32, (r / 96) * 64, scr, F.lane, [](int n) { return src_win(n); }); continue; } r -= I_IN;
        if (r < I_O) { transpose_item(w_o, 1024, 1024, (bf16*)(ws + WS_WT_O), (r % 32) * 32, (r / 32) * 64, scr, F.lane, [](int n) { return n; }); continue; } r -= I_O;
        if (r < I_F1) { transpose_item(w_f1, 1024, F1N, (bf16*)(ws + WS_WT_F1), (r % 176) * 32, (r / 176) * 64, scr, F.lane, [](int n) { return src_f1(n); }); continue; } r -= I_F1;
        if (r < I_F2) { transpose_item(w_f2, DFF, 1024, (bf16*)(ws + WS_WT_F2), (r % 32) * 32, (r / 32) * 64, scr, F.lane, [](int n) { return n; }); continue; } r -= I_F2;
        { const int cm = r >> 6, q = r & 63;
          transpose_item(w1 + (size_t)cm * 1024 * 128, 1024, 128, (bf16*)(ws + WS_W1R) + (size_t)cm * 128 * 1024, (q % 4) * 32, (q / 4) * 64, scr, F.lane, [](int n) { return n; }); }
    }
    { float* cbias = (float*)(ws + WS_CBIAS);
      for (int o = gw; o < 256; o += NGW) { const int c = o >> 7, hid = o & 127; float s = 0.f;
          for (int k = F.lane; k < 2048; k += 64) s += pe[((k >> 6) * 2 + c) * 64 + (k & 63)] * w1[((size_t)c * 2048 + k) * 128 + hid];
          s = wave_sum(s); if (F.lane == 0) cbias[o] = s + b1[o]; } }
    { const float* w2 = (const float*)a.in[20]; bf16* w2t = (bf16*)(ws + WS_W2T);
      for (int i = gw * 64 + F.lane; i < 16384; i += NGW * 64) { const int c = i >> 13, d = (i >> 7) & 63, hid = i & 127; w2t[i] = (bf16)f2bf(w2[((size_t)c * 128 + hid) * 64 + d]); } }
    { const float* cw = (const float*)a.in[5]; float* ow = a.out + O_WKS;
      for (int it = gw; it < 32 * 508; it += NGW) { const int b = it / 508, j = it % 508;
          *(GAS f32x4*)(ow + ((size_t)b * 512 + j) * 256 + F.lane * 4) = *(const GAS f32x4*)(cw + ((size_t)b * 512 + j + 4) * 256 + F.lane * 4); } }
    { const float* cc = (const float*)a.in[3]; const int* table = (const int*)a.in[6]; bf16* A = (bf16*)(ws + WS_ACMP);
      const int c = F.lane >> 5, g = (F.lane >> 4) & 1, d = (F.lane & 15) * 4;
      for (int it = gw; it < 32 * 128; it += NGW) { const int b = it >> 7, pg = it & 127; const float* src = cc + (size_t)table[it] * 128 * 256 + F.lane * 4;
          bf16* dst = A + (size_t)c * 65536 * 1024 + ((size_t)(b * 1024 + pg * 8) * 2 + g) * 1024 + d;
#pragma unroll 8
          for (int t = 0; t < 128; ++t) { const f32x4 v = *(const GAS f32x4*)(src + (size_t)t * 256);
              unsigned long long w = (unsigned long long)pk2(v.x, v.y) | ((unsigned long long)pk2(v.z, v.w) << 32);
              *(GAS unsigned long long*)(dst + (size_t)(t >> 4) * 2048 + (t & 15) * 64) = w; } } }
}
__device__ __forceinline__ void p1_ln_mod(Frame& F, const Args& a) {
    unsigned char* ws = a.ws; const float* modp = (const float*)(ws + WS_MODP); const float* b_ada = (const float*)a.in[12];
    const float* ln_g = (const float*)a.in[9]; const float* ln_b = (const float*)a.in[10];
    const int gw = F.vcu * NWAVES + F.wave, NGW = F.G * NWAVES;
    { float* modf = (float*)(ws + WS_MODF);
      for (int i = blockIdx.x * NTHR + F.tid; i < 40 * 6144; i += F.G * NTHR) { float s = b_ada[i % 6144];
#pragma unroll
          for (int kg = 0; kg < 8; ++kg) s += modp[(size_t)kg * 40 * 6144 + i];
          modf[i] = s; } }
    bf16* U = (bf16*)(ws + WS_U); float* stats = (float*)(ws + WS_STATS);
    for (int r = gw; r < R; r += NGW) {
        const float* xrow = r < RP ? (const float*)a.in[0] + (size_t)r * D : (const float*)a.in[1] + (size_t)(r - RP) * D;
        const GAS f32x4* xr = (const GAS f32x4*)xrow + F.lane;
        f32x4 v[4]; float s = 0.f;
#pragma unroll
        for (int j = 0; j < 4; ++j) { v[j] = xr[64 * j]; s += (v[j].x + v[j].y) + (v[j].z + v[j].w); }
        const float mean = wave_sum(s) * (1.f / D); float s2 = 0.f;
#pragma unroll
        for (int j = 0; j < 4; ++j) { v[j] = v[j] - mean; s2 += (v[j].x * v[j].x + v[j].y * v[j].y) + (v[j].z * v[j].z + v[j].w * v[j].w); }
        const float rstd = 1.f / sqrtf(wave_sum(s2) * (1.f / D) + 1e-5f);
        if (F.lane == 0) { stats[2 * r] = mean; stats[2 * r + 1] = rstd; }
        const int mr = mod_row(r);
        GAS unsigned long long* o8 = (GAS unsigned long long*)(U + (size_t)r * D) + F.lane;
#pragma unroll
        for (int j = 0; j < 4; ++j) { const int c = 256 * j + 4 * F.lane;
            f32x4 sh = *(const f32x4*)(b_ada + c), sc = *(const f32x4*)(b_ada + 1024 + c);
#pragma unroll
            for (int kg = 0; kg < 8; ++kg) { sh += *(const f32x4*)(modp + ((size_t)kg * 40 + mr) * 6144 + c); sc += *(const f32x4*)(modp + ((size_t)kg * 40 + mr) * 6144 + 1024 + c); }
            const f32x4 g = *(const f32x4*)(ln_g + c), bb = *(const f32x4*)(ln_b + c);
            const f32x4 y = (v[j] * rstd * g + bb) * (sc + 1.f) + sh;
            o8[64 * j] = (unsigned long long)pk2(y.x, y.y) | ((unsigned long long)pk2(y.z, y.w) << 32); }
    }
}


template <int WHICH> __device__ __forceinline__ void p_res_ln(Frame& F, const Args& a) {
    unsigned char* ws = a.ws; const float* modf = (const float*)(ws + WS_MODF); const float* stats = (const float*)(ws + WS_STATS);
    const float* mixb = (const float*)(ws + WS_H1); float* X1 = (float*)(ws + WS_X1); bf16* U = (bf16*)(ws + WS_U);
    const float* ln_g = (const float*)a.in[9]; const float* ln_b = (const float*)a.in[10];
    const float* lg = (const float*)a.in[WHICH == 0 ? 22 : 26]; const float* lb = (const float*)a.in[WHICH == 0 ? 23 : 27];
    const int gw = F.vcu * NWAVES + F.wave, NGW = F.G * NWAVES;
    for (int r = gw; r < R; r += NGW) {
        const int mr = mod_row(r); const float* mrow = modf + (size_t)mr * 6144;
        f32x4 v[4]; float s = 0.f;
        if (WHICH == 0) { const float* xrow = r < RP ? (const float*)a.in[0] + (size_t)r * D : (const float*)a.in[1] + (size_t)(r - RP) * D;
            const float mean = stats[2 * r], rstd = stats[2 * r + 1];
#pragma unroll
            for (int j = 0; j < 4; ++j) { const int c = 256 * j + 4 * F.lane; const f32x4 x = *(const GAS f32x4*)(xrow + c), m = *(const GAS f32x4*)(mixb + (size_t)r * D + c);
                const f32x4 xp = (x - mean) * rstd * *(const f32x4*)(ln_g + c) + *(const f32x4*)(ln_b + c);
                v[j] = xp * ALPHA + *(const f32x4*)(mrow + 2048 + c) * m; s += (v[j].x + v[j].y) + (v[j].z + v[j].w); } }
        else {
#pragma unroll
            for (int j = 0; j < 4; ++j) { const int c = 256 * j + 4 * F.lane; const f32x4 x1 = *(const GAS f32x4*)(X1 + (size_t)r * D + c), m = *(const GAS f32x4*)(mixb + (size_t)r * D + c);
                v[j] = x1 * ALPHA + *(const f32x4*)(mrow + 5120 + c) * m; s += (v[j].x + v[j].y) + (v[j].z + v[j].w); } }
        const float mean2 = wave_sum(s) * (1.f / D); float s2 = 0.f;
#pragma unroll
        for (int j = 0; j < 4; ++j) { v[j] = v[j] - mean2; s2 += (v[j].x * v[j].x + v[j].y * v[j].y) + (v[j].z * v[j].z + v[j].w * v[j].w); }
        const float rstd2 = 1.f / sqrtf(wave_sum(s2) * (1.f / D) + 1e-5f);
#pragma unroll
        for (int j = 0; j < 4; ++j) { const int c = 256 * j + 4 * F.lane; const f32x4 y = v[j] * rstd2 * *(const f32x4*)(lg + c) + *(const f32x4*)(lb + c);
            if (WHICH == 0) { *(GAS f32x4*)(X1 + (size_t)r * D + c) = y;
                const f32x4 u = y * (*(const f32x4*)(mrow + 4096 + c) + 1.f) + *(const f32x4*)(mrow + 3072 + c);
                *(GAS unsigned long long*)(U + (size_t)r * D + c) = (unsigned long long)pk2(u.x, u.y) | ((unsigned long long)pk2(u.z, u.w) << 32); }
            else { float* o = r < RP ? a.out + O_YP + (size_t)r * D : a.out + O_YS + (size_t)(r - RP) * D; *(GAS f32x4*)(o + c) = y; } }
    }
}


typedef float f32x4_ __attribute__((ext_vector_type(4)));
__device__ __forceinline__ float bf2f(unsigned short h) { return __uint_as_float((unsigned)h << 16); }
__device__ __forceinline__ float gelu_tanh(float x) { const float u = 0.7978845608028654f * (x + 0.044715f * x * x * x); const float e = __expf(2.f * u); return x * (1.f - 1.f / (e + 1.f)); }
__device__ __forceinline__ void cmp_post_sample(Frame& F, const Args& a) {
    unsigned char* ws = a.ws; const bf16* P = (const bf16*)(ws + WS_PCMP); const bf16* w2t = (const bf16*)(ws + WS_W2T); const float* cbias = (const float*)(ws + WS_CBIAS);
    float* kcvs = (float*)(ws + WS_KCVS);
    const int gw = F.vcu * NWAVES + F.wave, NGW = F.G * NWAVES, lr = F.lane & 15, quad = F.lane >> 4;
    for (int tile = gw; tile < 2 * 4092; tile += NGW) { const int c = tile / 4092, tt = tile % 4092;
        const int rho = tt * 16 + lr; const bool valid = rho < 65472; const int rc = valid ? rho : 65471;
        const int b = rc / 2046, rem = rc % 2046, n = rem >> 1, g = rem & 1;
        const bf16* p0 = P + (size_t)c * 65536 * 256 + ((size_t)(b * 1024 + n) * 2 + g) * 256; const bf16* p1 = p0 + 2 * 256 + 128;
        bf16x8 hf[4];
#pragma unroll
        for (int ks = 0; ks < 4; ++ks) { const int hid0 = 32 * ks + 8 * quad; const bf16x8 x0 = *(const bf16x8*)(p0 + hid0), x1 = *(const bf16x8*)(p1 + hid0);
            const f32x4 cb0 = *(const f32x4*)(cbias + c * 128 + hid0), cb1 = *(const f32x4*)(cbias + c * 128 + hid0 + 4); float h[8];
#pragma unroll
            for (int e = 0; e < 8; ++e) h[e] = gelu_tanh(bf2f((unsigned short)x0[e]) + bf2f((unsigned short)x1[e]) + (e < 4 ? cb0[e] : cb1[e - 4]));
            v4u w; w.x = pk2(h[0], h[1]); w.y = pk2(h[2], h[3]); w.z = pk2(h[4], h[5]); w.w = pk2(h[6], h[7]); hf[ks] = __builtin_bit_cast(bf16x8, w); }
#pragma unroll
        for (int nt = 0; nt < 4; ++nt) { f32x4 acc = {0.f, 0.f, 0.f, 0.f};
#pragma unroll
            for (int ks = 0; ks < 4; ++ks) { const bf16x8 wf = *(const bf16x8*)(w2t + ((size_t)c * 64 + 16 * nt + lr) * 128 + 32 * ks + 8 * quad);
                acc = __builtin_amdgcn_mfma_f32_16x16x32_bf16(wf, hf[ks], acc, 0, 0, 0); }
            if (valid) *(GAS f32x4*)(kcvs + (((size_t)b * 1023 + n) * 2 + c) * 128 + g * 64 + 16 * nt + 4 * quad) = acc; }
    }
}
__device__ __forceinline__ void cmp_prompt(Frame& F, const Args& a) {
    unsigned char* ws = a.ws; const bf16* ZB = (const bf16*)(ws + WS_ZB); const bf16* w1r = (const bf16*)(ws + WS_W1R); const bf16* w2t = (const bf16*)(ws + WS_W2T);
    const float* cbias = (const float*)(ws + WS_CBIAS); float* kcvp = (float*)(ws + WS_KCVP);
    LAS float* red = (LAS float*)(F.lds + RING_OFF);
    LAS bf16* H = (LAS bf16*)(F.lds + RING_OFF + 65536);
    const int lr = F.lane & 15, quad = F.lane >> 4;
    for (int unit = blockIdx.x; unit < 2 * 127; unit += F.G) { const int c = unit / 127, tt = unit % 127;
        const int rho = tt * 16 + lr; const int b = rho / 254, rem = rho % 254, n = rem >> 1, g = rem & 1;
        const bf16* arow = ZB + ((size_t)b * 2048 + 16 * n) * ZN + PZ_KVC + c * 128 + g * 64;
        f32x4 acc[8];
#pragma unroll
        for (int nt = 0; nt < 8; ++nt) acc[nt] = (f32x4){0.f, 0.f, 0.f, 0.f};
#pragma unroll 2
        for (int ks = 0; ks < 8; ++ks) { const int k = F.wave * 256 + ks * 32 + quad * 8;
            const bf16x8 af = *(const bf16x8*)(arow + (size_t)(k >> 6) * ZN + (k & 63));
            const bf16* wb = w1r + ((size_t)c * 256 + (k >> 10) * 128 + lr) * 1024 + (k & 1023);
#pragma unroll
            for (int nt = 0; nt < 8; ++nt) { const bf16x8 bf = *(const bf16x8*)(wb + (size_t)nt * 16 * 1024); acc[nt] = __builtin_amdgcn_mfma_f32_16x16x32_bf16(af, bf, acc[nt], 0, 0, 0); } }
#pragma unroll
        for (int nt = 0; nt < 8; ++nt)
#pragma unroll
            for (int e = 0; e < 4; ++e) red[(F.wave * 16 + 4 * quad + e) * 128 + 16 * nt + lr] = acc[nt][e];
        __syncthreads();
        { const int row = F.tid >> 5, h4 = (F.tid & 31) * 4; f32x4 s = *(const f32x4*)(cbias + c * 128 + h4);
#pragma unroll
          for (int w = 0; w < 8; ++w) s += *(const LAS f32x4*)(red + (w * 16 + row) * 128 + h4);
          *(LAS unsigned long long*)(H + row * 136 + h4) = (unsigned long long)pk2(gelu_tanh(s.x), gelu_tanh(s.y)) | ((unsigned long long)pk2(gelu_tanh(s.z), gelu_tanh(s.w)) << 32); }
        __syncthreads();
        if (F.wave < 4) { const int nt = F.wave; f32x4 o = {0.f, 0.f, 0.f, 0.f};
#pragma unroll
            for (int ks = 0; ks < 4; ++ks) { const bf16x8 wf = *(const bf16x8*)(w2t + ((size_t)c * 64 + 16 * nt + lr) * 128 + 32 * ks + 8 * quad);
                const bf16x8 hf = *(const LAS bf16x8*)(H + lr * 136 + 32 * ks + 8 * quad);
                o = __builtin_amdgcn_mfma_f32_16x16x32_bf16(wf, hf, o, 0, 0, 0); }
            *(GAS f32x4*)(kcvp + (((size_t)b * 127 + n) * 2 + c) * 128 + g * 64 + 16 * nt + 4 * quad) = o;
            const int d0 = 16 * nt + 4 * quad;
            if (c == 0) *(GAS unsigned long long*)((bf16*)(ws + WS_KC) + ((size_t)(b * 2 + g) * 128 + n) * 64 + d0) = (unsigned long long)pk2(o.x, o.y) | ((unsigned long long)pk2(o.z, o.w) << 32);
            else { bf16* vt = (bf16*)(ws + WS_VTC) + ((size_t)(b * 2 + g) * 64 + d0) * 128 + n; vt[0] = (bf16)f2bf(o.x); vt[128] = (bf16)f2bf(o.y); vt[256] = (bf16)f2bf(o.z); vt[384] = (bf16)f2bf(o.w); } }
        __syncthreads();
    }
    if (blockIdx.x == 0) for (int i = F.tid; i < 16 * 64; i += NTHR) { const int bg = i >> 6, d = i & 63; ((bf16*)(ws + WS_KC))[((size_t)bg * 128 + 127) * 64 + d] = 0; ((bf16*)(ws + WS_VTC))[((size_t)bg * 64 + d) * 128 + 127] = 0; }
}


__device__ __forceinline__ float logsig_f(float x) { return fminf(x, 0.f) - __logf(1.f + __expf(-fabsf(x))); }
__device__ __forceinline__ void gla_cumsum(Frame& F, const Args& a, int row0, int h, LAS float* Bc, LAS float* seg) {
    const float* narrow = (const float*)(a.ws + WS_NARROW); const float* w_a2 = (const float*)a.in[14]; const float* b_a = (const float*)a.in[15];
    { const int c = F.tid >> 3, dk0 = (F.tid & 7) * 8; const float* ar = narrow + (size_t)(row0 + c) * 64;
      const f32x4 a0 = *(const f32x4*)(ar), a1 = *(const f32x4*)(ar + 4), a2 = *(const f32x4*)(ar + 8), a3 = *(const f32x4*)(ar + 12);
      const float ag[16] = {a0.x, a0.y, a0.z, a0.w, a1.x, a1.y, a1.z, a1.w, a2.x, a2.y, a2.z, a2.w, a3.x, a3.y, a3.z, a3.w};
      f32x4 l0 = *(const f32x4*)(b_a + h * 64 + dk0), l1 = *(const f32x4*)(b_a + h * 64 + dk0 + 4);
#pragma unroll
      for (int r = 0; r < 16; ++r) { l0 += *(const f32x4*)(w_a2 + r * 256 + h * 64 + dk0) * ag[r]; l1 += *(const f32x4*)(w_a2 + r * 256 + h * 64 + dk0 + 4) * ag[r]; }
#pragma unroll
      for (int e = 0; e < 4; ++e) { Bc[c * 65 + dk0 + e] = logsig_f(l0[e]) * 0.0625f; Bc[c * 65 + dk0 + 4 + e] = logsig_f(l1[e]) * 0.0625f; } }
    __syncthreads();
    const int dk = F.tid & 63, sg = F.tid >> 6;
    { float run = 0.f;
#pragma unroll
      for (int i = 0; i < 8; ++i) { run += Bc[(sg * 8 + i) * 65 + dk]; Bc[(sg * 8 + i) * 65 + dk] = run; }
      seg[sg * 64 + dk] = run; }
    __syncthreads();
    { float off = 0.f;
#pragma unroll
      for (int s2 = 0; s2 < 8; ++s2) off += (s2 < sg) ? seg[s2 * 64 + dk] : 0.f;
#pragma unroll
      for (int i = 0; i < 8; ++i) Bc[(sg * 8 + i) * 65 + dk] += off; }
    __syncthreads();
}
__device__ __forceinline__ void gla_load_vt(Frame& F, const bf16* ZB, int row0, int h, LAS bf16* VT) {
#pragma unroll
    for (int q = 0; q < 2; ++q) { const int ch = F.tid + q * NTHR, c = ch >> 4, dv0 = (ch & 15) * 8;
        const bf16x8 vx = *(const bf16x8*)(ZB + (size_t)(row0 + c) * ZN + PZ_VG + h * 128 + dv0);
#pragma unroll
        for (int e = 0; e < 8; ++e) VT[(dv0 + e) * 72 + c] = (bf16)vx[e]; }
}
__device__ __forceinline__ void gla_a(Frame& F, const Args& a) {
    unsigned char* ws = a.ws; const bf16* ZB = (const bf16*)(ws + WS_ZB); float* glas = (float*)(ws + WS_GLAS); float* glad = (float*)(ws + WS_GLAD);
    LAS float* Bc = (LAS float*)(F.lds + RING_OFF); LAS float* seg = (LAS float*)(F.lds + RING_OFF + 16640);
    LAS bf16* KT = (LAS bf16*)(F.lds + RING_OFF + 18688); LAS bf16* VT = (LAS bf16*)(F.lds + RING_OFF + 73984);
    const int lr = F.lane & 15, quad = F.lane >> 4;
    for (int unit = blockIdx.x; unit < 1024; unit += F.G) { const int b = unit >> 7, h = (unit >> 5) & 3, n = unit & 31, row0 = b * 2048 + n * 64;
        gla_cumsum(F, a, row0, h, Bc, seg);
        { const int c = F.tid >> 3, dk0 = (F.tid & 7) * 8; const bf16x8 kx = *(const bf16x8*)(ZB + (size_t)(row0 + c) * ZN + PZ_KG + h * 64 + dk0);
#pragma unroll
          for (int e = 0; e < 8; ++e) KT[(dk0 + e) * 72 + c] = (bf16)f2bf(bf2f((unsigned short)kx[e]) * __expf(Bc[63 * 65 + dk0 + e] - Bc[c * 65 + dk0 + e])); }
        gla_load_vt(F, ZB, row0, h, VT);
        if (F.tid < 64) glad[(size_t)unit * 64 + F.tid] = __expf(Bc[63 * 65 + F.tid]);
        __syncthreads();
#pragma unroll
        for (int it = 0; it < 4; ++it) { f32x4 acc = {0.f, 0.f, 0.f, 0.f};
#pragma unroll
            for (int ks = 0; ks < 2; ++ks) { const bf16x8 af = *(const LAS bf16x8*)(KT + (16 * it + lr) * 72 + 32 * ks + 8 * quad), bf = *(const LAS bf16x8*)(VT + (16 * F.wave + lr) * 72 + 32 * ks + 8 * quad);
                acc = __builtin_amdgcn_mfma_f32_16x16x32_bf16(af, bf, acc, 0, 0, 0); }
            *(GAS f32x4*)(glas + ((size_t)unit * 128 + 16 * F.wave + lr) * 64 + 16 * it + 4 * quad) = acc; }
        __syncthreads();
    }
}
__device__ __forceinline__ void gla_scan(Frame& F, const Args& a) {
    float* glas = (float*)(a.ws + WS_GLAS); const float* glad = (const float*)(a.ws + WS_GLAD);
    for (int idx = blockIdx.x * NTHR + F.tid; idx < 32 * 8192; idx += F.G * NTHR) { const int bh = idx >> 13, rest = idx & 8191, dk = rest & 63, dv = rest >> 6;
        float kv[32], d[32];
#pragma unroll
        for (int n = 0; n < 32; ++n) { kv[n] = glas[((size_t)(bh * 32 + n)) * 8192 + rest]; d[n] = glad[(size_t)(bh * 32 + n) * 64 + dk]; }
        float S = 0.f;
#pragma unroll
        for (int n = 0; n < 32; ++n) { glas[((size_t)(bh * 32 + n)) * 8192 + rest] = S; S = d[n] * S + kv[n]; }
        a.out[O_GSP + ((size_t)bh * 64 + dk) * 128 + dv] = S; }
}
__device__ __forceinline__ void gla_c(Frame& F, const Args& a) {
    unsigned char* ws = a.ws; const bf16* ZB = (const bf16*)(ws + WS_ZB); const float* glas = (const float*)(ws + WS_GLAS); bf16* ATT = (bf16*)(ws + WS_ATT);
    const float* gamma = (const float*)a.in[16];
    LAS float* Bc = (LAS float*)(F.lds + RING_OFF); LAS float* seg = (LAS float*)(F.lds + RING_OFF + 16640);
    LAS bf16* QH = (LAS bf16*)(F.lds + RING_OFF + 18688); LAS bf16* KH = (LAS bf16*)(F.lds + RING_OFF + 27904); LAS bf16* QT = (LAS bf16*)(F.lds + RING_OFF + 37120);
    LAS bf16* AM = (LAS bf16*)(F.lds + RING_OFF + 46336); LAS bf16* ST = (LAS bf16*)(F.lds + RING_OFF + 55552); LAS bf16* VT = (LAS bf16*)(F.lds + RING_OFF + 73984);
    LAS float* ssq = (LAS float*)(F.lds + RING_OFF + 92416);
    const int lr = F.lane & 15, quad = F.lane >> 4;
    for (int unit = blockIdx.x; unit < 1024; unit += F.G) { const int b = unit >> 7, h = (unit >> 5) & 3, n = unit & 31, row0 = b * 2048 + n * 64;
        gla_cumsum(F, a, row0, h, Bc, seg);
        { const int c = F.tid >> 3, dk0 = (F.tid & 7) * 8; const bf16* zr = ZB + (size_t)(row0 + c) * ZN + h * 64 + dk0;
          const bf16x8 qx = *(const bf16x8*)(zr + PZ_QG), kx = *(const bf16x8*)(zr + PZ_KG); float qh[8], kh[8], qt[8];
#pragma unroll
          for (int e = 0; e < 8; ++e) { const float bc = Bc[c * 65 + dk0 + e], bm = Bc[31 * 65 + dk0 + e], q = bf2f((unsigned short)qx[e]), k = bf2f((unsigned short)kx[e]);
              qh[e] = q * __expf(bc - bm); kh[e] = k * __expf(bm - bc); qt[e] = q * __expf(bc); }
          v4u w; w.x = pk2(qh[0], qh[1]); w.y = pk2(qh[2], qh[3]); w.z = pk2(qh[4], qh[5]); w.w = pk2(qh[6], qh[7]); *(LAS v4u*)(QH + c * 72 + dk0) = w;
          w.x = pk2(kh[0], kh[1]); w.y = pk2(kh[2], kh[3]); w.z = pk2(kh[4], kh[5]); w.w = pk2(kh[6], kh[7]); *(LAS v4u*)(KH + c * 72 + dk0) = w;
          w.x = pk2(qt[0], qt[1]); w.y = pk2(qt[2], qt[3]); w.z = pk2(qt[4], qt[5]); w.w = pk2(qt[6], qt[7]); *(LAS v4u*)(QT + c * 72 + dk0) = w; }
#pragma unroll
        for (int q = 0; q < 2; ++q) { const int ch = F.tid + q * NTHR, dv = ch >> 3, dk0 = (ch & 7) * 8; const float* sp = glas + ((size_t)unit * 128 + dv) * 64 + dk0;
            const f32x4 s0 = *(const GAS f32x4*)sp, s1 = *(const GAS f32x4*)(sp + 4);
            v4u w; w.x = pk2(s0.x, s0.y); w.y = pk2(s0.z, s0.w); w.z = pk2(s1.x, s1.y); w.w = pk2(s1.z, s1.w); *(LAS v4u*)(ST + dv * 72 + dk0) = w; }
        gla_load_vt(F, ZB, row0, h, VT);
        __syncthreads();
        { const int it = F.wave >> 1;
#pragma unroll
          for (int jj = 0; jj < 2; ++jj) { const int jt = 2 * (F.wave & 1) + jj; f32x4 acc = {0.f, 0.f, 0.f, 0.f};
#pragma unroll
              for (int ks = 0; ks < 2; ++ks) { const bf16x8 af = *(const LAS bf16x8*)(QH + (16 * it + lr) * 72 + 32 * ks + 8 * quad), bf = *(const LAS bf16x8*)(KH + (16 * jt + lr) * 72 + 32 * ks + 8 * quad);
                  acc = __builtin_amdgcn_mfma_f32_16x16x32_bf16(af, bf, acc, 0, 0, 0); }
#pragma unroll
              for (int e = 0; e < 4; ++e) { const int i = 16 * it + 4 * quad + e, j = 16 * jt + lr; AM[i * 72 + j] = (bf16)f2bf(j <= i ? acc[e] : 0.f); } } }
        __syncthreads();
        { const int it = F.wave >> 1; f32x4 acc[4]; float sq = 0.f;
#pragma unroll
          for (int mm = 0; mm < 4; ++mm) { const int mt = 4 * (F.wave & 1) + mm; acc[mm] = (f32x4){0.f, 0.f, 0.f, 0.f};
#pragma unroll
              for (int ks = 0; ks < 2; ++ks) { const bf16x8 af = *(const LAS bf16x8*)(VT + (16 * mt + lr) * 72 + 32 * ks + 8 * quad), bf = *(const LAS bf16x8*)(AM + (16 * it + lr) * 72 + 32 * ks + 8 * quad);
                  acc[mm] = __builtin_amdgcn_mfma_f32_16x16x32_bf16(af, bf, acc[mm], 0, 0, 0); }
#pragma unroll
              for (int ks = 0; ks < 2; ++ks) { const bf16x8 af = *(const LAS bf16x8*)(ST + (16 * mt + lr) * 72 + 32 * ks + 8 * quad), bf = *(const LAS bf16x8*)(QT + (16 * it + lr) * 72 + 32 * ks + 8 * quad);
                  acc[mm] = __builtin_amdgcn_mfma_f32_16x16x32_bf16(af, bf, acc[mm], 0, 0, 0); }
              sq += (acc[mm].x * acc[mm].x + acc[mm].y * acc[mm].y) + (acc[mm].z * acc[mm].z + acc[mm].w * acc[mm].w); }
          sq += xor_f<16>(sq); sq = swap32_sum(sq);
          if (quad == 0) ssq[(F.wave & 1) * 64 + 16 * it + lr] = sq;
          __syncthreads();
          const int i = 16 * it + lr; const float rs = rsqrtf((ssq[i] + ssq[64 + i]) * (1.f / 128.f) + 1e-6f);
#pragma unroll
          for (int mm = 0; mm < 4; ++mm) { const int dv0 = 16 * (4 * (F.wave & 1) + mm) + 4 * quad; const f32x4 gm = *(const f32x4*)(gamma + dv0);
              const unsigned long long rgw = *(const GAS unsigned long long*)(ZB + (size_t)(row0 + i) * ZN + PZ_RG + h * 128 + dv0); float o[4];
#pragma unroll
              for (int e = 0; e < 4; ++e) { const float rg = bf2f((unsigned short)(rgw >> (16 * e))); o[e] = acc[mm][e] * rs * gm[e] * rg / (1.f + __expf(-rg)); }
              *(GAS unsigned long long*)(ATT + (size_t)(row0 + i) * 1024 + h * 128 + dv0) = (unsigned long long)pk2(o[0], o[1]) | ((unsigned long long)pk2(o[2], o[3]) << 32); } }
        __syncthreads();
    }
}
__device__ __forceinline__ void gla_sample(Frame& F, const Args& a) {
    unsigned char* ws = a.ws; const bf16* ZB = (const bf16*)(ws + WS_ZB); const float* narrow = (const float*)(ws + WS_NARROW); bf16* ATT = (bf16*)(ws + WS_ATT);
    const float* st0 = (const float*)a.in[2]; const float* w_a2 = (const float*)a.in[14]; const float* b_a = (const float*)a.in[15]; const float* gamma = (const float*)a.in[16];
    LAS float* par = (LAS float*)(F.lds + RING_OFF); LAS float* tot = (LAS float*)(F.lds + RING_OFF + 4096); LAS float* gk = (LAS float*)(F.lds + RING_OFF + 8192);
    const int dv = F.tid & 127, dq = F.tid >> 7;
    for (int unit = blockIdx.x; unit < 128; unit += F.G) { const int b = unit >> 2, h = unit & 3;
        float S[16];
#pragma unroll
        for (int e = 0; e < 16; ++e) S[e] = st0[((size_t)unit * 64 + dq * 16 + e) * 128 + dv];
        for (int t = 0; t < 4; ++t) { const size_t row = (size_t)RP + b * 4 + t;
            if (F.tid < 64) { const int dk = h * 64 + F.tid; const float* ar = narrow + row * 64; float lg = b_a[dk];
#pragma unroll
                for (int r = 0; r < 16; ++r) lg += ar[r] * w_a2[r * 256 + dk];
                gk[F.tid] = __expf(logsig_f(lg) * 0.0625f); gk[64 + F.tid] = bf2f(ZB[row * ZN + PZ_KG + dk]); gk[128 + F.tid] = bf2f(ZB[row * ZN + PZ_QG + dk]); }
            __syncthreads();
            const float vv = bf2f(ZB[row * ZN + PZ_VG + h * 128 + dv]); float op = 0.f;
#pragma unroll
            for (int e = 0; e < 16; ++e) { const int dl = dq * 16 + e; S[e] = gk[dl] * S[e] + gk[64 + dl] * vv; op += gk[128 + dl] * S[e]; }
            par[dq * 128 + dv] = op; __syncthreads();
            const float o = (par[dv] + par[128 + dv]) + (par[256 + dv] + par[384 + dv]);
            if (F.tid < 128) { const float q = wave_sum(o * o); if (F.lane == 0) tot[F.wave] = q; }
            __syncthreads();
            if (F.tid < 128) { const float rs = rsqrtf((tot[0] + tot[1]) * (1.f / 128.f) + 1e-6f); const float rg = bf2f(ZB[row * ZN + PZ_RG + h * 128 + dv]);
                ATT[row * 1024 + h * 128 + dv] = (bf16)f2bf(o * rs * gamma[dv] * rg / (1.f + __expf(-rg))); }
            __syncthreads(); }
#pragma unroll
        for (int e = 0; e < 16; ++e) a.out[O_GSS + ((size_t)unit * 64 + dq * 16 + e) * 128 + dv] = S[e];
    }
}


__device__ __forceinline__ void make_vt(Frame& F, const Args& a) {
    unsigned char* ws = a.ws; const bf16* ZB = (const bf16*)(ws + WS_ZB);
    LAS bf16* T = (LAS bf16*)(F.lds + RING_OFF + F.wave * 9216);
    const int gw = F.vcu * NWAVES + F.wave, NGW = F.G * NWAVES;
    for (int it = gw; it < 1024; it += NGW) { const int which = it >> 9, b = (it >> 6) & 7, g = (it >> 5) & 1, tile = it & 31;
        const bf16* src = ZB + ((size_t)b * 2048 + 64 * tile) * ZN + (which ? PZ_KVW : PZ_KVS) + 128 + g * 64;
        bf16* dst = (bf16*)(ws + (which ? WS_VTW : WS_VTS)) + ((size_t)(b * 2 + g) * 64) * 2048 + 64 * tile;
#pragma unroll
        for (int i = 0; i < 8; ++i) { const int ch = i * 64 + F.lane, tok = ch >> 3, c8 = ch & 7; const bf16x8 x = *(const bf16x8*)(src + (size_t)tok * ZN + c8 * 8);
#pragma unroll
            for (int e = 0; e < 8; ++e) T[(c8 * 8 + e) * 72 + tok] = (bf16)x[e]; }
        LDS_WAIT(); asm volatile("" ::: "memory");
#pragma unroll
        for (int i = 0; i < 8; ++i) { const int ch = i * 64 + F.lane, d = ch >> 3, c8 = ch & 7; *(GAS v4u*)(dst + (size_t)d * 2048 + c8 * 8) = *(const LAS v4u*)(T + d * 72 + c8 * 8); }
        LDS_WAIT(); asm volatile("" ::: "memory");
    }
}
typedef float f32x16 __attribute__((ext_vector_type(16)));
constexpr float L2E = 1.4426950408889634f, NEGB = -1.0e30f;
constexpr int A_K0 = 0, A_K1 = 9216, A_V0 = 18432, A_V1 = 27136, A_IMPH = 36864, A_IMPC = 70656, A_SC = 104448, A_MASK = 112896;
struct AttnSt { float m, l; f32x16 o0, o1; };
__device__ __forceinline__ unsigned bfpair(float lo, float hi) { return pk2(lo, hi); }
__device__ __forceinline__ void attn_tile(const LAS bf16* Kb, const LAS bf16* Vb, const bf16x8 (&qr)[4], AttnSt& st, int mode, int itok, bool on, int lane) {
    const int q = lane & 31, hi = lane >> 5;
    f32x16 p0, p1;
#pragma unroll
    for (int r = 0; r < 16; ++r) { p0[r] = 0.f; p1[r] = 0.f; }
#pragma unroll
    for (int ds = 0; ds < 4; ++ds) { const bf16x8 k0 = *(const LAS bf16x8*)(Kb + q * 72 + 16 * ds + 8 * hi), k1 = *(const LAS bf16x8*)(Kb + (q + 32) * 72 + 16 * ds + 8 * hi);
        p0 = __builtin_amdgcn_mfma_f32_32x32x16_bf16(k0, qr[ds], p0, 0, 0, 0); p1 = __builtin_amdgcn_mfma_f32_32x32x16_bf16(k1, qr[ds], p1, 0, 0, 0); __builtin_amdgcn_sched_barrier(0); }
    float mx = NEGB;
#pragma unroll
    for (int r = 0; r < 16; ++r) { const int kv = (r & 3) + 8 * (r >> 2) + 4 * hi;
        const bool ok0 = on && (mode == 0 || (mode == 1 ? kv <= itok : kv > itok)), ok1 = on && (mode == 0 || (mode == 1 ? kv + 32 <= itok : kv + 32 > itok));
        p0[r] = ok0 ? p0[r] * L2E : NEGB; p1[r] = ok1 ? p1[r] * L2E : NEGB; mx = fmaxf(mx, fmaxf(p0[r], p1[r])); }
    mx = swap32_max(mx);
    const float mn = fmaxf(st.m, mx), alpha = __builtin_amdgcn_exp2f(st.m - mn); st.m = mn;
    float sum = 0.f;
#pragma unroll
    for (int r = 0; r < 16; ++r) { p0[r] = __builtin_amdgcn_exp2f(p0[r] - mn); p1[r] = __builtin_amdgcn_exp2f(p1[r] - mn); sum += p0[r] + p1[r]; }
    st.l = st.l * alpha + sum;
    if (__any(alpha != 1.0f)) { st.o0 *= alpha; st.o1 *= alpha; }
    __builtin_amdgcn_sched_barrier(0);
    bf16x8 pf[4];
#pragma unroll
    for (int s = 0; s < 4; ++s) { const f32x16& p = (s < 2) ? p0 : p1; const int o = 8 * (s & 1);
        v4u w; w.x = bfpair(p[o], p[o + 1]); w.y = bfpair(p[o + 2], p[o + 3]); w.z = bfpair(p[o + 4], p[o + 5]); w.w = bfpair(p[o + 6], p[o + 7]); pf[s] = __builtin_bit_cast(bf16x8, w); }
    __builtin_amdgcn_sched_barrier(0);
#pragma unroll
    for (int s = 0; s < 4; ++s) {
        typedef unsigned long long u64; typedef u64 u64x2 __attribute__((ext_vector_type(2)));
        u64x2 va, vb; va.x = *(const LAS u64*)(Vb + q * 68 + 16 * s + 4 * hi); va.y = *(const LAS u64*)(Vb + q * 68 + 16 * s + 8 + 4 * hi);
        vb.x = *(const LAS u64*)(Vb + (q + 32) * 68 + 16 * s + 4 * hi); vb.y = *(const LAS u64*)(Vb + (q + 32) * 68 + 16 * s + 8 + 4 * hi);
        st.o0 = __builtin_amdgcn_mfma_f32_32x32x16_bf16(__builtin_bit_cast(bf16x8, va), pf[s], st.o0, 0, 0, 0);
        st.o1 = __builtin_amdgcn_mfma_f32_32x32x16_bf16(__builtin_bit_cast(bf16x8, vb), pf[s], st.o1, 0, 0, 0); __builtin_amdgcn_sched_barrier(0); }
}
struct TileRegs { v4u k, v; };
__device__ __forceinline__ void tile_fetch(TileRegs& t, const bf16* kbase, size_t kpitch, const bf16* vbase, size_t vpitch, int tid) {
    const int row = tid >> 3, c8 = tid & 7; t.k = *(const GAS v4u*)(kbase + (size_t)row * kpitch + c8 * 8); t.v = *(const GAS v4u*)(vbase + (size_t)row * vpitch + c8 * 8); }
__device__ __forceinline__ void tile_store(const TileRegs& t, LAS bf16* Kb, LAS bf16* Vb, int tid) {
    typedef unsigned long long u64; const int row = tid >> 3, c8 = tid & 7; *(LAS v4u*)(Kb + row * 72 + c8 * 8) = t.k;
    *(LAS u64*)(Vb + row * 68 + c8 * 8) = (u64)t.v.x | ((u64)t.v.y << 32); *(LAS u64*)(Vb + row * 68 + c8 * 8 + 4) = (u64)t.v.z | ((u64)t.v.w << 32); }

__device__ __forceinline__ void nsa_prompt_unit(Frame& F, const Args& a, int b, int g, int qb) {
    unsigned char* ws = a.ws; const bf16* ZB = (const bf16*)(ws + WS_ZB); const float* narrow = (const float*)(ws + WS_NARROW); bf16* ATT = (bf16*)(ws + WS_ATT);
    LAS bf16* KB0 = (LAS bf16*)(F.lds + RING_OFF + A_K0); LAS bf16* KB1 = (LAS bf16*)(F.lds + RING_OFF + A_K1); LAS bf16* VB0 = (LAS bf16*)(F.lds + RING_OFF + A_V0); LAS bf16* VB1 = (LAS bf16*)(F.lds + RING_OFF + A_V1);
    LAS float* IMPH = (LAS float*)(F.lds + RING_OFF + A_IMPH); LAS float* IMPC = (LAS float*)(F.lds + RING_OFF + A_IMPC); LAS float* SC = (LAS float*)(F.lds + RING_OFF + A_SC);
    LAS unsigned* MASK = (LAS unsigned*)(F.lds + RING_OFF + A_MASK);
    const int lane = F.lane, q = lane & 31, hi = lane >> 5, r = F.wave >> 1, th = F.wave & 1, itok = 32 * th + q, t0 = 64 * qb, t = t0 + itok, h = g * 4 + r;
    const size_t row = (size_t)b * 2048 + t;
    bf16x8 qr[4];
#pragma unroll
    for (int ds = 0; ds < 4; ++ds) qr[ds] = *(const bf16x8*)(ZB + row * ZN + PZ_QN + h * 64 + 16 * ds + 8 * hi);
    float gate[3];
#pragma unroll
    for (int br = 0; br < 3; ++br) { const float gx = narrow[row * 64 + 16 + h * 3 + br]; gate[br] = 1.f / (1.f + __expf(-gx)); }
    f32x16 oc0, oc1;
    LAS float* stg = (LAS float*)(F.lds + RING_OFF + A_IMPH) + F.wave * 2048 + lane;
    { const bf16* kc = (const bf16*)(ws + WS_KC) + (size_t)(b * 2 + g) * 128 * 64; const bf16* vtc = (const bf16*)(ws + WS_VTC) + (size_t)(b * 2 + g) * 64 * 128;
      TileRegs ta, tb; tile_fetch(ta, kc, 64, vtc, 128, F.tid); tile_fetch(tb, kc + 64 * 64, 64, vtc + 64, 128, F.tid);
      tile_store(ta, KB0, VB0, F.tid); tile_store(tb, KB1, VB1, F.tid);
      __syncthreads();
      f32x16 pa0, pa1, pb0, pb1;
#pragma unroll
      for (int rr = 0; rr < 16; ++rr) { pa0[rr] = 0.f; pa1[rr] = 0.f; pb0[rr] = 0.f; pb1[rr] = 0.f; }
#pragma unroll
      for (int ds = 0; ds < 4; ++ds) { const int ko = 16 * ds + 8 * hi;
          pa0 = __builtin_amdgcn_mfma_f32_32x32x16_bf16(*(const LAS bf16x8*)(KB0 + q * 72 + ko), qr[ds], pa0, 0, 0, 0); pa1 = __builtin_amdgcn_mfma_f32_32x32x16_bf16(*(const LAS bf16x8*)(KB0 + (q + 32) * 72 + ko), qr[ds], pa1, 0, 0, 0);
          pb0 = __builtin_amdgcn_mfma_f32_32x32x16_bf16(*(const LAS bf16x8*)(KB1 + q * 72 + ko), qr[ds], pb0, 0, 0, 0); pb1 = __builtin_amdgcn_mfma_f32_32x32x16_bf16(*(const LAS bf16x8*)(KB1 + (q + 32) * 72 + ko), qr[ds], pb1, 0, 0, 0); }
      const int nmax = t >= 31 ? ((t - 31) >> 4) : -1; float mx = NEGB;
#pragma unroll
      for (int rr = 0; rr < 16; ++rr) { const int kv = (rr & 3) + 8 * (rr >> 2) + 4 * hi;
          pa0[rr] = (kv <= nmax) ? pa0[rr] * L2E : NEGB; pa1[rr] = (kv + 32 <= nmax) ? pa1[rr] * L2E : NEGB; pb0[rr] = (kv + 64 <= nmax) ? pb0[rr] * L2E : NEGB; pb1[rr] = (kv + 96 <= nmax) ? pb1[rr] * L2E : NEGB;
          mx = fmaxf(fmaxf(mx, fmaxf(pa0[rr], pa1[rr])), fmaxf(pb0[rr], pb1[rr])); }
      mx = swap32_max(mx); float sum = 0.f;
#pragma unroll
      for (int rr = 0; rr < 16; ++rr) { const int kv = (rr & 3) + 8 * (rr >> 2) + 4 * hi;
          pa0[rr] = (kv <= nmax) ? __builtin_amdgcn_exp2f(pa0[rr] - mx) : 0.f; pa1[rr] = (kv + 32 <= nmax) ? __builtin_amdgcn_exp2f(pa1[rr] - mx) : 0.f;
          pb0[rr] = (kv + 64 <= nmax) ? __builtin_amdgcn_exp2f(pb0[rr] - mx) : 0.f; pb1[rr] = (kv + 96 <= nmax) ? __builtin_amdgcn_exp2f(pb1[rr] - mx) : 0.f;
          sum += (pa0[rr] + pa1[rr]) + (pb0[rr] + pb1[rr]); }
      sum = swap32_sum(sum); const float inv = sum > 0.f ? 1.f / sum : 0.f;
#pragma unroll
      for (int rr = 0; rr < 16; ++rr) { pa0[rr] *= inv; pa1[rr] *= inv; pb0[rr] *= inv; pb1[rr] *= inv; }
      { LAS float* ih = IMPH + (r * 64 + itok) * 33; LAS float* ic = IMPC + (r * 64 + itok) * 33;
        if (hi == 0) ic[0] = 0.f;
#pragma unroll
        for (int rg = 0; rg < 4; ++rg) {
            const int j0 = 2 * rg + hi;
            ih[j0] = (pa0[4 * rg] + pa0[4 * rg + 1]) + (pa0[4 * rg + 2] + pa0[4 * rg + 3]); ic[j0 + 1] = pa0[4 * rg + 3];
            ih[j0 + 8] = (pa1[4 * rg] + pa1[4 * rg + 1]) + (pa1[4 * rg + 2] + pa1[4 * rg + 3]); ic[j0 + 9] = pa1[4 * rg + 3];
            ih[j0 + 16] = (pb0[4 * rg] + pb0[4 * rg + 1]) + (pb0[4 * rg + 2] + pb0[4 * rg + 3]); ic[j0 + 17] = pb0[4 * rg + 3];
            ih[j0 + 24] = (pb1[4 * rg] + pb1[4 * rg + 1]) + (pb1[4 * rg + 2] + pb1[4 * rg + 3]); ic[j0 + 25] = pb1[4 * rg + 3]; } }
#pragma unroll
      for (int rr = 0; rr < 16; ++rr) { oc0[rr] = 0.f; oc1[rr] = 0.f; }
#pragma unroll
      for (int s = 0; s < 8; ++s) { const f32x16& p = (s < 2) ? pa0 : (s < 4) ? pa1 : (s < 6) ? pb0 : pb1; const int o = 8 * (s & 1); const LAS bf16* Vb = (s < 4) ? VB0 : VB1; const int sl = s & 3;
          v4u w; w.x = bfpair(p[o], p[o + 1]); w.y = bfpair(p[o + 2], p[o + 3]); w.z = bfpair(p[o + 4], p[o + 5]); w.w = bfpair(p[o + 6], p[o + 7]); const bf16x8 pf = __builtin_bit_cast(bf16x8, w);
          typedef unsigned long long u64; typedef u64 u64x2 __attribute__((ext_vector_type(2)));
          u64x2 va, vb; va.x = *(const LAS u64*)(Vb + q * 68 + 16 * sl + 4 * hi); va.y = *(const LAS u64*)(Vb + q * 68 + 16 * sl + 8 + 4 * hi);
          vb.x = *(const LAS u64*)(Vb + (q + 32) * 68 + 16 * sl + 4 * hi); vb.y = *(const LAS u64*)(Vb + (q + 32) * 68 + 16 * sl + 8 + 4 * hi);
          oc0 = __builtin_amdgcn_mfma_f32_32x32x16_bf16(__builtin_bit_cast(bf16x8, va), pf, oc0, 0, 0, 0); oc1 = __builtin_amdgcn_mfma_f32_32x32x16_bf16(__builtin_bit_cast(bf16x8, vb), pf, oc1, 0, 0, 0); }
      oc0 *= gate[0]; oc1 *= gate[0];
    }
    __syncthreads();
    if (qb >= 16) {
        const int tok = F.tid >> 3, jg = F.tid & 7;
#pragma unroll
        for (int e = 0; e < 4; ++e) { const int j = jg * 4 + e; float im = 0.f;
#pragma unroll
            for (int hh = 0; hh < 4; ++hh) im += IMPH[(hh * 64 + tok) * 33 + j] + IMPC[(hh * 64 + tok) * 33 + j];
            const bool forced = (j == 0) || (j == qb) || (j == qb - 1);
            SC[tok * 33 + j] = (j <= qb) ? im + (forced ? 1.0e4f : 0.f) : -INFINITY; }
        __syncthreads();
        unsigned bits = 0u;
#pragma unroll
        for (int e = 0; e < 4; ++e) { const int j = jg * 4 + e; const float sj = SC[tok * 33 + j]; int cnt = 0;
            for (int k = 0; k < 32; ++k) { const float sk = SC[tok * 33 + k]; cnt += (sk > sj || (sk == sj && k < j)) ? 1 : 0; }
            bits |= (cnt < 16 ? 1u : 0u) << j; }
        MASK[tok * 8 + jg] = bits;
        __syncthreads();
    }
    unsigned selmask = 0xffffffffu;
    if (qb >= 16) { const v4u m0 = *(const LAS v4u*)(MASK + itok * 8), m1 = *(const LAS v4u*)(MASK + itok * 8 + 4); selmask = (m0.x | m0.y) | (m0.z | m0.w) | (m1.x | m1.y) | (m1.z | m1.w); }
#pragma unroll
    for (int rr = 0; rr < 16; ++rr) { stg[rr * 64] = oc0[rr]; stg[(16 + rr) * 64] = oc1[rr]; }
    { AttnSt st; st.m = NEGB; st.l = 0.f;
#pragma unroll
      for (int rr = 0; rr < 16; ++rr) { st.o0[rr] = 0.f; st.o1[rr] = 0.f; }
      const bf16* kb = ZB + (size_t)b * 2048 * ZN + PZ_KVS + g * 64; const bf16* vb = (const bf16*)(ws + WS_VTS) + (size_t)(b * 2 + g) * 64 * 2048;
      TileRegs tr; tile_fetch(tr, kb, ZN, vb, 2048, F.tid);
      for (int j = 0; j <= qb; ++j) { LAS bf16* Kb = (j & 1) ? KB1 : KB0; LAS bf16* Vb = (j & 1) ? VB1 : VB0;
          tile_store(tr, Kb, Vb, F.tid); __syncthreads();
          if (j < qb) tile_fetch(tr, kb + (size_t)(j + 1) * 64 * ZN, ZN, vb + (j + 1) * 64, 2048, F.tid);
          attn_tile(Kb, Vb, qr, st, j == qb ? 1 : 0, itok, (selmask >> j) & 1u, lane); }
      const float l = swap32_sum(st.l), f = gate[1] / l;
#pragma unroll
      for (int rr = 0; rr < 16; ++rr) { stg[rr * 64] += st.o0[rr] * f; stg[(16 + rr) * 64] += st.o1[rr] * f; } }
    __syncthreads();
    { AttnSt st; st.m = NEGB; st.l = 0.f;
#pragma unroll
      for (int rr = 0; rr < 16; ++rr) { st.o0[rr] = 0.f; st.o1[rr] = 0.f; }
      const bf16* kb = ZB + (size_t)b * 2048 * ZN + PZ_KVW + g * 64; const bf16* vb = (const bf16*)(ws + WS_VTW) + (size_t)(b * 2 + g) * 64 * 2048;
      const int jlo = qb >= 8 ? qb - 8 : 0;
      TileRegs tr; tile_fetch(tr, kb + (size_t)qb * 64 * ZN, ZN, vb + qb * 64, 2048, F.tid);
      for (int j = qb, it = 0; j >= jlo; --j, ++it) { LAS bf16* Kb = (it & 1) ? KB1 : KB0; LAS bf16* Vb = (it & 1) ? VB1 : VB0;
          tile_store(tr, Kb, Vb, F.tid); __syncthreads();
          if (j > jlo) tile_fetch(tr, kb + (size_t)(j - 1) * 64 * ZN, ZN, vb + (j - 1) * 64, 2048, F.tid);
          attn_tile(Kb, Vb, qr, st, j == qb ? 1 : (j == qb - 8 ? 2 : 0), itok, true, lane); }
      const float l = swap32_sum(st.l), f = gate[2] / l;
#pragma unroll
      for (int rr = 0; rr < 16; ++rr) { oc0[rr] = stg[rr * 64] + st.o0[rr] * f; oc1[rr] = stg[(16 + rr) * 64] + st.o1[rr] * f; } }
    __syncthreads();
    { const f32x16& tot0 = oc0; const f32x16& tot1 = oc1; bf16* orow = ATT + row * 1024 + 512 + h * 64;
#pragma unroll
      for (int rg = 0; rg < 4; ++rg) { const int d0 = 8 * rg + 4 * hi;
          *(GAS unsigned long long*)(orow + d0) = (unsigned long long)pk2(tot0[4 * rg], tot0[4 * rg + 1]) | ((unsigned long long)pk2(tot0[4 * rg + 2], tot0[4 * rg + 3]) << 32);
          *(GAS unsigned long long*)(orow + 32 + d0) = (unsigned long long)pk2(tot1[4 * rg], tot1[4 * rg + 1]) | ((unsigned long long)pk2(tot1[4 * rg + 2], tot1[4 * rg + 3]) << 32); } }
}
__device__ __forceinline__ void nsa_prompt(Frame& F, const Args& a) {
    for (int v = blockIdx.x; v < 256; v += F.G) { const int bg = v >> 4, s = v & 15;
        nsa_prompt_unit(F, a, bg >> 1, bg & 1, 31 - s);
        nsa_prompt_unit(F, a, bg >> 1, bg & 1, s); }
}


template <class KP> __device__ __forceinline__ float attend512(Frame& F, int NK, KP kp, LAS float* sc, LAS unsigned long long* kptr, const LAS float* qs, LAS float* red, LAS float* po) {
    int i0 = F.tid; asm volatile("" : "+v"(i0));
    for (int i = i0; i < NK; i += NTHR) { const float* k = kp(i); kptr[i] = (unsigned long long)(uintptr_t)k;
        float s0 = NEGB, s1 = NEGB, s2 = NEGB, s3 = NEGB;
        if (k) { s0 = 0.f; s1 = 0.f; s2 = 0.f; s3 = 0.f;
#pragma unroll
            for (int c = 0; c < 16; ++c) { const f32x4 kv = *(const GAS f32x4*)(k + 4 * c);
                const f32x4 q0 = *(const LAS f32x4*)(qs + 4 * c), q1 = *(const LAS f32x4*)(qs + 64 + 4 * c), q2 = *(const LAS f32x4*)(qs + 128 + 4 * c), q3 = *(const LAS f32x4*)(qs + 192 + 4 * c);
                s0 += (kv.x * q0.x + kv.y * q0.y) + (kv.z * q0.z + kv.w * q0.w); s1 += (kv.x * q1.x + kv.y * q1.y) + (kv.z * q1.z + kv.w * q1.w);
                s2 += (kv.x * q2.x + kv.y * q2.y) + (kv.z * q2.z + kv.w * q2.w); s3 += (kv.x * q3.x + kv.y * q3.y) + (kv.z * q3.z + kv.w * q3.w); } }
        sc[i] = s0; sc[1024 + i] = s1; sc[2048 + i] = s2; sc[3072 + i] = s3; }
    __syncthreads();
    if (F.wave < 4) { LAS float* row = sc + F.wave * 1024; float m = NEGB;
        for (int i = F.lane; i < NK; i += 64) m = fmaxf(m, row[i]);
        m = wave_max(m);
        float sum = 0.f;
        for (int i = F.lane; i < NK; i += 64) { const float x = row[i]; const float e = (x > -1.0e29f) ? __expf(x - m) : 0.f; row[i] = e; sum += e; }
        sum = wave_sum(sum); const float inv = 1.f / fmaxf(sum, 1.0e-30f);
        for (int i = F.lane; i < NK; i += 64) row[i] *= inv; }
    __syncthreads();
    { const int r = F.tid >> 7, part = (F.tid >> 6) & 1, d = F.tid & 63; const LAS float* row = sc + r * 1024; float o = 0.f;
      for (int i = part; i < NK; i += 2) { const float p = row[i]; if (p != 0.f) { const float* k = (const float*)(uintptr_t)kptr[i]; o += p * k[128 + d]; } }
      po[(part * 4 + r) * 64 + d] = o; }
    __syncthreads();
    const float res = po[(F.tid >> 6 & 3) * 64 + (F.tid & 63)] + po[(4 + (F.tid >> 6 & 3)) * 64 + (F.tid & 63)];
    (void)red; return res;
}
__device__ __forceinline__ void nsa_sample(Frame& F, const Args& a) {
    unsigned char* ws = a.ws; const bf16* ZB = (const bf16*)(ws + WS_ZB); const float* narrow = (const float*)(ws + WS_NARROW); bf16* ATT = (bf16*)(ws + WS_ATT);
    const float* kcvs = (const float*)(ws + WS_KCVS); const float* cslc = (const float*)a.in[4]; const float* cwin = (const float*)a.in[5]; const int* table = (const int*)a.in[6];
    LAS float* sc = (LAS float*)(F.lds + RING_OFF); LAS unsigned long long* kptr = (LAS unsigned long long*)(F.lds + RING_OFF + 16384); LAS float* qs = (LAS float*)(F.lds + RING_OFF + 24576);
    LAS float* score = (LAS float*)(F.lds + RING_OFF + 25600); LAS unsigned* flag = (LAS unsigned*)(F.lds + RING_OFF + 26656); LAS int* sel = (LAS int*)(F.lds + RING_OFF + 27712);
    LAS float* red = (LAS float*)(F.lds + RING_OFF + 27776); LAS float* po = (LAS float*)(F.lds + RING_OFF + 28032);
    for (int unit = blockIdx.x; unit < 256; unit += F.G) { const int b = unit >> 3, g = (unit >> 2) & 1, s = unit & 3, tq = 16384 + s; const size_t row = (size_t)RP + b * 4 + s;
        if (F.tid < 256) qs[F.tid] = bf2f(ZB[row * ZN + PZ_QN + (g * 4 + (F.tid >> 6)) * 64 + (F.tid & 63)]);
        __syncthreads();
        const float* kc = kcvs + (size_t)b * 1023 * 256 + g * 64;
        const float oc = attend512(F, 1023, [&](int i) -> const float* { return kc + (size_t)i * 256; }, sc, kptr, qs, red, po);
        for (int j = F.tid; j < 257; j += NTHR) { float im = 0.f;
            for (int i = 4 * j - 1; i <= 4 * j + 3; ++i) if (i >= 0 && i < 1023) im += (sc[i] + sc[1024 + i]) + (sc[2048 + i] + sc[3072 + i]);
            score[j] = im + ((j == 0 || j >= 255) ? 1.0e4f : 0.f); }
        __syncthreads();
        for (int j = F.tid; j < 257; j += NTHR) { const float sj = score[j]; int cnt = 0;
            for (int k = 0; k < 257; ++k) { const float sk = score[k]; cnt += (sk > sj || (sk == sj && k < j)) ? 1 : 0; }
            flag[j] = cnt < 16 ? 1u : 0u; }
        __syncthreads();
        for (int j = F.tid; j < 257; j += NTHR) if (flag[j]) { int pos = 0; for (int k = 0; k < j; ++k) pos += (int)flag[k]; sel[pos] = j; }
        __syncthreads();
        const float os = attend512(F, 1024, [&](int i) -> const float* { const int pos = sel[i >> 6] * 64 + (i & 63); if (pos > tq) return nullptr;
            if (pos < 16384) return cslc + ((size_t)table[b * 128 + (pos >> 7)] * 128 + (pos & 127)) * 256 + g * 64;
            return a.out + O_SKS + (size_t)(b * 4 + (pos - 16384)) * 256 + g * 64; }, sc, kptr, qs, red, po);
        const float ow = attend512(F, 516, [&](int i) -> const float* { const int tw = 15872 + i; if (tw > tq || tw <= tq - 512) return nullptr;
            return i < 512 ? cwin + ((size_t)b * 512 + i) * 256 + g * 64 : a.out + O_WKS + ((size_t)b * 512 + 508 + (i - 512)) * 256 + g * 64; }, sc, kptr, qs, red, po);
        if (F.tid < 256) { const int h = g * 4 + (F.tid >> 6), d = F.tid & 63; const float* gn = narrow + row * 64 + 16 + h * 3;
            const float o = oc / (1.f + __expf(-gn[0])) + os / (1.f + __expf(-gn[1])) + ow / (1.f + __expf(-gn[2]));
            ATT[row * 1024 + 512 + h * 64 + d] = (bf16)f2bf(o); }
        __syncthreads();
    }
}

__global__ void __launch_bounds__(NTHR, 2) mega(Args args) {
    extern __shared__ __attribute__((aligned(16))) unsigned char lds[];
    Frame F; F.lds = (LAS unsigned char*)lds; F.tid = threadIdx.x; F.lane = F.tid & 63; F.wave = __builtin_amdgcn_readfirstlane(F.tid >> 6);
    F.G = gridDim.x; { const int bx = blockIdx.x; F.vcu = (F.G % 8 == 0) ? (bx % 8) * (F.G / 8) + bx / 8 : bx; }
    unsigned char* ws = args.ws; F.ctl = (gu32*)(ws + WS_CTL);
    for (int u = F.tid; u < (LDS_BYTES - LDSCTL_OFF) / 4; u += NTHR) ((LAS unsigned*)(F.lds + LDSCTL_OFF))[u] = 0u;
    __syncthreads();
    const int lo = args.ph_lo, hi = args.ph_hi;
    const bool multi = (hi - lo) > 1;
    unsigned* barw = (unsigned*)(F.ctl + CW_BAR) + args.li * XCD_BAR_WORDS;
    XcdBarrier bar; bar.bar = barw; bar.x = 0; bar.st = nullptr;
    if (multi) bar = xcd_barrier_post(barw, (volatile LAS unsigned*)(F.lds + MISC_OFF) + 8);
#define IN(k) (lo <= (k) && (k) < hi)
#define SEAM(k) do { if (IN(k) && IN((k) + 1)) xcd_barrier(bar); } while (0)
    if (IN(0)) { p0_prologue(F, args); } SEAM(0);
    if (IN(1)) { p1_ln_mod(F, args); } SEAM(1);
    if (IN(2)) { pg8::Gemm g{(const pg8::bf16_t*)(ws + WS_U), (const pg8::bf16_t*)(ws + WS_WT_IN), MP, ZN, 1024}; pg8::ComboOrder S; S.init(F.G, (int)blockIdx.x);
        pg8::EpiZ E{(pg8::bf16_t*)(ws + WS_ZB), args.out, (float*)(ws + WS_NARROW), (pg8::bf16_t*)(ws + WS_PCMP)};
        pg8::gemm_phase<pg8::EpiZ, pg8::ComboOrder, true, true>(F.lds + RING_OFF, g, S, E); } SEAM(2);
    if (IN(3)) { cmp_post_sample(F, args); cmp_prompt(F, args); gla_a(F, args); make_vt(F, args); } SEAM(3);
    if (IN(4)) { gla_scan(F, args); } SEAM(4);
    if (IN(5)) { nsa_prompt(F, args); gla_c(F, args); gla_sample(F, args); nsa_sample(F, args); } SEAM(5);
    if (IN(6)) { pg8::Gemm g{(const pg8::bf16_t*)(ws + WS_ATT), (const pg8::bf16_t*)(ws + WS_WT_O), MP, 1024, 1024}; pg8::StaticOrder S; S.init(MP, 1024, F.G, (int)blockIdx.x);
        pg8::EpiF32 E{(float*)(ws + WS_H1), 1024};
        pg8::gemm_phase<pg8::EpiF32, pg8::StaticOrder, true, true>(F.lds + RING_OFF, g, S, E); } SEAM(6);
    if (IN(7)) { p_res_ln<0>(F, args); } SEAM(7);
    if (IN(8)) { pg8::Gemm g{(const pg8::bf16_t*)(ws + WS_U), (const pg8::bf16_t*)(ws + WS_WT_F1), MP, F1N, 1024}; pg8::StaticOrder S; S.init(MP, F1N, F.G, (int)blockIdx.x);
        pg8::EpiSwiglu E{(pg8::bf16_t*)(ws + WS_HM)};
        pg8::gemm_phase<pg8::EpiSwiglu, pg8::StaticOrder, true, true>(F.lds + RING_OFF, g, S, E); } SEAM(8);
    if (IN(9)) { pg8::Gemm g{(const pg8::bf16_t*)(ws + WS_HM), (const pg8::bf16_t*)(ws + WS_WT_F2), MP, 1024, DFF}; pg8::StaticOrder S; S.init(MP, 1024, F.G, (int)blockIdx.x);
        pg8::EpiF32 E{(float*)(ws + WS_H1), 1024};
        pg8::gemm_phase<pg8::EpiF32, pg8::StaticOrder, true, true>(F.lds + RING_OFF, g, S, E); } SEAM(9);
    if (IN(10)) { p_res_ln<1>(F, args); }
#undef IN
#undef SEAM
}

__global__ void glue_z(const unsigned short* ZB, const float* narrow, float* Z) {
    const int r = blockIdx.x;
    for (int c = threadIdx.x; c < 2856; c += 256) { float v;
        if (c >= 1024 && c < 1040) v = narrow[(size_t)r * 64 + (c - 1024)];
        else if (c >= 2832) v = narrow[(size_t)r * 64 + 16 + (c - 2832)];
        else { const int pc = c < 1024 ? c : c - 16; v = __uint_as_float((unsigned)ZB[(size_t)r * ZN + pc] << 16); if (pc < 256 || (pc >= 1536 && pc < 2048)) v *= 8.f; }
        Z[(size_t)r * 2856 + c] = v; }
}
__global__ void glue_att(const float* ATT, unsigned short* ATTB) {
    const int r = RP + blockIdx.x; for (int c = 512 + threadIdx.x; c < 1024; c += 256) ATTB[(size_t)r * 1024 + c] = (unsigned short)f2bf(ATT[(size_t)r * 1024 + c]);
}
}
#ifndef MK_SPLIT
#define MK_SPLIT 0
#endif
static int g_grid = 0;
extern "C" void kernel_launch(void* const* d_in, const int* in_sizes, int n_in, void* d_out, int out_size, void* d_ws, size_t ws_size, hipStream_t stream) {
    (void)in_sizes; (void)n_in; (void)out_size; (void)ws_size;
    if (!g_grid) { int dev = 0, cus = 0; (void)hipGetDevice(&dev); (void)hipDeviceGetAttribute(&cus, hipDeviceAttributeMultiprocessorCount, dev);
        (void)hipFuncSetAttribute((const void*)fk::mega, hipFuncAttributeMaxDynamicSharedMemorySize, fk::LDS_BYTES); g_grid = cus > 0 ? cus : 256; }
    (void)hipMemsetAsync((char*)d_ws + fk::WS_CTL, 0, fk::CTL_ZERO_BYTES, stream);
    fk::Args a{}; for (int i = 0; i < 28; ++i) a.in[i] = d_in[i]; a.out = (float*)d_out; a.ws = (unsigned char*)d_ws;
#if MK_SPLIT
    for (int p = 0; p <= 10; ++p) { a.ph_lo = p; a.ph_hi = p + 1; a.li = 0; hipLaunchKernelGGL(fk::mega, dim3(g_grid), dim3(fk::NTHR), fk::LDS_BYTES, stream, a); }
#else
    a.ph_lo = 0; a.ph_hi = 11; a.li = 0; hipLaunchKernelGGL(fk::mega, dim3(g_grid), dim3(fk::NTHR), fk::LDS_BYTES, stream, a);
#endif
}
```

```cpp
#include <hip/hip_runtime.h>
#include <cstdio>
#include <cstdint>
#include <cmath>
namespace fc {
constexpr int D = 1024, RP = 16384, RS = 128, R = RP + RS, MP = 16640;
constexpr int ZN = 3072;
constexpr int PZ_QG = 0, PZ_KG = 256, PZ_VG = 512, PZ_RG = 1024, PZ_QN = 1536, PZ_KVC = 2048, PZ_KVS = 2304, PZ_KVW = 2560, PZ_AG = 2816, PZ_GN = 2832;
constexpr int DFF = 2816, F1N = 5632;
constexpr float ALPHA = 1.189207115002721f;
constexpr long O_YP = 0, O_YS = 16777216, O_GSP = 16908288, O_GSS = 17170432, O_CKP = 18219008, O_CKS = 22413312, O_SKP = 22446080, O_SKS = 26640384,
               O_WKP = 26673152, O_WKS = 27721728, O_END = 31916032;
}
namespace pg8 {
#define PG8_LAS __attribute__((address_space(3)))
typedef unsigned short bf16_t;
typedef short bf16x8 __attribute__((ext_vector_type(8)));
typedef float f32x4 __attribute__((ext_vector_type(4)));
typedef unsigned u32x4 __attribute__((ext_vector_type(4)));
constexpr int BM = 256, BK = 64, HALF = 128, HTB = HALF * BK * 2  , STAGE_BYTES = 8 * HTB, NXCD = 8, WGM = 8;

__host__ __device__ __forceinline__ int lds_byte(int r, int c) { const int st = (r >> 4) * 2 + (c >> 5), rr = r & 15, cc = c & 31, ob = rr * 64 + cc * 2; return st * 1024 + (ob ^ (((ob >> 9) & 1) << 5)); }
__host__ __device__ __forceinline__ void stage_rc(int b, int& R, int& C) { const int st = b / 1024, sb = b % 1024, swz = sb ^ (((sb >> 9) & 1) << 5); R = (st >> 1) * 16 + swz / 64; C = (st & 1) * 32 + (swz % 64) / 2; }
__host__ __device__ __forceinline__ int perm32(int rho) { const int n = rho >> 4, i = rho & 15; return 8 * (i >> 2) + 4 * n + (i & 3); }

struct Unit { int pm, pn; };
struct Gemm { const bf16_t* A; const bf16_t* Bt; int M, N, K; };

struct StaticOrder {
    int nM, nN, nwg, G, c;
    __host__ __device__ void init(int M, int N, int G_, int c_) { nM = M / BM; nN = N / BM; nwg = nM * nN; G = G_; c = c_; }
    __host__ __device__ bool next(int i, Unit& u) const {
        const long L = (long)i * G + c; if (L >= nwg) return false;
        int wgid = (int)L; { const int q = nwg / NXCD, r = nwg % NXCD, xcd = wgid % NXCD, off = wgid / NXCD; wgid = (xcd < r ? xcd * (q + 1) : r * (q + 1) + (xcd - r) * q) + off; }
        const int nig = WGM * nN, gid = wgid / nig, fm = gid * WGM, gsz = (nM - fm) < WGM ? (nM - fm) : WGM;
        u.pm = fm + ((wgid % nig) % gsz); u.pn = (wgid % nig) / gsz; return true;
    }
    __device__ __forceinline__ void a_ready(const Unit&) const {}
    __device__ __forceinline__ void done(const Unit&) const {}
};

__device__ __forceinline__ unsigned cvt_pk_bf16(float lo, float hi) { unsigned r; asm volatile("v_cvt_pk_bf16_f32 %0, %1, %2" : "=v"(r) : "v"(lo), "v"(hi)); return r; }
typedef float f32x2 __attribute__((ext_vector_type(2)));
__device__ __forceinline__ f32x2 gelu_pk(f32x2 v) {
    const f32x2 av = __builtin_elementwise_abs(v), d = av * 0.2316418882f + 1.0f;
    f32x2 t; t.x = __builtin_amdgcn_rcpf(d.x); t.y = __builtin_amdgcn_rcpf(d.y);
    f32x2 q = t * 0.5307027145f + (-0.7265760135f); q = q * t + 0.7107068705f; q = q * t + (-0.142248368f); q = q * t + 0.127414796f; q = q * t;
    const f32x2 s = (v * v) * (-0.72134752044f);
    f32x2 e; e.x = __builtin_amdgcn_exp2f(s.x); e.y = __builtin_amdgcn_exp2f(s.y);
    const f32x2 m = v * (q * e), r = v - m;
    f32x2 o; o.x = v.x < 0.f ? m.x : r.x; o.y = v.y < 0.f ? m.y : r.y; return o;
}

template <int ACT  > struct EpiBf16 {
    static constexpr bool PERM = true, AFTER_DRAIN = false; static_assert(ACT == 0 || ACT == 1, "EpiBf16: ACT is 0 (none) or 1 (gelu_pk)");
    bf16_t* O; int ldc; const float* bias; int split_cols; size_t split_stride; float scale0;
    __device__ __forceinline__ void operator()(const f32x4 (&acc)[2][2][4][2], const Unit& u, int wr, int wc, int fr, int fq) const {
        const int row0 = u.pm * BM + wr * 64 + fr; int colt = u.pn * BM; bf16_t* base = O;
        float sc = 1.f; if (split_cols) { const int t = colt / split_cols; base += (size_t)t * split_stride; colt -= t * split_cols; if (t == 0) sc = scale0; }
        const int col0 = colt + wc * 32 + 8 * fq, bcol0 = u.pn * BM + wc * 32 + 8 * fq;
        f32x4 bv[2][2];
#pragma unroll
        for (int bj = 0; bj < 2; ++bj)
#pragma unroll
            for (int n = 0; n < 2; ++n) bv[bj][n] = bias ? *(const f32x4*)(bias + bcol0 + bj * HALF + 4 * n) : (f32x4){0.f, 0.f, 0.f, 0.f};
#pragma unroll
        for (int ai = 0; ai < 2; ++ai)
#pragma unroll
            for (int m = 0; m < 4; ++m) { bf16_t* rowp = base + (size_t)(row0 + ai * HALF + m * 16) * ldc + col0;
#pragma unroll
                for (int bj = 0; bj < 2; ++bj) { f32x4 v0 = acc[ai][bj][m][0] + bv[bj][0], v1 = acc[ai][bj][m][1] + bv[bj][1];
                    if (ACT == 1) { f32x2 a = gelu_pk((f32x2){v0[0], v0[1]}), b = gelu_pk((f32x2){v0[2], v0[3]}), c = gelu_pk((f32x2){v1[0], v1[1]}), d = gelu_pk((f32x2){v1[2], v1[3]});
                        v0 = (f32x4){a.x, a.y, b.x, b.y}; v1 = (f32x4){c.x, c.y, d.x, d.y}; }
                    v0 = v0 * sc; v1 = v1 * sc; u32x4 w; w.x = cvt_pk_bf16(v0[0], v0[1]); w.y = cvt_pk_bf16(v0[2], v0[3]); w.z = cvt_pk_bf16(v1[0], v1[1]); w.w = cvt_pk_bf16(v1[2], v1[3]);
                    *(u32x4*)(rowp + bj * HALF) = w; } }
    }
};
struct EpiZ {
    static constexpr bool PERM = true, AFTER_DRAIN = false;
    bf16_t* ZB; float* out; float* narrow; bf16_t* pcmp;
    __device__ __forceinline__ void operator()(const f32x4 (&acc)[2][2][4][2], const Unit& u, int wr, int wc, int fr, int fq) const {
        const int pn = u.pn; const float sc = (pn == 0 || pn == 6 || pn == 7) ? 0.125f : 1.0f;
        const int row0 = u.pm * BM + wr * 64 + fr, cc0 = wc * 32 + 8 * fq;
        if (pn >= 12) {
            const int c = pn - 12; bf16_t* base = pcmp + (size_t)c * 65536 * 256 + ((size_t)(u.pm - 65 - 256 * c) * BM + wr * 64 + fr) * 256 + cc0;
#pragma unroll
            for (int ai = 0; ai < 2; ++ai)
#pragma unroll
                for (int m = 0; m < 4; ++m)
#pragma unroll
                    for (int bj = 0; bj < 2; ++bj) { const f32x4 v0 = acc[ai][bj][m][0], v1 = acc[ai][bj][m][1];
                        u32x4 w; w.x = cvt_pk_bf16(v0[0], v0[1]); w.y = cvt_pk_bf16(v0[2], v0[3]); w.z = cvt_pk_bf16(v1[0], v1[1]); w.w = cvt_pk_bf16(v1[2], v1[3]);
                        *(u32x4*)(base + (size_t)(ai * HALF + m * 16) * 256 + bj * HALF) = w; }
            return; }
#pragma unroll
        for (int ai = 0; ai < 2; ++ai)
#pragma unroll
            for (int m = 0; m < 4; ++m) { const int row = row0 + ai * HALF + m * 16; bf16_t* rowp = ZB + (size_t)row * fc::ZN + pn * BM + cc0;
                float* fdst = nullptr;
                if (pn >= 8 && pn <= 10 && row < fc::R) {
                    if (row < fc::RP) { const int b = row >> 11, t = row & 2047;
                        if (pn == 8) fdst = out + fc::O_CKP + (size_t)row * 256; else if (pn == 9) fdst = out + fc::O_SKP + (size_t)row * 256;
                        else if (t >= 1536) fdst = out + fc::O_WKP + ((size_t)b * 512 + (t - 1536)) * 256; }
                    else { const int rr = row - fc::RP;
                        if (pn == 8) fdst = out + fc::O_CKS + (size_t)rr * 256; else if (pn == 9) fdst = out + fc::O_SKS + (size_t)rr * 256;
                        else fdst = out + fc::O_WKS + ((size_t)(rr >> 2) * 512 + 508 + (rr & 3)) * 256; } }
#pragma unroll
                for (int bj = 0; bj < 2; ++bj) { const f32x4 v0 = acc[ai][bj][m][0] * sc, v1 = acc[ai][bj][m][1] * sc;
                    u32x4 w; w.x = cvt_pk_bf16(v0[0], v0[1]); w.y = cvt_pk_bf16(v0[2], v0[3]); w.z = cvt_pk_bf16(v1[0], v1[1]); w.w = cvt_pk_bf16(v1[2], v1[3]);
                    *(u32x4*)(rowp + bj * HALF) = w;
                    if (fdst) { *(f32x4*)(fdst + cc0 + bj * HALF) = v0; *(f32x4*)(fdst + cc0 + bj * HALF + 4) = v1; }
                    if (pn == 11 && bj == 0 && cc0 < 64) { *(f32x4*)(narrow + (size_t)row * 64 + cc0) = v0; *(f32x4*)(narrow + (size_t)row * 64 + cc0 + 4) = v1; } } }
    }
};
struct EpiF32 {
    static constexpr bool PERM = false, AFTER_DRAIN = false;
    float* O; int ldc;
    __device__ __forceinline__ void operator()(const f32x4 (&acc)[2][2][4][2], const Unit& u, int wr, int wc, int fr, int fq) const {
        const int row0 = u.pm * BM + wr * 64 + fr, col0 = u.pn * BM + wc * 32 + 4 * fq;
#pragma unroll
        for (int ai = 0; ai < 2; ++ai)
#pragma unroll
            for (int m = 0; m < 4; ++m) { float* rowp = O + (size_t)(row0 + ai * HALF + m * 16) * ldc + col0;
#pragma unroll
                for (int bj = 0; bj < 2; ++bj)
#pragma unroll
                    for (int n = 0; n < 2; ++n) *(f32x4*)(rowp + bj * HALF + n * 16) = acc[ai][bj][m][n]; }
    }
};
struct EpiSwiglu {
    static constexpr bool PERM = true, AFTER_DRAIN = false;
    bf16_t* HM;
    __device__ __forceinline__ void operator()(const f32x4 (&acc)[2][2][4][2], const Unit& u, int wr, int wc, int fr, int fq) const {
        const int row0 = u.pm * BM + wr * 64 + fr, col0 = u.pn * HALF + wc * 32 + 8 * fq;
#pragma unroll
        for (int ai = 0; ai < 2; ++ai)
#pragma unroll
            for (int m = 0; m < 4; ++m) { float o[8];
#pragma unroll
                for (int n = 0; n < 2; ++n)
#pragma unroll
                    for (int e = 0; e < 4; ++e) { const float g = acc[ai][0][m][n][e], up = acc[ai][1][m][n][e]; o[n * 4 + e] = g * __builtin_amdgcn_rcpf(1.0f + __builtin_amdgcn_exp2f(-1.4426950408889634f * g)) * up; }
                u32x4 w; w.x = cvt_pk_bf16(o[0], o[1]); w.y = cvt_pk_bf16(o[2], o[3]); w.z = cvt_pk_bf16(o[4], o[5]); w.w = cvt_pk_bf16(o[6], o[7]);
                *(u32x4*)(HM + (size_t)(row0 + ai * HALF + m * 16) * fc::DFF + col0) = w; }
    }
};
struct ComboOrder {
    StaticOrder so; int G, c;
    __device__ void init(int G_, int c_) { so.init(fc::MP, fc::ZN, G_, c_); G = G_; c = c_; }
    __device__ bool next(int i, Unit& u) const { const long L = (long)i * G + c; if (L < 780) return so.next(i, u); if (L >= 780 + 512) return false;
        const int j = (int)L - 780, cc = j >> 8, t = j & 255; u.pm = 65 + cc * 256 + t; u.pn = 12 + cc; return true; }
    __device__ __forceinline__ void a_ready(const Unit&) const {}
    __device__ __forceinline__ void done(const Unit&) const {}
};
template <class Epi, class Sched, bool ALIGN_EPI = false, bool SP2 = false>
__device__ __forceinline__ void gemm_phase(PG8_LAS unsigned char* lds, const Gemm g, const Sched& S, const Epi& E) {
    int tid_ = threadIdx.x; asm volatile("" : "+v"(tid_));
    const int tid = tid_, wid = __builtin_amdgcn_readfirstlane(tid >> 6), lane = tid & 63, wr = wid >> 2, wc = wid & 3, fr = lane & 15, fq = lane >> 4;
    const int K = g.K, nt = K / BK;
    unsigned voffA[2], voffB[2];
#pragma unroll
    for (int i = 0; i < 2; ++i) { int R, C; stage_rc(tid * 16 + i * 8192, R, C); const int Rb = Epi::PERM ? ((R & ~31) + perm32(R & 31)) : R;
        voffA[i] = (unsigned)(R * K + C) * 2u; voffB[i] = (unsigned)(Rb * K + C) * 2u; }
    const size_t kstep = (size_t)(BK * 2);
    const size_t hstep = (size_t)HALF * K * 2;
    const size_t tstep = 2 * hstep;
    const unsigned ldsw = (unsigned)wid * 1024u;
    const int aoff = lds_byte(wr * 64 + fr, fq * 8), boff = lds_byte(wc * 32 + fr, fq * 8);
#define PG8_SA(b, h) (((b) * 2 + (h)) * HTB)
#define PG8_SB(b, h) ((4 + (b) * 2 + (h)) * HTB)
#define PG8_STAGE(bufoff, gbase, voff) do { _Pragma("unroll") for (int _i = 0; _i < 2; ++_i) \
        __builtin_amdgcn_global_load_lds((const unsigned*)((const char*)(gbase) + (voff)[_i]), (PG8_LAS unsigned*)(lds + (bufoff) + ldsw + _i * 8192), 16, 0, 0); } while (0)
#define PG8_LDA(dst, b, h) do { _Pragma("unroll") for (int m = 0; m < 4; ++m) _Pragma("unroll") for (int k = 0; k < 2; ++k) dst[m][k] = *(const PG8_LAS bf16x8*)(lds + PG8_SA(b, h) + aoff + m * 2048 + k * 1024); } while (0)
#define PG8_LDB(dst, b, h) do { _Pragma("unroll") for (int n = 0; n < 2; ++n) _Pragma("unroll") for (int k = 0; k < 2; ++k) dst[n][k] = *(const PG8_LAS bf16x8*)(lds + PG8_SB(b, h) + boff + n * 2048 + k * 1024); } while (0)
#define PG8_MMA(ai, bj, At, Bt) do { __builtin_amdgcn_s_setprio(1); _Pragma("unroll") for (int m = 0; m < 4; ++m) _Pragma("unroll") for (int n = 0; n < 2; ++n) _Pragma("unroll") for (int k = 0; k < 2; ++k) \
        acc[ai][bj][m][n] = __builtin_amdgcn_mfma_f32_16x16x32_bf16(Bt[n][k], At[m][k], acc[ai][bj][m][n], 0, 0, 0); __builtin_amdgcn_s_setprio(0); } while (0)
#define PG8_WAIT_V(n) asm volatile("s_waitcnt vmcnt(" #n ")" ::: "memory")
#define PG8_WAIT_L(n) asm volatile("s_waitcnt lgkmcnt(" #n ")" ::: "memory")
#define PG8_BAR __builtin_amdgcn_s_barrier()
#define PG8_SCHED __builtin_amdgcn_sched_barrier(0)
    Unit cur, nxt; int ui = 0;
    if (!S.next(0, cur)) return;
    f32x4 acc[2][2][4][2];
#pragma unroll
    for (int a = 0; a < 2; ++a)
#pragma unroll
        for (int b = 0; b < 2; ++b)
#pragma unroll
            for (int m = 0; m < 4; ++m)
#pragma unroll
                for (int n = 0; n < 2; ++n) acc[a][b][m][n] = (f32x4){0.f, 0.f, 0.f, 0.f};
    bf16x8 At[4][2], B0[2][2], B1[2][2];
    const char* cA = (const char*)g.A + (size_t)cur.pm * tstep; const char* cB = (const char*)g.Bt + (size_t)cur.pn * tstep;
    S.a_ready(cur);
    if constexpr (SP2) {
        PG8_STAGE(PG8_SB(0, 0), cB, voffB); PG8_STAGE(PG8_SB(0, 1), cB + hstep, voffB); PG8_STAGE(PG8_SA(0, 0), cA, voffA); PG8_STAGE(PG8_SA(0, 1), cA + hstep, voffA);
        if (wr == 1) PG8_BAR;
        PG8_WAIT_V(2); PG8_BAR;
        PG8_STAGE(PG8_SB(1, 0), cB + kstep, voffB); PG8_STAGE(PG8_SA(1, 0), cA + kstep, voffA); PG8_STAGE(PG8_SB(1, 1), cB + hstep + kstep, voffB);
        PG8_WAIT_V(6); PG8_BAR;
    } else {
        PG8_STAGE(PG8_SB(0, 0), cB, voffB); PG8_STAGE(PG8_SA(0, 0), cA, voffA); PG8_STAGE(PG8_SB(0, 1), cB + hstep, voffB); PG8_STAGE(PG8_SA(0, 1), cA + hstep, voffA);
        if (wr == 1) PG8_BAR;
        PG8_WAIT_V(4); PG8_BAR;
        PG8_STAGE(PG8_SB(1, 0), cB + kstep, voffB); PG8_STAGE(PG8_SA(1, 0), cA + kstep, voffA); PG8_STAGE(PG8_SB(1, 1), cB + hstep + kstep, voffB);
        PG8_WAIT_V(6); PG8_BAR;
    }
    for (;;) {
        const bool has_next = S.next(ui + 1, nxt);
        const char* nA = has_next ? (const char*)g.A + (size_t)nxt.pm * tstep : cA; const char* nB = has_next ? (const char*)g.Bt + (size_t)nxt.pn * tstep : cB;
        for (int t = 0; t < nt; t += 2) {
            const bool last = (t == nt - 2);
            const char* a1 = cA + (size_t)(t + 1) * kstep;
            const char* a2 = last ? nA : cA + (size_t)(t + 2) * kstep; const char* b2 = last ? nB : cB + (size_t)(t + 2) * kstep;
            const char* a3 = a2 + kstep; const char* b3 = b2 + kstep;
            if (last && has_next) S.a_ready(nxt);
            if constexpr (SP2) {
            PG8_LDB(B0, 0, 0); PG8_LDB(B1, 0, 1); PG8_SCHED; PG8_LDA(At, 0, 0); PG8_STAGE(PG8_SA(1, 1), a1 + hstep, voffA);
            PG8_WAIT_V(8); PG8_WAIT_L(0); PG8_BAR; PG8_MMA(0, 0, At, B0); PG8_MMA(0, 1, At, B1); PG8_BAR; PG8_SCHED;
            PG8_LDA(At, 0, 1); PG8_STAGE(PG8_SB(0, 0), b2, voffB); PG8_STAGE(PG8_SB(0, 1), b2 + hstep, voffB); PG8_STAGE(PG8_SA(0, 0), a2, voffA);
            PG8_WAIT_V(8); PG8_WAIT_L(0); PG8_BAR; PG8_MMA(1, 0, At, B0); PG8_MMA(1, 1, At, B1); PG8_BAR; PG8_SCHED;
            PG8_LDB(B0, 1, 0); PG8_LDB(B1, 1, 1); PG8_SCHED; PG8_LDA(At, 1, 0); PG8_STAGE(PG8_SA(0, 1), a2 + hstep, voffA);
            PG8_WAIT_V(8); PG8_WAIT_L(0); PG8_BAR; PG8_MMA(0, 0, At, B0); PG8_MMA(0, 1, At, B1); PG8_BAR; PG8_SCHED;
            PG8_LDA(At, 1, 1); PG8_STAGE(PG8_SB(1, 0), b3, voffB); PG8_STAGE(PG8_SB(1, 1), b3 + hstep, voffB); PG8_STAGE(PG8_SA(1, 0), a3, voffA);
            PG8_WAIT_V(8); PG8_WAIT_L(0); PG8_BAR; PG8_MMA(1, 0, At, B0); PG8_MMA(1, 1, At, B1); PG8_BAR; PG8_SCHED;
            } else {
            PG8_LDB(B0, 0, 0); PG8_SCHED; PG8_LDA(At, 0, 0); PG8_STAGE(PG8_SA(1, 1), a1 + hstep, voffA);
            PG8_WAIT_L(8); PG8_BAR; PG8_WAIT_L(0); PG8_MMA(0, 0, At, B0); PG8_BAR; PG8_SCHED;
            PG8_LDB(B1, 0, 1); PG8_STAGE(PG8_SB(0, 0), b2, voffB);
            PG8_BAR; PG8_WAIT_L(0); PG8_MMA(0, 1, At, B1); PG8_BAR;
            PG8_LDA(At, 0, 1); PG8_STAGE(PG8_SA(0, 0), a2, voffA);
            PG8_BAR; PG8_WAIT_L(0); PG8_MMA(1, 0, At, B0); PG8_BAR; PG8_SCHED;
            PG8_STAGE(PG8_SB(0, 1), b2 + hstep, voffB);
            PG8_WAIT_V(6); PG8_BAR; PG8_MMA(1, 1, At, B1); PG8_BAR;
            PG8_LDB(B0, 1, 0); PG8_SCHED; PG8_LDA(At, 1, 0); PG8_STAGE(PG8_SA(0, 1), a2 + hstep, voffA);
            PG8_WAIT_L(8); PG8_BAR; PG8_WAIT_L(0); PG8_MMA(0, 0, At, B0); PG8_BAR; PG8_SCHED;
            PG8_LDB(B1, 1, 1); PG8_STAGE(PG8_SB(1, 0), b3, voffB);
            PG8_BAR; PG8_WAIT_L(0); PG8_MMA(0, 1, At, B1); PG8_BAR;
            PG8_LDA(At, 1, 1); PG8_STAGE(PG8_SA(1, 0), a3, voffA);
            PG8_BAR; PG8_WAIT_L(0); PG8_MMA(1, 0, At, B0); PG8_BAR; PG8_SCHED;
            PG8_STAGE(PG8_SB(1, 1), b3 + hstep, voffB);
            PG8_WAIT_V(6); PG8_BAR; PG8_MMA(1, 1, At, B1); PG8_BAR;
            }
        }
        if constexpr (ALIGN_EPI) { if (wr == 0) PG8_BAR; }
        if constexpr (!Epi::AFTER_DRAIN) { E(acc, cur, wr, wc, fr, fq); S.done(cur); }
        if (!has_next) break;
#pragma unroll
        for (int a = 0; a < 2; ++a)
#pragma unroll
            for (int b = 0; b < 2; ++b)
#pragma unroll
                for (int m = 0; m < 4; ++m)
#pragma unroll
                    for (int n = 0; n < 2; ++n) acc[a][b][m][n] = (f32x4){0.f, 0.f, 0.f, 0.f};
        cur = nxt; cA = nA; cB = nB; ++ui;
        if constexpr (ALIGN_EPI) { if (wr == 1) PG8_BAR; }
    }
    PG8_WAIT_V(0);
    if constexpr (!ALIGN_EPI) { if (wr == 0) PG8_BAR; }
    PG8_BAR;
    if constexpr (Epi::AFTER_DRAIN) { E.fused(acc, cur, wr, wc, fr, fq, lds, wid, lane); S.done(cur); }
#undef PG8_SA
#undef PG8_SB
#undef PG8_STAGE
#undef PG8_LDA
#undef PG8_LDB
#undef PG8_MMA
#undef PG8_WAIT_V
#undef PG8_WAIT_L
#undef PG8_BAR
#undef PG8_SCHED
}
}
#define GAS __attribute__((address_space(1)))
#define LAS __attribute__((address_space(3)))
typedef unsigned short bf16;
typedef unsigned v4u __attribute__((ext_vector_type(4)));
typedef float f32x4 __attribute__((ext_vector_type(4)));
typedef short bf16x8 __attribute__((ext_vector_type(8)));
typedef GAS unsigned gu32;
typedef GAS unsigned long long gu64;
#define RLX_AGENT __ATOMIC_RELAXED, __HIP_MEMORY_SCOPE_AGENT
#define LDS_WAIT() asm volatile("s_waitcnt lgkmcnt(0)" ::: "memory")
#define VM_WAIT() asm volatile("s_waitcnt vmcnt(0)" ::: "memory")
__device__ __forceinline__ unsigned long long rt() { return __builtin_amdgcn_s_memrealtime(); }
__device__ __forceinline__ unsigned f2bf(float f) { unsigned u = __builtin_bit_cast(unsigned, f); return (u + 0x7fffu + ((u >> 16) & 1u)) >> 16; }
__device__ __forceinline__ unsigned pk2(float lo, float hi) { return f2bf(lo) | (f2bf(hi) << 16); }
#define XB_TMO      128
#define XB_XCNT(j)  (256  + 64 * (j))
#define XB_XSUB(j)  (1280 + 64 * (j))
#define XB_XGEN(j)  (2304 + 64 * (j))
#define XB_TOP      3328
#define XB_TOPGEN   3392
#define XCD_BAR_WORDS 3456
#define XB_SPIN_CAP (1u << 18)

__device__ __forceinline__ unsigned xb_ld(unsigned* p)              { return __hip_atomic_load(p, __ATOMIC_RELAXED, __HIP_MEMORY_SCOPE_AGENT); }
__device__ __forceinline__ unsigned xb_add(unsigned* p, unsigned v) { return __hip_atomic_fetch_add(p, v, __ATOMIC_RELAXED, __HIP_MEMORY_SCOPE_AGENT); }
__device__ __forceinline__ unsigned xb_xcc_id() { return (unsigned)__builtin_amdgcn_s_getreg((3 << 11) | 20) & 0xFu; }
#define XB_SPIN(cond, bar) do { unsigned _sp = 0; while (cond) { __builtin_amdgcn_s_sleep(1); \
    if ((++_sp & 255u) == 0u) { if (xb_ld(&(bar)[XB_TMO])) break; if (_sp > XB_SPIN_CAP) { atomicAdd(&(bar)[XB_TMO], 1u); break; } } } } while (0)

struct XcdBarrier {
    unsigned* bar; unsigned x;
    volatile LAS unsigned* st;
};

__device__ __forceinline__ XcdBarrier xcd_barrier_post(unsigned* bar, volatile LAS unsigned* st) {
    XcdBarrier b; b.bar = bar; b.x = xb_xcc_id(); b.st = st;
    if (threadIdx.x == 0) (void)xb_add(&bar[XB_XCNT(b.x)], 1u);
    return b;
}
__device__ __forceinline__ void xcd_barrier_complete(unsigned* bar, unsigned x, unsigned& nloc, unsigned& nx) {
    const unsigned G = gridDim.x * gridDim.y * gridDim.z;
    unsigned sum, cnt, mine, sp = 0u;
    for (;;) {
        sum = 0u; cnt = 0u; mine = 0u;
#pragma unroll
        for (unsigned j = 0; j < 16; ++j) { const unsigned c = xb_ld(&bar[XB_XCNT(j)]); sum += c; cnt += (c > 0u) ? 1u : 0u; mine = (j == x) ? c : mine; }
        if (sum == G) break;
        __builtin_amdgcn_s_sleep(1);
        if ((++sp & 255u) == 0u) { if (xb_ld(&bar[XB_TMO])) break; if (sp > XB_SPIN_CAP) { atomicAdd(&bar[XB_TMO], 1u); break; } }
    }
    nloc = mine > 0u ? mine : 1u; nx = cnt > 0u ? cnt : 1u;
}

__device__ __forceinline__ void xcd_barrier(const XcdBarrier& b) {
    asm volatile("s_waitcnt vmcnt(0)" ::: "memory");
    __syncthreads();
    if (threadIdx.x == 0) {
        unsigned* bar = b.bar;
        __builtin_amdgcn_s_waitcnt(0);
        unsigned nloc = b.st[0], nx = b.st[1];
        if (nloc == 0u) { xcd_barrier_complete(bar, b.x, nloc, nx); b.st[0] = nloc; b.st[1] = nx; }
        const unsigned old = xb_add(&bar[XB_XSUB(b.x)], 1u);
        const unsigned gen = old / nloc;
        if (old + 1u == (gen + 1u) * nloc) {
            __builtin_amdgcn_fence(__ATOMIC_RELEASE, "agent");
            asm volatile("s_waitcnt vmcnt(0)" ::: "memory");
            const unsigned og = xb_add(&bar[XB_TOP], 1u);
            const unsigned tg = og / nx;
            if (og + 1u == (tg + 1u) * nx) xb_add(&bar[XB_TOPGEN], 1u);
            else XB_SPIN(xb_ld(&bar[XB_TOPGEN]) == tg, bar);
            __builtin_amdgcn_fence(__ATOMIC_ACQUIRE, "agent");
            xb_add(&bar[XB_XGEN(b.x)], 1u);
            asm volatile("s_waitcnt vmcnt(0)" ::: "memory");
        } else {
            XB_SPIN(xb_ld(&bar[XB_XGEN(b.x)]) == gen, bar);
            __builtin_amdgcn_fence(__ATOMIC_ACQUIRE, "agent");
            asm volatile("s_waitcnt vmcnt(0)" ::: "memory");
        }
    }
    __syncthreads();
}
namespace fk {
using namespace fc;
constexpr int NWAVES = 8, NTHR = 512;
constexpr size_t MiB = 1u << 20;
constexpr size_t WS_CTL = 0, CTL_ZERO_BYTES = 1 * MiB;
constexpr int CW_BAR = 4096;
constexpr size_t FB = 1536 * MiB;
constexpr size_t WS_WT_IN = FB + 0 * MiB;
constexpr size_t WS_W1R = FB + 6 * MiB;
constexpr size_t WS_WT_O = FB + 8 * MiB;
constexpr size_t WS_WT_F1 = FB + 10 * MiB;
constexpr size_t WS_WT_F2 = FB + 21 * MiB;
constexpr size_t WS_MODP = FB + 27 * MiB;
constexpr size_t WS_MODF = FB + 35 * MiB;
constexpr size_t WS_STATS = FB + 36 * MiB;
constexpr size_t WS_CBIAS = FB + 36 * MiB + 512 * 1024;
constexpr size_t WS_W2T = FB + 36 * MiB + 768 * 1024;
constexpr size_t WS_NARROW = FB + 37 * MiB;
constexpr size_t WS_U = FB + 42 * MiB;
constexpr size_t WS_ACMP = WS_U + (size_t)MP * 1024 * 2;
constexpr size_t WS_ZB = FB + 331 * MiB;
constexpr size_t WS_PCMP = FB + 429 * MiB;
constexpr size_t WS_KCVP = FB + 493 * MiB;
constexpr size_t WS_KCVS = FB + 494 * MiB;
constexpr size_t WS_KC = FB + 41 * MiB + 256 * 1024;
constexpr size_t WS_VTC = FB + 41 * MiB + 512 * 1024;
constexpr size_t WS_GLAS = FB + 526 * MiB;
constexpr size_t WS_GLAD = FB + 558 * MiB;
constexpr size_t WS_ATT = FB + 559 * MiB;
constexpr size_t WS_H1 = FB + 592 * MiB;
constexpr size_t WS_X1 = FB + 657 * MiB;
constexpr size_t WS_HM = FB + 722 * MiB;
constexpr size_t WS_VTS = FB + 812 * MiB;
constexpr size_t WS_VTW = FB + 816 * MiB;
constexpr size_t WS_END = FB + 820 * MiB;
constexpr int RING_OFF = 0, RING_BYTES = 131072, LDSCTL_OFF = RING_BYTES, MISC_OFF = LDSCTL_OFF + 320, LDS_BYTES = 147456;


struct Args { const void* in[28]; float* out; unsigned char* ws; int ph_lo, ph_hi, li, pad; };
struct Frame { LAS unsigned char* lds; gu32* ctl; int tid, lane, wave, vcu, G; };

template <int X> __device__ __forceinline__ float xor_f(float v) {
    if constexpr (X == 32) { auto rr = __builtin_amdgcn_permlane32_swap(__float_as_uint(v), __float_as_uint(v), false, false); const unsigned me = __float_as_uint(v); return __uint_as_float(rr[0] == me ? rr[1] : rr[0]); }
    else return __int_as_float(__builtin_amdgcn_ds_swizzle(__float_as_int(v), (X << 10) | 0x1f));
}
__device__ __forceinline__ float swap32_sum(float v) { auto rr = __builtin_amdgcn_permlane32_swap(__float_as_uint(v), __float_as_uint(v), false, false); return __uint_as_float(rr[0]) + __uint_as_float(rr[1]); }
__device__ __forceinline__ float swap32_max(float v) { auto rr = __builtin_amdgcn_permlane32_swap(__float_as_uint(v), __float_as_uint(v), false, false); return fmaxf(__uint_as_float(rr[0]), __uint_as_float(rr[1])); }
__device__ __forceinline__ float wave_sum(float v) { v += xor_f<1>(v); v += xor_f<2>(v); v += xor_f<4>(v); v += xor_f<8>(v); v += xor_f<16>(v); return swap32_sum(v); }
__device__ __forceinline__ float wave_max(float v) { v = fmaxf(v, xor_f<1>(v)); v = fmaxf(v, xor_f<2>(v)); v = fmaxf(v, xor_f<4>(v)); v = fmaxf(v, xor_f<8>(v)); v = fmaxf(v, xor_f<16>(v)); return swap32_max(v); }
__device__ __forceinline__ Frame launder(const Frame& F0) { Frame F = F0; int t = F0.tid; asm volatile("" : "+v"(t)); F.tid = t; F.lane = t & 63; F.wave = __builtin_amdgcn_readfirstlane(t >> 6); return F; }
__device__ __forceinline__ float silu_f(float x) { return x / (1.f + __expf(-x)); }
__device__ __forceinline__ int mod_row(int r) { return r < RP ? (r >> 11) : 8 + ((r - RP) >> 2); }

template <class SrcCol> __device__ __forceinline__ void transpose_item(const float* W, int K, int N, bf16* WT, int n0, int k0, LAS float* scr, int lane, SrcCol src) {
    const int sc = src(n0 + (lane & 31));
#pragma unroll 8
    for (int i = 0; i < 32; ++i) { const int kk = 2 * i + (lane >> 5); scr[kk * 33 + (lane & 31)] = sc >= 0 ? W[(size_t)(k0 + kk) * N + sc] : 0.f; }
    LDS_WAIT(); asm volatile("" ::: "memory");
    const int c = lane & 7;
#pragma unroll
    for (int j = 0; j < 4; ++j) { const int n = (lane >> 3) + 8 * j; const LAS float* s = scr + (8 * c) * 33 + n;
        v4u o; o.x = pk2(s[0 * 33], s[1 * 33]); o.y = pk2(s[2 * 33], s[3 * 33]); o.z = pk2(s[4 * 33], s[5 * 33]); o.w = pk2(s[6 * 33], s[7 * 33]);
        *(GAS v4u*)(WT + (size_t)(n0 + n) * K + k0 + 8 * c) = o; }
    LDS_WAIT(); asm volatile("" ::: "memory");
}
__device__ __forceinline__ int src_win(int n) { return n < 1024 ? n : (n < 2816 ? n + 16 : (n < 2832 ? 1024 + (n - 2816) : (n < 2856 ? n : -1))); }
__device__ __forceinline__ int src_f1(int n) { return ((n >> 7) & 1) * DFF + (n >> 8) * 128 + (n & 127); }

__device__ __forceinline__ void p0_prologue(Frame& F0, const Args& a) { Frame F = launder(F0);
    const float* w_in = (const float*)a.in[13]; const float* w_o = (const float*)a.in[21]; const float* w_f1 = (const float*)a.in[24]; const float* w_f2 = (const float*)a.in[25];
    const float* w1 = (const float*)a.in[18]; const float* b1 = (const float*)a.in[19]; const float* pe = (const float*)a.in[17];
    unsigned char* ws = a.ws;
    {
        LAS float* sl = (LAS float*)(F.lds + RING_OFF);
        const float* cp = (const float*)a.in[7]; const float* cs = (const float*)a.in[8]; const float* w_ada = (const float*)a.in[11];
        float* modp = (float*)(ws + WS_MODP);
        for (int j = blockIdx.x; j < 256; j += F.G) { const int cg = j & 31, kg = j >> 5;
            for (int i = F.tid; i < 40 * 128; i += NTHR) { const int r = i >> 7, k = i & 127; const float c = r < 8 ? cp[r * D + kg * 128 + k] : cs[(r - 8) * D + kg * 128 + k]; sl[i] = silu_f(c); }
            __syncthreads();
            float acc[40];
#pragma unroll
            for (int r = 0; r < 40; ++r) acc[r] = 0.f;
            const int col = F.tid % 192, kh = F.tid / 192;
            if (F.tid < 384) { const float* wp = w_ada + (size_t)(kg * 128 + kh * 64) * 6144 + cg * 192 + col;
                for (int k = 0; k < 64; ++k) { const float w = wp[(size_t)k * 6144];
#pragma unroll
                    for (int r = 0; r < 40; ++r) acc[r] += sl[r * 128 + kh * 64 + k] * w; } }
            __syncthreads();
            LAS float* cb = sl + 40 * 128;
            if (F.tid >= 192 && F.tid < 384) {
#pragma unroll
                for (int r = 0; r < 40; ++r) cb[r * 192 + col] = acc[r]; }
            __syncthreads();
            if (F.tid < 192) {
#pragma unroll
                for (int r = 0; r < 40; ++r) modp[((size_t)kg * 40 + r) * 6144 + cg * 192 + col] = acc[r] + cb[r * 192 + col]; }
            __syncthreads();
        }
    }
    LAS float* scr = (LAS float*)(F.lds + RING_OFF + F.wave * 16384);
    const int gw = F.vcu * NWAVES + F.wave, NGW = F.G * NWAVES;
    constexpr int I_IN = 16 * 96, I_O = 16 * 32, I_F1 = 16 * 176, I_F2 = 44 * 32, I_W1 = 4 * 16 * 4;
    constexpr int NITEMS = I_IN + I_O + I_F1 + I_F2 + I_W1;
    for (int it = gw; it < NITEMS; it += NGW) { int r = it;
        if (r < I_IN) { transpose_item(w_in, 1024, 2856, (bf16*)(ws + WS_WT_IN), (r % 96) * 32, (r / 96) * 64, scr, F.lane, [](int n) { return src_win(n); }); continue; } r -= I_IN;
        if (r < I_O) { transpose_item(w_o, 1024, 1024, (bf16*)(ws + WS_WT_O), (r % 32) * 32, (r / 32) * 64, scr, F.lane, [](int n) { return n; }); continue; } r -= I_O;
        if (r < I_F1) { transpose_item(w_f1, 1024, F1N, (bf16*)(ws + WS_WT_F1), (r % 176) * 32, (r / 176) * 64, scr, F.lane, [](int n) { return src_f1(n); }); continue; } r -= I_F1;
        if (r < I_F2) { transpose_item(w_f2, DFF, 1024, (bf16*)(ws + WS_WT_F2), (r % 32) * 32, (r / 32) * 64, scr, F.lane, [](int n) { return n; }); continue; } r -= I_F2;
        { const int cm = r >> 6, q = r & 63;
          transpose_item(w1 + (size_t)cm * 1024 * 128, 1024, 128, (bf16*)(ws + WS_W1R) + (size_t)cm * 128 * 1024, (q % 4) * 32, (q / 4) * 64, scr, F.lane, [](int n) { return n; }); }
    }
    { float* cbias = (float*)(ws + WS_CBIAS);
      for (int o = gw; o < 256; o += NGW) { const int c = o >> 7, hid = o & 127; float s = 0.f;
          for (int k = F.lane; k < 2048; k += 64) s += pe[((k >> 6) * 2 + c) * 64 + (k & 63)] * w1[((size_t)c * 2048 + k) * 128 + hid];
          s = wave_sum(s); if (F.lane == 0) cbias[o] = s + b1[o]; } }
    { const float* w2 = (const float*)a.in[20]; bf16* w2t = (bf16*)(ws + WS_W2T);
      for (int i = gw * 64 + F.lane; i < 16384; i += NGW * 64) { const int c = i >> 13, d = (i >> 7) & 63, hid = i & 127; w2t[i] = (bf16)f2bf(w2[((size_t)c * 128 + hid) * 64 + d]); } }
    { const float* cw = (const float*)a.in[5]; float* ow = a.out + O_WKS;
      for (int it = gw; it < 32 * 508; it += NGW) { const int b = it / 508, j = it % 508;
          *(GAS f32x4*)(ow + ((size_t)b * 512 + j) * 256 + F.lane * 4) = *(const GAS f32x4*)(cw + ((size_t)b * 512 + j + 4) * 256 + F.lane * 4); } }
    { const float* cc = (const float*)a.in[3]; const int* table = (const int*)a.in[6]; bf16* A = (bf16*)(ws + WS_ACMP);
      const int c = F.lane >> 5, g = (F.lane >> 4) & 1, d = (F.lane & 15) * 4;
      for (int it = gw; it < 32 * 128; it += NGW) { const int b = it >> 7, pg = it & 127; const float* src = cc + (size_t)table[it] * 128 * 256 + F.lane * 4;
          bf16* dst = A + (size_t)c * 65536 * 1024 + ((size_t)(b * 1024 + pg * 8) * 2 + g) * 1024 + d;
#pragma unroll 8
          for (int t = 0; t < 128; ++t) { const f32x4 v = *(const GAS f32x4*)(src + (size_t)t * 256);
              unsigned long long w = (unsigned long long)pk2(v.x, v.y) | ((unsigned long long)pk2(v.z, v.w) << 32);
              *(GAS unsigned long long*)(dst + (size_t)(t >> 4) * 2048 + (t & 15) * 64) = w; } } }
}
__device__ __forceinline__ void p1_ln_mod(Frame& F0, const Args& a) { Frame F = launder(F0);
    unsigned char* ws = a.ws; const float* modp = (const float*)(ws + WS_MODP); const float* b_ada = (const float*)a.in[12];
    const float* ln_g = (const float*)a.in[9]; const float* ln_b = (const float*)a.in[10];
    const int gw = F.vcu * NWAVES + F.wave, NGW = F.G * NWAVES;
    { float* modf = (float*)(ws + WS_MODF);
      for (int i = blockIdx.x * NTHR + F.tid; i < 40 * 6144; i += F.G * NTHR) { float s = b_ada[i % 6144];
#pragma unroll
          for (int kg = 0; kg < 8; ++kg) s += modp[(size_t)kg * 40 * 6144 + i];
          modf[i] = s; } }
    bf16* U = (bf16*)(ws + WS_U); float* stats = (float*)(ws + WS_STATS);
    for (int r = gw; r < R; r += NGW) {
        const float* xrow = r < RP ? (const float*)a.in[0] + (size_t)r * D : (const float*)a.in[1] + (size_t)(r - RP) * D;
        const GAS f32x4* xr = (const GAS f32x4*)xrow + F.lane;
        f32x4 v[4]; float s = 0.f;
#pragma unroll
        for (int j = 0; j < 4; ++j) { v[j] = xr[64 * j]; s += (v[j].x + v[j].y) + (v[j].z + v[j].w); }
        const float mean = wave_sum(s) * (1.f / D); float s2 = 0.f;
#pragma unroll
        for (int j = 0; j < 4; ++j) { v[j] = v[j] - mean; s2 += (v[j].x * v[j].x + v[j].y * v[j].y) + (v[j].z * v[j].z + v[j].w * v[j].w); }
        const float rstd = 1.f / sqrtf(wave_sum(s2) * (1.f / D) + 1e-5f);
        if (F.lane == 0) { stats[2 * r] = mean; stats[2 * r + 1] = rstd; }
        const int mr = mod_row(r);
        GAS unsigned long long* o8 = (GAS unsigned long long*)(U + (size_t)r * D) + F.lane;
#pragma unroll
        for (int j = 0; j < 4; ++j) { const int c = 256 * j + 4 * F.lane;
            f32x4 sh = *(const f32x4*)(b_ada + c), sc = *(const f32x4*)(b_ada + 1024 + c);
#pragma unroll
            for (int kg = 0; kg < 8; ++kg) { sh += *(const f32x4*)(modp + ((size_t)kg * 40 + mr) * 6144 + c); sc += *(const f32x4*)(modp + ((size_t)kg * 40 + mr) * 6144 + 1024 + c); }
            const f32x4 g = *(const f32x4*)(ln_g + c), bb = *(const f32x4*)(ln_b + c);
            const f32x4 y = (v[j] * rstd * g + bb) * (sc + 1.f) + sh;
            o8[64 * j] = (unsigned long long)pk2(y.x, y.y) | ((unsigned long long)pk2(y.z, y.w) << 32); }
    }
}


template <int WHICH> __device__ __forceinline__ void p_res_ln(Frame& F0, const Args& a) { Frame F = launder(F0);
    unsigned char* ws = a.ws; const float* modf = (const float*)(ws + WS_MODF); const float* stats = (const float*)(ws + WS_STATS);
    const float* mixb = (const float*)(ws + WS_H1); float* X1 = (float*)(ws + WS_X1); bf16* U = (bf16*)(ws + WS_U);
    const float* ln_g = (const float*)a.in[9]; const float* ln_b = (const float*)a.in[10];
    const float* lg = (const float*)a.in[WHICH == 0 ? 22 : 26]; const float* lb = (const float*)a.in[WHICH == 0 ? 23 : 27];
    const int gw = F.vcu * NWAVES + F.wave, NGW = F.G * NWAVES;
    for (int r = gw; r < R; r += NGW) {
        const int mr = mod_row(r); const float* mrow = modf + (size_t)mr * 6144;
        f32x4 v[4]; float s = 0.f;
        if (WHICH == 0) { const float* xrow = r < RP ? (const float*)a.in[0] + (size_t)r * D : (const float*)a.in[1] + (size_t)(r - RP) * D;
            const float mean = stats[2 * r], rstd = stats[2 * r + 1];
#pragma unroll
            for (int j = 0; j < 4; ++j) { const int c = 256 * j + 4 * F.lane; const f32x4 x = *(const GAS f32x4*)(xrow + c), m = *(const GAS f32x4*)(mixb + (size_t)r * D + c);
                const f32x4 xp = (x - mean) * rstd * *(const f32x4*)(ln_g + c) + *(const f32x4*)(ln_b + c);
                v[j] = xp * ALPHA + *(const f32x4*)(mrow + 2048 + c) * m; s += (v[j].x + v[j].y) + (v[j].z + v[j].w); } }
        else {
#pragma unroll
            for (int j = 0; j < 4; ++j) { const int c = 256 * j + 4 * F.lane; const f32x4 x1 = *(const GAS f32x4*)(X1 + (size_t)r * D + c), m = *(const GAS f32x4*)(mixb + (size_t)r * D + c);
                v[j] = x1 * ALPHA + *(const f32x4*)(mrow + 5120 + c) * m; s += (v[j].x + v[j].y) + (v[j].z + v[j].w); } }
        const float mean2 = wave_sum(s) * (1.f / D); float s2 = 0.f;
#pragma unroll
        for (int j = 0; j < 4; ++j) { v[j] = v[j] - mean2; s2 += (v[j].x * v[j].x + v[j].y * v[j].y) + (v[j].z * v[j].z + v[j].w * v[j].w); }
        const float rstd2 = 1.f / sqrtf(wave_sum(s2) * (1.f / D) + 1e-5f);
#pragma unroll
        for (int j = 0; j < 4; ++j) { const int c = 256 * j + 4 * F.lane; const f32x4 y = v[j] * rstd2 * *(const f32x4*)(lg + c) + *(const f32x4*)(lb + c);
            if (WHICH == 0) { *(GAS f32x4*)(X1 + (size_t)r * D + c) = y;
                const f32x4 u = y * (*(const f32x4*)(mrow + 4096 + c) + 1.f) + *(const f32x4*)(mrow + 3072 + c);
                *(GAS unsigned long long*)(U + (size_t)r * D + c) = (unsigned long long)pk2(u.x, u.y) | ((unsigned long long)pk2(u.z, u.w) << 32); }
            else { float* o = r < RP ? a.out + O_YP + (size_t)r * D : a.out + O_YS + (size_t)(r - RP) * D; *(GAS f32x4*)(o + c) = y; } }
    }
}


typedef float f32x4_ __attribute__((ext_vector_type(4)));
__device__ __forceinline__ float bf2f(unsigned short h) { return __uint_as_float((unsigned)h << 16); }
__device__ __forceinline__ float gelu_tanh(float x) { const float u = 0.7978845608028654f * (x + 0.044715f * x * x * x); const float e = __expf(2.f * u); return x * (1.f - 1.f / (e + 1.f)); }
__device__ __forceinline__ void cmp_post_sample(Frame& F0, const Args& a) { Frame F = launder(F0);
    unsigned char* ws = a.ws; const bf16* P = (const bf16*)(ws + WS_PCMP); const bf16* w2t = (const bf16*)(ws + WS_W2T); const float* cbias = (const float*)(ws + WS_CBIAS);
    float* kcvs = (float*)(ws + WS_KCVS);
    const int gw = F.vcu * NWAVES + F.wave, NGW = F.G * NWAVES, lr = F.lane & 15, quad = F.lane >> 4;
    for (int tile = gw; tile < 2 * 4092; tile += NGW) { const int c = tile / 4092, tt = tile % 4092;
        const int rho = tt * 16 + lr; const bool valid = rho < 65472; const int rc = valid ? rho : 65471;
        const int b = rc / 2046, rem = rc % 2046, n = rem >> 1, g = rem & 1;
        const bf16* p0 = P + (size_t)c * 65536 * 256 + ((size_t)(b * 1024 + n) * 2 + g) * 256; const bf16* p1 = p0 + 2 * 256 + 128;
        bf16x8 hf[4];
#pragma unroll
        for (int ks = 0; ks < 4; ++ks) { const int hid0 = 32 * ks + 8 * quad; const bf16x8 x0 = *(const bf16x8*)(p0 + hid0), x1 = *(const bf16x8*)(p1 + hid0);
            const f32x4 cb0 = *(const f32x4*)(cbias + c * 128 + hid0), cb1 = *(const f32x4*)(cbias + c * 128 + hid0 + 4); float h[8];
#pragma unroll
            for (int e = 0; e < 8; ++e) h[e] = gelu_tanh(bf2f((unsigned short)x0[e]) + bf2f((unsigned short)x1[e]) + (e < 4 ? cb0[e] : cb1[e - 4]));
            v4u w; w.x = pk2(h[0], h[1]); w.y = pk2(h[2], h[3]); w.z = pk2(h[4], h[5]); w.w = pk2(h[6], h[7]); hf[ks] = __builtin_bit_cast(bf16x8, w); }
#pragma unroll
        for (int nt = 0; nt < 4; ++nt) { f32x4 acc = {0.f, 0.f, 0.f, 0.f};
#pragma unroll
            for (int ks = 0; ks < 4; ++ks) { const bf16x8 wf = *(const bf16x8*)(w2t + ((size_t)c * 64 + 16 * nt + lr) * 128 + 32 * ks + 8 * quad);
                acc = __builtin_amdgcn_mfma_f32_16x16x32_bf16(wf, hf[ks], acc, 0, 0, 0); }
            if (valid) *(GAS f32x4*)(kcvs + (((size_t)b * 1023 + n) * 2 + c) * 128 + g * 64 + 16 * nt + 4 * quad) = acc; }
    }
}
__device__ __forceinline__ void cmp_prompt(Frame& F0, const Args& a) { Frame F = launder(F0);
    unsigned char* ws = a.ws; const bf16* ZB = (const bf16*)(ws + WS_ZB); const bf16* w1r = (const bf16*)(ws + WS_W1R); const bf16* w2t = (const bf16*)(ws + WS_W2T);
    const float* cbias = (const float*)(ws + WS_CBIAS); float* kcvp = (float*)(ws + WS_KCVP);
    LAS float* red = (LAS float*)(F.lds + RING_OFF);
    LAS bf16* H = (LAS bf16*)(F.lds + RING_OFF + 65536);
    const int lr = F.lane & 15, quad = F.lane >> 4;
    for (int unit = blockIdx.x; unit < 2 * 127; unit += F.G) { const int c = unit / 127, tt = unit % 127;
        const int rho = tt * 16 + lr; const int b = rho / 254, rem = rho % 254, n = rem >> 1, g = rem & 1;
        const bf16* arow = ZB + ((size_t)b * 2048 + 16 * n) * ZN + PZ_KVC + c * 128 + g * 64;
        f32x4 acc[8];
#pragma unroll
        for (int nt = 0; nt < 8; ++nt) acc[nt] = (f32x4){0.f, 0.f, 0.f, 0.f};
#pragma unroll 2
        for (int ks = 0; ks < 8; ++ks) { const int k = F.wave * 256 + ks * 32 + quad * 8;
            const bf16x8 af = *(const bf16x8*)(arow + (size_t)(k >> 6) * ZN + (k & 63));
            const bf16* wb = w1r + ((size_t)c * 256 + (k >> 10) * 128 + lr) * 1024 + (k & 1023);
#pragma unroll
            for (int nt = 0; nt < 8; ++nt) { const bf16x8 bf = *(const bf16x8*)(wb + (size_t)nt * 16 * 1024); acc[nt] = __builtin_amdgcn_mfma_f32_16x16x32_bf16(af, bf, acc[nt], 0, 0, 0); } }
#pragma unroll
        for (int nt = 0; nt < 8; ++nt)
#pragma unroll
            for (int e = 0; e < 4; ++e) red[(F.wave * 16 + 4 * quad + e) * 128 + 16 * nt + lr] = acc[nt][e];
        __syncthreads();
        { const int row = F.tid >> 5, h4 = (F.tid & 31) * 4; f32x4 s = *(const f32x4*)(cbias + c * 128 + h4);
#pragma unroll
          for (int w = 0; w < 8; ++w) s += *(const LAS f32x4*)(red + (w * 16 + row) * 128 + h4);
          *(LAS unsigned long long*)(H + row * 136 + h4) = (unsigned long long)pk2(gelu_tanh(s.x), gelu_tanh(s.y)) | ((unsigned long long)pk2(gelu_tanh(s.z), gelu_tanh(s.w)) << 32); }
        __syncthreads();
        if (F.wave < 4) { const int nt = F.wave; f32x4 o = {0.f, 0.f, 0.f, 0.f};
#pragma unroll
            for (int ks = 0; ks < 4; ++ks) { const bf16x8 wf = *(const bf16x8*)(w2t + ((size_t)c * 64 + 16 * nt + lr) * 128 + 32 * ks + 8 * quad);
                const bf16x8 hf = *(const LAS bf16x8*)(H + lr * 136 + 32 * ks + 8 * quad);
                o = __builtin_amdgcn_mfma_f32_16x16x32_bf16(wf, hf, o, 0, 0, 0); }
            *(GAS f32x4*)(kcvp + (((size_t)b * 127 + n) * 2 + c) * 128 + g * 64 + 16 * nt + 4 * quad) = o;
            const int d0 = 16 * nt + 4 * quad;
            if (c == 0) *(GAS unsigned long long*)((bf16*)(ws + WS_KC) + ((size_t)(b * 2 + g) * 128 + n) * 64 + d0) = (unsigned long long)pk2(o.x, o.y) | ((unsigned long long)pk2(o.z, o.w) << 32);
            else { bf16* vt = (bf16*)(ws + WS_VTC) + ((size_t)(b * 2 + g) * 64 + d0) * 128 + n; vt[0] = (bf16)f2bf(o.x); vt[128] = (bf16)f2bf(o.y); vt[256] = (bf16)f2bf(o.z); vt[384] = (bf16)f2bf(o.w); } }
        __syncthreads();
    }
    if (blockIdx.x == 0) for (int i = F.tid; i < 16 * 64; i += NTHR) { const int bg = i >> 6, d = i & 63; ((bf16*)(ws + WS_KC))[((size_t)bg * 128 + 127) * 64 + d] = 0; ((bf16*)(ws + WS_VTC))[((size_t)bg * 64 + d) * 128 + 127] = 0; }
}


__device__ __forceinline__ float logsig_f(float x) { return fminf(x, 0.f) - __logf(1.f + __expf(-fabsf(x))); }
__device__ __forceinline__ void gla_cumsum(Frame& F, const Args& a, int row0, int h, LAS float* Bc, LAS float* seg) {
    const float* narrow = (const float*)(a.ws + WS_NARROW); const float* w_a2 = (const float*)a.in[14]; const float* b_a = (const float*)a.in[15];
    { const int c = F.tid >> 3, dk0 = (F.tid & 7) * 8; const float* ar = narrow + (size_t)(row0 + c) * 64;
      const f32x4 a0 = *(const f32x4*)(ar), a1 = *(const f32x4*)(ar + 4), a2 = *(const f32x4*)(ar + 8), a3 = *(const f32x4*)(ar + 12);
      const float ag[16] = {a0.x, a0.y, a0.z, a0.w, a1.x, a1.y, a1.z, a1.w, a2.x, a2.y, a2.z, a2.w, a3.x, a3.y, a3.z, a3.w};
      f32x4 l0 = *(const f32x4*)(b_a + h * 64 + dk0), l1 = *(const f32x4*)(b_a + h * 64 + dk0 + 4);
#pragma unroll
      for (int r = 0; r < 16; ++r) { l0 += *(const f32x4*)(w_a2 + r * 256 + h * 64 + dk0) * ag[r]; l1 += *(const f32x4*)(w_a2 + r * 256 + h * 64 + dk0 + 4) * ag[r]; }
#pragma unroll
      for (int e = 0; e < 4; ++e) { Bc[c * 65 + dk0 + e] = logsig_f(l0[e]) * 0.0625f; Bc[c * 65 + dk0 + 4 + e] = logsig_f(l1[e]) * 0.0625f; } }
    __syncthreads();
    const int dk = F.tid & 63, sg = F.tid >> 6;
    { float run = 0.f;
#pragma unroll
      for (int i = 0; i < 8; ++i) { run += Bc[(sg * 8 + i) * 65 + dk]; Bc[(sg * 8 + i) * 65 + dk] = run; }
      seg[sg * 64 + dk] = run; }
    __syncthreads();
    { float off = 0.f;
#pragma unroll
      for (int s2 = 0; s2 < 8; ++s2) off += (s2 < sg) ? seg[s2 * 64 + dk] : 0.f;
#pragma unroll
      for (int i = 0; i < 8; ++i) Bc[(sg * 8 + i) * 65 + dk] += off; }
    __syncthreads();
}
__device__ __forceinline__ void gla_load_vt(Frame& F, const bf16* ZB, int row0, int h, LAS bf16* VT) {
#pragma unroll
    for (int q = 0; q < 2; ++q) { const int ch = F.tid + q * NTHR, c = ch >> 4, dv0 = (ch & 15) * 8;
        const bf16x8 vx = *(const bf16x8*)(ZB + (size_t)(row0 + c) * ZN + PZ_VG + h * 128 + dv0);
#pragma unroll
        for (int e = 0; e < 8; ++e) VT[(dv0 + e) * 72 + c] = (bf16)vx[e]; }
}
__device__ __forceinline__ void gla_a(Frame& F0, const Args& a) { Frame F = launder(F0);
    unsigned char* ws = a.ws; const bf16* ZB = (const bf16*)(ws + WS_ZB); float* glas = (float*)(ws + WS_GLAS); float* glad = (float*)(ws + WS_GLAD);
    LAS float* Bc = (LAS float*)(F.lds + RING_OFF); LAS float* seg = (LAS float*)(F.lds + RING_OFF + 16640);
    LAS bf16* KT = (LAS bf16*)(F.lds + RING_OFF + 18688); LAS bf16* VT = (LAS bf16*)(F.lds + RING_OFF + 73984);
    const int lr = F.lane & 15, quad = F.lane >> 4;
    for (int unit = blockIdx.x; unit < 1024; unit += F.G) { const int b = unit >> 7, h = (unit >> 5) & 3, n = unit & 31, row0 = b * 2048 + n * 64;
        gla_cumsum(F, a, row0, h, Bc, seg);
        { const int c = F.tid >> 3, dk0 = (F.tid & 7) * 8; const bf16x8 kx = *(const bf16x8*)(ZB + (size_t)(row0 + c) * ZN + PZ_KG + h * 64 + dk0);
#pragma unroll
          for (int e = 0; e < 8; ++e) KT[(dk0 + e) * 72 + c] = (bf16)f2bf(bf2f((unsigned short)kx[e]) * __expf(Bc[63 * 65 + dk0 + e] - Bc[c * 65 + dk0 + e])); }
        gla_load_vt(F, ZB, row0, h, VT);
        if (F.tid < 64) glad[(size_t)unit * 64 + F.tid] = __expf(Bc[63 * 65 + F.tid]);
        __syncthreads();
#pragma unroll
        for (int it = 0; it < 4; ++it) { f32x4 acc = {0.f, 0.f, 0.f, 0.f};
#pragma unroll
            for (int ks = 0; ks < 2; ++ks) { const bf16x8 af = *(const LAS bf16x8*)(KT + (16 * it + lr) * 72 + 32 * ks + 8 * quad), bf = *(const LAS bf16x8*)(VT + (16 * F.wave + lr) * 72 + 32 * ks + 8 * quad);
                acc = __builtin_amdgcn_mfma_f32_16x16x32_bf16(af, bf, acc, 0, 0, 0); }
            *(GAS f32x4*)(glas + ((size_t)unit * 128 + 16 * F.wave + lr) * 64 + 16 * it + 4 * quad) = acc; }
        __syncthreads();
    }
}
__device__ __forceinline__ void gla_scan(Frame& F0, const Args& a) { Frame F = launder(F0);
    float* glas = (float*)(a.ws + WS_GLAS); const float* glad = (const float*)(a.ws + WS_GLAD);
    for (int idx = blockIdx.x * NTHR + F.tid; idx < 32 * 8192; idx += F.G * NTHR) { const int bh = idx >> 13, rest = idx & 8191, dk = rest & 63, dv = rest >> 6;
        float kv[32], d[32];
#pragma unroll
        for (int n = 0; n < 32; ++n) { kv[n] = glas[((size_t)(bh * 32 + n)) * 8192 + rest]; d[n] = glad[(size_t)(bh * 32 + n) * 64 + dk]; }
        float S = 0.f;
#pragma unroll
        for (int n = 0; n < 32; ++n) { glas[((size_t)(bh * 32 + n)) * 8192 + rest] = S; S = d[n] * S + kv[n]; }
        a.out[O_GSP + ((size_t)bh * 64 + dk) * 128 + dv] = S; }
}
__device__ __forceinline__ void gla_c(Frame& F0, const Args& a) { Frame F = launder(F0);
    unsigned char* ws = a.ws; const bf16* ZB = (const bf16*)(ws + WS_ZB); const float* glas = (const float*)(ws + WS_GLAS); bf16* ATT = (bf16*)(ws + WS_ATT);
    const float* gamma = (const float*)a.in[16];
    LAS float* Bc = (LAS float*)(F.lds + RING_OFF); LAS float* seg = (LAS float*)(F.lds + RING_OFF + 16640);
    LAS bf16* QH = (LAS bf16*)(F.lds + RING_OFF + 18688); LAS bf16* KH = (LAS bf16*)(F.lds + RING_OFF + 27904); LAS bf16* QT = (LAS bf16*)(F.lds + RING_OFF + 37120);
    LAS bf16* AM = (LAS bf16*)(F.lds + RING_OFF + 46336); LAS bf16* ST = (LAS bf16*)(F.lds + RING_OFF + 55552); LAS bf16* VT = (LAS bf16*)(F.lds + RING_OFF + 73984);
    LAS float* ssq = (LAS float*)(F.lds + RING_OFF + 92416);
    const int lr = F.lane & 15, quad = F.lane >> 4;
    for (int unit = blockIdx.x; unit < 1024; unit += F.G) { const int b = unit >> 7, h = (unit >> 5) & 3, n = unit & 31, row0 = b * 2048 + n * 64;
        gla_cumsum(F, a, row0, h, Bc, seg);
        { const int c = F.tid >> 3, dk0 = (F.tid & 7) * 8; const bf16* zr = ZB + (size_t)(row0 + c) * ZN + h * 64 + dk0;
          const bf16x8 qx = *(const bf16x8*)(zr + PZ_QG), kx = *(const bf16x8*)(zr + PZ_KG); float qh[8], kh[8], qt[8];
#pragma unroll
          for (int e = 0; e < 8; ++e) { const float bc = Bc[c * 65 + dk0 + e], bm = Bc[31 * 65 + dk0 + e], q = bf2f((unsigned short)qx[e]), k = bf2f((unsigned short)kx[e]);
              qh[e] = q * __expf(bc - bm); kh[e] = k * __expf(bm - bc); qt[e] = q * __expf(bc); }
          v4u w; w.x = pk2(qh[0], qh[1]); w.y = pk2(qh[2], qh[3]); w.z = pk2(qh[4], qh[5]); w.w = pk2(qh[6], qh[7]); *(LAS v4u*)(QH + c * 72 + dk0) = w;
          w.x = pk2(kh[0], kh[1]); w.y = pk2(kh[2], kh[3]); w.z = pk2(kh[4], kh[5]); w.w = pk2(kh[6], kh[7]); *(LAS v4u*)(KH + c * 72 + dk0) = w;
          w.x = pk2(qt[0], qt[1]); w.y = pk2(qt[2], qt[3]); w.z = pk2(qt[4], qt[5]); w.w = pk2(qt[6], qt[7]); *(LAS v4u*)(QT + c * 72 + dk0) = w; }
#pragma unroll
        for (int q = 0; q < 2; ++q) { const int ch = F.tid + q * NTHR, dv = ch >> 3, dk0 = (ch & 7) * 8; const float* sp = glas + ((size_t)unit * 128 + dv) * 64 + dk0;
            const f32x4 s0 = *(const GAS f32x4*)sp, s1 = *(const GAS f32x4*)(sp + 4);
            v4u w; w.x = pk2(s0.x, s0.y); w.y = pk2(s0.z, s0.w); w.z = pk2(s1.x, s1.y); w.w = pk2(s1.z, s1.w); *(LAS v4u*)(ST + dv * 72 + dk0) = w; }
        gla_load_vt(F, ZB, row0, h, VT);
        __syncthreads();
        { const int it = F.wave >> 1;
#pragma unroll
          for (int jj = 0; jj < 2; ++jj) { const int jt = 2 * (F.wave & 1) + jj; f32x4 acc = {0.f, 0.f, 0.f, 0.f};
#pragma unroll
              for (int ks = 0; ks < 2; ++ks) { const bf16x8 af = *(const LAS bf16x8*)(QH + (16 * it + lr) * 72 + 32 * ks + 8 * quad), bf = *(const LAS bf16x8*)(KH + (16 * jt + lr) * 72 + 32 * ks + 8 * quad);
                  acc = __builtin_amdgcn_mfma_f32_16x16x32_bf16(af, bf, acc, 0, 0, 0); }
#pragma unroll
              for (int e = 0; e < 4; ++e) { const int i = 16 * it + 4 * quad + e, j = 16 * jt + lr; AM[i * 72 + j] = (bf16)f2bf(j <= i ? acc[e] : 0.f); } } }
        __syncthreads();
        { const int it = F.wave >> 1; f32x4 acc[4]; float sq = 0.f;
#pragma unroll
          for (int mm = 0; mm < 4; ++mm) { const int mt = 4 * (F.wave & 1) + mm; acc[mm] = (f32x4){0.f, 0.f, 0.f, 0.f};
#pragma unroll
              for (int ks = 0; ks < 2; ++ks) { const bf16x8 af = *(const LAS bf16x8*)(VT + (16 * mt + lr) * 72 + 32 * ks + 8 * quad), bf = *(const LAS bf16x8*)(AM + (16 * it + lr) * 72 + 32 * ks + 8 * quad);
                  acc[mm] = __builtin_amdgcn_mfma_f32_16x16x32_bf16(af, bf, acc[mm], 0, 0, 0); }
#pragma unroll
              for (int ks = 0; ks < 2; ++ks) { const bf16x8 af = *(const LAS bf16x8*)(ST + (16 * mt + lr) * 72 + 32 * ks + 8 * quad), bf = *(const LAS bf16x8*)(QT + (16 * it + lr) * 72 + 32 * ks + 8 * quad);
                  acc[mm] = __builtin_amdgcn_mfma_f32_16x16x32_bf16(af, bf, acc[mm], 0, 0, 0); }
              sq += (acc[mm].x * acc[mm].x + acc[mm].y * acc[mm].y) + (acc[mm].z * acc[mm].z + acc[mm].w * acc[mm].w); }
          sq += xor_f<16>(sq); sq = swap32_sum(sq);
          if (quad == 0) ssq[(F.wave & 1) * 64 + 16 * it + lr] = sq;
          __syncthreads();
          const int i = 16 * it + lr; const float rs = rsqrtf((ssq[i] + ssq[64 + i]) * (1.f / 128.f) + 1e-6f);
#pragma unroll
          for (int mm = 0; mm < 4; ++mm) { const int dv0 = 16 * (4 * (F.wave & 1) + mm) + 4 * quad; const f32x4 gm = *(const f32x4*)(gamma + dv0);
              const unsigned long long rgw = *(const GAS unsigned long long*)(ZB + (size_t)(row0 + i) * ZN + PZ_RG + h * 128 + dv0); float o[4];
#pragma unroll
              for (int e = 0; e < 4; ++e) { const float rg = bf2f((unsigned short)(rgw >> (16 * e))); o[e] = acc[mm][e] * rs * gm[e] * rg / (1.f + __expf(-rg)); }
              *(GAS unsigned long long*)(ATT + (size_t)(row0 + i) * 1024 + h * 128 + dv0) = (unsigned long long)pk2(o[0], o[1]) | ((unsigned long long)pk2(o[2], o[3]) << 32); } }
        __syncthreads();
    }
}
__device__ __forceinline__ void gla_sample(Frame& F0, const Args& a) { Frame F = launder(F0);
    unsigned char* ws = a.ws; const bf16* ZB = (const bf16*)(ws + WS_ZB); const float* narrow = (const float*)(ws + WS_NARROW); bf16* ATT = (bf16*)(ws + WS_ATT);
    const float* st0 = (const float*)a.in[2]; const float* w_a2 = (const float*)a.in[14]; const float* b_a = (const float*)a.in[15]; const float* gamma = (const float*)a.in[16];
    LAS float* par = (LAS float*)(F.lds + RING_OFF); LAS float* tot = (LAS float*)(F.lds + RING_OFF + 4096); LAS float* gk = (LAS float*)(F.lds + RING_OFF + 8192);
    const int dv = F.tid & 127, dq = F.tid >> 7;
    for (int unit = blockIdx.x; unit < 128; unit += F.G) { const int b = unit >> 2, h = unit & 3;
        float S[16];
#pragma unroll
        for (int e = 0; e < 16; ++e) S[e] = st0[((size_t)unit * 64 + dq * 16 + e) * 128 + dv];
        for (int t = 0; t < 4; ++t) { const size_t row = (size_t)RP + b * 4 + t;
            if (F.tid < 64) { const int dk = h * 64 + F.tid; const float* ar = narrow + row * 64; float lg = b_a[dk];
#pragma unroll
                for (int r = 0; r < 16; ++r) lg += ar[r] * w_a2[r * 256 + dk];
                gk[F.tid] = __expf(logsig_f(lg) * 0.0625f); gk[64 + F.tid] = bf2f(ZB[row * ZN + PZ_KG + dk]); gk[128 + F.tid] = bf2f(ZB[row * ZN + PZ_QG + dk]); }
            __syncthreads();
            const float vv = bf2f(ZB[row * ZN + PZ_VG + h * 128 + dv]); float op = 0.f;
#pragma unroll
            for (int e = 0; e < 16; ++e) { const int dl = dq * 16 + e; S[e] = gk[dl] * S[e] + gk[64 + dl] * vv; op += gk[128 + dl] * S[e]; }
            par[dq * 128 + dv] = op; __syncthreads();
            const float o = (par[dv] + par[128 + dv]) + (par[256 + dv] + par[384 + dv]);
            if (F.tid < 128) { const float q = wave_sum(o * o); if (F.lane == 0) tot[F.wave] = q; }
            __syncthreads();
            if (F.tid < 128) { const float rs = rsqrtf((tot[0] + tot[1]) * (1.f / 128.f) + 1e-6f); const float rg = bf2f(ZB[row * ZN + PZ_RG + h * 128 + dv]);
                ATT[row * 1024 + h * 128 + dv] = (bf16)f2bf(o * rs * gamma[dv] * rg / (1.f + __expf(-rg))); }
            __syncthreads(); }
#pragma unroll
        for (int e = 0; e < 16; ++e) a.out[O_GSS + ((size_t)unit * 64 + dq * 16 + e) * 128 + dv] = S[e];
    }
}


__device__ __forceinline__ void make_vt(Frame& F0, const Args& a) { Frame F = launder(F0);
    unsigned char* ws = a.ws; const bf16* ZB = (const bf16*)(ws + WS_ZB);
    LAS bf16* T = (LAS bf16*)(F.lds + RING_OFF + F.wave * 9216);
    const int gw = F.vcu * NWAVES + F.wave, NGW = F.G * NWAVES;
    for (int it = gw; it < 1024; it += NGW) { const int which = it >> 9, b = (it >> 6) & 7, g = (it >> 5) & 1, tile = it & 31;
        const bf16* src = ZB + ((size_t)b * 2048 + 64 * tile) * ZN + (which ? PZ_KVW : PZ_KVS) + 128 + g * 64;
        bf16* dst = (bf16*)(ws + (which ? WS_VTW : WS_VTS)) + ((size_t)(b * 2 + g) * 64) * 2048 + 64 * tile;
#pragma unroll
        for (int i = 0; i < 8; ++i) { const int ch = i * 64 + F.lane, tok = ch >> 3, c8 = ch & 7; const bf16x8 x = *(const bf16x8*)(src + (size_t)tok * ZN + c8 * 8);
#pragma unroll
            for (int e = 0; e < 8; ++e) T[(c8 * 8 + e) * 72 + tok] = (bf16)x[e]; }
        LDS_WAIT(); asm volatile("" ::: "memory");
#pragma unroll
        for (int i = 0; i < 8; ++i) { const int ch = i * 64 + F.lane, d = ch >> 3, c8 = ch & 7; *(GAS v4u*)(dst + (size_t)d * 2048 + c8 * 8) = *(const LAS v4u*)(T + d * 72 + c8 * 8); }
        LDS_WAIT(); asm volatile("" ::: "memory");
    }
}
typedef float f32x16 __attribute__((ext_vector_type(16)));
constexpr float L2E = 1.4426950408889634f, NEGB = -1.0e30f;
constexpr int A_K0 = 0, A_K1 = 9216, A_V0 = 18432, A_V1 = 27136, A_IMPH = 36864, A_IMPC = 70656, A_SC = 104448, A_MASK = 112896;
struct AttnSt { float m, l; f32x16 o0, o1; };
__device__ __forceinline__ unsigned bfpair(float lo, float hi) { return pk2(lo, hi); }
__device__ __forceinline__ void attn_tile(const LAS bf16* Kb, const LAS bf16* Vb, const bf16x8 (&qr)[4], AttnSt& st, int mode, int itok, bool on, int lane) {
    const int q = lane & 31, hi = lane >> 5;
    f32x16 p0, p1;
#pragma unroll
    for (int r = 0; r < 16; ++r) { p0[r] = 0.f; p1[r] = 0.f; }
#pragma unroll
    for (int ds = 0; ds < 4; ++ds) { const bf16x8 k0 = *(const LAS bf16x8*)(Kb + q * 72 + 16 * ds + 8 * hi), k1 = *(const LAS bf16x8*)(Kb + (q + 32) * 72 + 16 * ds + 8 * hi);
        p0 = __builtin_amdgcn_mfma_f32_32x32x16_bf16(k0, qr[ds], p0, 0, 0, 0); p1 = __builtin_amdgcn_mfma_f32_32x32x16_bf16(k1, qr[ds], p1, 0, 0, 0); __builtin_amdgcn_sched_barrier(0); }
    float mx = NEGB;
#pragma unroll
    for (int r = 0; r < 16; ++r) { const int kv = (r & 3) + 8 * (r >> 2) + 4 * hi;
        const bool ok0 = on && (mode == 0 || (mode == 1 ? kv <= itok : kv > itok)), ok1 = on && (mode == 0 || (mode == 1 ? kv + 32 <= itok : kv + 32 > itok));
        p0[r] = ok0 ? p0[r] * L2E : NEGB; p1[r] = ok1 ? p1[r] * L2E : NEGB; mx = fmaxf(mx, fmaxf(p0[r], p1[r])); }
    mx = swap32_max(mx);
    const float mn = fmaxf(st.m, mx), alpha = __builtin_amdgcn_exp2f(st.m - mn); st.m = mn;
    float sum = 0.f;
#pragma unroll
    for (int r = 0; r < 16; ++r) { p0[r] = __builtin_amdgcn_exp2f(p0[r] - mn); p1[r] = __builtin_amdgcn_exp2f(p1[r] - mn); sum += p0[r] + p1[r]; }
    st.l = st.l * alpha + sum;
    if (__any(alpha != 1.0f)) { st.o0 *= alpha; st.o1 *= alpha; }
    __builtin_amdgcn_sched_barrier(0);
    bf16x8 pf[4];
#pragma unroll
    for (int s = 0; s < 4; ++s) { const f32x16& p = (s < 2) ? p0 : p1; const int o = 8 * (s & 1);
        v4u w; w.x = bfpair(p[o], p[o + 1]); w.y = bfpair(p[o + 2], p[o + 3]); w.z = bfpair(p[o + 4], p[o + 5]); w.w = bfpair(p[o + 6], p[o + 7]); pf[s] = __builtin_bit_cast(bf16x8, w); }
    __builtin_amdgcn_sched_barrier(0);
#pragma unroll
    for (int s = 0; s < 4; ++s) {
        typedef unsigned long long u64; typedef u64 u64x2 __attribute__((ext_vector_type(2)));
        u64x2 va, vb; va.x = *(const LAS u64*)(Vb + q * 68 + 16 * s + 4 * hi); va.y = *(const LAS u64*)(Vb + q * 68 + 16 * s + 8 + 4 * hi);
        vb.x = *(const LAS u64*)(Vb + (q + 32) * 68 + 16 * s + 4 * hi); vb.y = *(const LAS u64*)(Vb + (q + 32) * 68 + 16 * s + 8 + 4 * hi);
        st.o0 = __builtin_amdgcn_mfma_f32_32x32x16_bf16(__builtin_bit_cast(bf16x8, va), pf[s], st.o0, 0, 0, 0);
        st.o1 = __builtin_amdgcn_mfma_f32_32x32x16_bf16(__builtin_bit_cast(bf16x8, vb), pf[s], st.o1, 0, 0, 0); __builtin_amdgcn_sched_barrier(0); }
}
struct TileRegs { v4u k, v; };
__device__ __forceinline__ void tile_fetch(TileRegs& t, const bf16* kbase, size_t kpitch, const bf16* vbase, size_t vpitch, int tid) {
    const int row = tid >> 3, c8 = tid & 7; t.k = *(const GAS v4u*)(kbase + (size_t)row * kpitch + c8 * 8); t.v = *(const GAS v4u*)(vbase + (size_t)row * vpitch + c8 * 8); }
__device__ __forceinline__ void tile_store(const TileRegs& t, LAS bf16* Kb, LAS bf16* Vb, int tid) {
    typedef unsigned long long u64; const int row = tid >> 3, c8 = tid & 7; *(LAS v4u*)(Kb + row * 72 + c8 * 8) = t.k;
    *(LAS u64*)(Vb + row * 68 + c8 * 8) = (u64)t.v.x | ((u64)t.v.y << 32); *(LAS u64*)(Vb + row * 68 + c8 * 8 + 4) = (u64)t.v.z | ((u64)t.v.w << 32); }

__device__ __forceinline__ void nsa_prompt_unit(Frame& F, const Args& a, int b, int g, int qb) {
    unsigned char* ws = a.ws; const bf16* ZB = (const bf16*)(ws + WS_ZB); const float* narrow = (const float*)(ws + WS_NARROW); bf16* ATT = (bf16*)(ws + WS_ATT);
    LAS bf16* KB0 = (LAS bf16*)(F.lds + RING_OFF + A_K0); LAS bf16* KB1 = (LAS bf16*)(F.lds + RING_OFF + A_K1); LAS bf16* VB0 = (LAS bf16*)(F.lds + RING_OFF + A_V0); LAS bf16* VB1 = (LAS bf16*)(F.lds + RING_OFF + A_V1);
    LAS float* IMPH = (LAS float*)(F.lds + RING_OFF + A_IMPH); LAS float* IMPC = (LAS float*)(F.lds + RING_OFF + A_IMPC); LAS float* SC = (LAS float*)(F.lds + RING_OFF + A_SC);
    LAS unsigned* MASK = (LAS unsigned*)(F.lds + RING_OFF + A_MASK);
    const int lane = F.lane, q = lane & 31, hi = lane >> 5, r = F.wave >> 1, th = F.wave & 1, itok = 32 * th + q, t0 = 64 * qb, t = t0 + itok, h = g * 4 + r;
    const size_t row = (size_t)b * 2048 + t;
    bf16x8 qr[4];
#pragma unroll
    for (int ds = 0; ds < 4; ++ds) qr[ds] = *(const bf16x8*)(ZB + row * ZN + PZ_QN + h * 64 + 16 * ds + 8 * hi);
    float gate[3];
#pragma unroll
    for (int br = 0; br < 3; ++br) { const float gx = narrow[row * 64 + 16 + h * 3 + br]; gate[br] = 1.f / (1.f + __expf(-gx)); }
    f32x16 oc0, oc1;
    LAS float* stg = (LAS float*)(F.lds + RING_OFF + A_IMPH) + F.wave * 2048 + lane;
    { const bf16* kc = (const bf16*)(ws + WS_KC) + (size_t)(b * 2 + g) * 128 * 64; const bf16* vtc = (const bf16*)(ws + WS_VTC) + (size_t)(b * 2 + g) * 64 * 128;
      TileRegs ta, tb; tile_fetch(ta, kc, 64, vtc, 128, F.tid); tile_fetch(tb, kc + 64 * 64, 64, vtc + 64, 128, F.tid);
      tile_store(ta, KB0, VB0, F.tid); tile_store(tb, KB1, VB1, F.tid);
      __syncthreads();
      f32x16 pa0, pa1, pb0, pb1;
#pragma unroll
      for (int rr = 0; rr < 16; ++rr) { pa0[rr] = 0.f; pa1[rr] = 0.f; pb0[rr] = 0.f; pb1[rr] = 0.f; }
#pragma unroll
      for (int ds = 0; ds < 4; ++ds) { const int ko = 16 * ds + 8 * hi;
          pa0 = __builtin_amdgcn_mfma_f32_32x32x16_bf16(*(const LAS bf16x8*)(KB0 + q * 72 + ko), qr[ds], pa0, 0, 0, 0); pa1 = __builtin_amdgcn_mfma_f32_32x32x16_bf16(*(const LAS bf16x8*)(KB0 + (q + 32) * 72 + ko), qr[ds], pa1, 0, 0, 0);
          pb0 = __builtin_amdgcn_mfma_f32_32x32x16_bf16(*(const LAS bf16x8*)(KB1 + q * 72 + ko), qr[ds], pb0, 0, 0, 0); pb1 = __builtin_amdgcn_mfma_f32_32x32x16_bf16(*(const LAS bf16x8*)(KB1 + (q + 32) * 72 + ko), qr[ds], pb1, 0, 0, 0); }
      const int nmax = t >= 31 ? ((t - 31) >> 4) : -1; float mx = NEGB;
#pragma unroll
      for (int rr = 0; rr < 16; ++rr) { const int kv = (rr & 3) + 8 * (rr >> 2) + 4 * hi;
          pa0[rr] = (kv <= nmax) ? pa0[rr] * L2E : NEGB; pa1[rr] = (kv + 32 <= nmax) ? pa1[rr] * L2E : NEGB; pb0[rr] = (kv + 64 <= nmax) ? pb0[rr] * L2E : NEGB; pb1[rr] = (kv + 96 <= nmax) ? pb1[rr] * L2E : NEGB;
          mx = fmaxf(fmaxf(mx, fmaxf(pa0[rr], pa1[rr])), fmaxf(pb0[rr], pb1[rr])); }
      mx = swap32_max(mx); float sum = 0.f;
#pragma unroll
      for (int rr = 0; rr < 16; ++rr) { const int kv = (rr & 3) + 8 * (rr >> 2) + 4 * hi;
          pa0[rr] = (kv <= nmax) ? __builtin_amdgcn_exp2f(pa0[rr] - mx) : 0.f; pa1[rr] = (kv + 32 <= nmax) ? __builtin_amdgcn_exp2f(pa1[rr] - mx) : 0.f;
          pb0[rr] = (kv + 64 <= nmax) ? __builtin_amdgcn_exp2f(pb0[rr] - mx) : 0.f; pb1[rr] = (kv + 96 <= nmax) ? __builtin_amdgcn_exp2f(pb1[rr] - mx) : 0.f;
          sum += (pa0[rr] + pa1[rr]) + (pb0[rr] + pb1[rr]); }
      sum = swap32_sum(sum); const float inv = sum > 0.f ? 1.f / sum : 0.f;
#pragma unroll
      for (int rr = 0; rr < 16; ++rr) { pa0[rr] *= inv; pa1[rr] *= inv; pb0[rr] *= inv; pb1[rr] *= inv; }
      { LAS float* ih = IMPH + (r * 64 + itok) * 33; LAS float* ic = IMPC + (r * 64 + itok) * 33;
        if (hi == 0) ic[0] = 0.f;
#pragma unroll
        for (int rg = 0; rg < 4; ++rg) {
            const int j0 = 2 * rg + hi;
            ih[j0] = (pa0[4 * rg] + pa0[4 * rg + 1]) + (pa0[4 * rg + 2] + pa0[4 * rg + 3]); ic[j0 + 1] = pa0[4 * rg + 3];
            ih[j0 + 8] = (pa1[4 * rg] + pa1[4 * rg + 1]) + (pa1[4 * rg + 2] + pa1[4 * rg + 3]); ic[j0 + 9] = pa1[4 * rg + 3];
            ih[j0 + 16] = (pb0[4 * rg] + pb0[4 * rg + 1]) + (pb0[4 * rg + 2] + pb0[4 * rg + 3]); ic[j0 + 17] = pb0[4 * rg + 3];
            ih[j0 + 24] = (pb1[4 * rg] + pb1[4 * rg + 1]) + (pb1[4 * rg + 2] + pb1[4 * rg + 3]); ic[j0 + 25] = pb1[4 * rg + 3]; } }
#pragma unroll
      for (int rr = 0; rr < 16; ++rr) { oc0[rr] = 0.f; oc1[rr] = 0.f; }
#pragma unroll
      for (int s = 0; s < 8; ++s) { const f32x16& p = (s < 2) ? pa0 : (s < 4) ? pa1 : (s < 6) ? pb0 : pb1; const int o = 8 * (s & 1); const LAS bf16* Vb = (s < 4) ? VB0 : VB1; const int sl = s & 3;
          v4u w; w.x = bfpair(p[o], p[o + 1]); w.y = bfpair(p[o + 2], p[o + 3]); w.z = bfpair(p[o + 4], p[o + 5]); w.w = bfpair(p[o + 6], p[o + 7]); const bf16x8 pf = __builtin_bit_cast(bf16x8, w);
          typedef unsigned long long u64; typedef u64 u64x2 __attribute__((ext_vector_type(2)));
          u64x2 va, vb; va.x = *(const LAS u64*)(Vb + q * 68 + 16 * sl + 4 * hi); va.y = *(const LAS u64*)(Vb + q * 68 + 16 * sl + 8 + 4 * hi);
          vb.x = *(const LAS u64*)(Vb + (q + 32) * 68 + 16 * sl + 4 * hi); vb.y = *(const LAS u64*)(Vb + (q + 32) * 68 + 16 * sl + 8 + 4 * hi);
          oc0 = __builtin_amdgcn_mfma_f32_32x32x16_bf16(__builtin_bit_cast(bf16x8, va), pf, oc0, 0, 0, 0); oc1 = __builtin_amdgcn_mfma_f32_32x32x16_bf16(__builtin_bit_cast(bf16x8, vb), pf, oc1, 0, 0, 0); }
      oc0 *= gate[0]; oc1 *= gate[0];
    }
    __syncthreads();
    if (qb >= 16) {
        const int tok = F.tid >> 3, jg = F.tid & 7;
#pragma unroll
        for (int e = 0; e < 4; ++e) { const int j = jg * 4 + e; float im = 0.f;
#pragma unroll
            for (int hh = 0; hh < 4; ++hh) im += IMPH[(hh * 64 + tok) * 33 + j] + IMPC[(hh * 64 + tok) * 33 + j];
            const bool forced = (j == 0) || (j == qb) || (j == qb - 1);
            SC[tok * 33 + j] = (j <= qb) ? im + (forced ? 1.0e4f : 0.f) : -INFINITY; }
        __syncthreads();
        unsigned bits = 0u;
#pragma unroll
        for (int e = 0; e < 4; ++e) { const int j = jg * 4 + e; const float sj = SC[tok * 33 + j]; int cnt = 0;
            for (int k = 0; k < 32; ++k) { const float sk = SC[tok * 33 + k]; cnt += (sk > sj || (sk == sj && k < j)) ? 1 : 0; }
            bits |= (cnt < 16 ? 1u : 0u) << j; }
        MASK[tok * 8 + jg] = bits;
        __syncthreads();
    }
    unsigned selmask = 0xffffffffu;
    if (qb >= 16) { const v4u m0 = *(const LAS v4u*)(MASK + itok * 8), m1 = *(const LAS v4u*)(MASK + itok * 8 + 4); selmask = (m0.x | m0.y) | (m0.z | m0.w) | (m1.x | m1.y) | (m1.z | m1.w); }
#pragma unroll
    for (int rr = 0; rr < 16; ++rr) { stg[rr * 64] = oc0[rr]; stg[(16 + rr) * 64] = oc1[rr]; }
    { AttnSt st; st.m = NEGB; st.l = 0.f;
#pragma unroll
      for (int rr = 0; rr < 16; ++rr) { st.o0[rr] = 0.f; st.o1[rr] = 0.f; }
      const bf16* kb = ZB + (size_t)b * 2048 * ZN + PZ_KVS + g * 64; const bf16* vb = (const bf16*)(ws + WS_VTS) + (size_t)(b * 2 + g) * 64 * 2048;
      TileRegs tr; tile_fetch(tr, kb, ZN, vb, 2048, F.tid);
      for (int j = 0; j <= qb; ++j) { LAS bf16* Kb = (j & 1) ? KB1 : KB0; LAS bf16* Vb = (j & 1) ? VB1 : VB0;
          tile_store(tr, Kb, Vb, F.tid); __syncthreads();
          if (j < qb) tile_fetch(tr, kb + (size_t)(j + 1) * 64 * ZN, ZN, vb + (j + 1) * 64, 2048, F.tid);
          attn_tile(Kb, Vb, qr, st, j == qb ? 1 : 0, itok, (selmask >> j) & 1u, lane); }
      const float l = swap32_sum(st.l), f = gate[1] / l;
#pragma unroll
      for (int rr = 0; rr < 16; ++rr) { stg[rr * 64] += st.o0[rr] * f; stg[(16 + rr) * 64] += st.o1[rr] * f; } }
    __syncthreads();
    { AttnSt st; st.m = NEGB; st.l = 0.f;
#pragma unroll
      for (int rr = 0; rr < 16; ++rr) { st.o0[rr] = 0.f; st.o1[rr] = 0.f; }
      const bf16* kb = ZB + (size_t)b * 2048 * ZN + PZ_KVW + g * 64; const bf16* vb = (const bf16*)(ws + WS_VTW) + (size_t)(b * 2 + g) * 64 * 2048;
      const int jlo = qb >= 8 ? qb - 8 : 0;
      TileRegs tr; tile_fetch(tr, kb + (size_t)qb * 64 * ZN, ZN, vb + qb * 64, 2048, F.tid);
      for (int j = qb, it = 0; j >= jlo; --j, ++it) { LAS bf16* Kb = (it & 1) ? KB1 : KB0; LAS bf16* Vb = (it & 1) ? VB1 : VB0;
          tile_store(tr, Kb, Vb, F.tid); __syncthreads();
          if (j > jlo) tile_fetch(tr, kb + (size_t)(j - 1) * 64 * ZN, ZN, vb + (j - 1) * 64, 2048, F.tid);
          attn_tile(Kb, Vb, qr, st, j == qb ? 1 : (j == qb - 8 ? 2 : 0), itok, true, lane); }
      const float l = swap32_sum(st.l), f = gate[2] / l;
#pragma unroll
      for (int rr = 0; rr < 16; ++rr) { oc0[rr] = stg[rr * 64] + st.o0[rr] * f; oc1[rr] = stg[(16 + rr) * 64] + st.o1[rr] * f; } }
    __syncthreads();
    { const f32x16& tot0 = oc0; const f32x16& tot1 = oc1; bf16* orow = ATT + row * 1024 + 512 + h * 64;
#pragma unroll
      for (int rg = 0; rg < 4; ++rg) { const int d0 = 8 * rg + 4 * hi;
          *(GAS unsigned long long*)(orow + d0) = (unsigned long long)pk2(tot0[4 * rg], tot0[4 * rg + 1]) | ((unsigned long long)pk2(tot0[4 * rg + 2], tot0[4 * rg + 3]) << 32);
          *(GAS unsigned long long*)(orow + 32 + d0) = (unsigned long long)pk2(tot1[4 * rg], tot1[4 * rg + 1]) | ((unsigned long long)pk2(tot1[4 * rg + 2], tot1[4 * rg + 3]) << 32); } }
}
__device__ __forceinline__ void nsa_prompt(Frame& F0, const Args& a) { Frame F = launder(F0);
    for (int v = blockIdx.x; v < 256; v += F.G) { const int bg = v >> 4, s = v & 15;
        nsa_prompt_unit(F, a, bg >> 1, bg & 1, 31 - s);
        nsa_prompt_unit(F, a, bg >> 1, bg & 1, s); }
}


template <class KP> __device__ __forceinline__ float attend512(Frame& F, int NK, KP kp, LAS float* sc, LAS unsigned long long* kptr, const LAS float* qs, const float* dummy, LAS float* po) {
    int i0 = F.tid; asm volatile("" : "+v"(i0));
    for (int i = i0; i < NK; i += NTHR) { const float* k = kp(i); kptr[i] = (unsigned long long)(uintptr_t)(k ? k : dummy);
        float s0 = NEGB, s1 = NEGB, s2 = NEGB, s3 = NEGB;
        if (k) { s0 = 0.f; s1 = 0.f; s2 = 0.f; s3 = 0.f;
#pragma unroll
            for (int c = 0; c < 16; ++c) { const f32x4 kv = *(const GAS f32x4*)(k + 4 * c);
                const f32x4 q0 = *(const LAS f32x4*)(qs + 4 * c), q1 = *(const LAS f32x4*)(qs + 64 + 4 * c), q2 = *(const LAS f32x4*)(qs + 128 + 4 * c), q3 = *(const LAS f32x4*)(qs + 192 + 4 * c);
                s0 += (kv.x * q0.x + kv.y * q0.y) + (kv.z * q0.z + kv.w * q0.w); s1 += (kv.x * q1.x + kv.y * q1.y) + (kv.z * q1.z + kv.w * q1.w);
                s2 += (kv.x * q2.x + kv.y * q2.y) + (kv.z * q2.z + kv.w * q2.w); s3 += (kv.x * q3.x + kv.y * q3.y) + (kv.z * q3.z + kv.w * q3.w); } }
        sc[i] = s0; sc[1024 + i] = s1; sc[2048 + i] = s2; sc[3072 + i] = s3; }
    __syncthreads();
    if (F.wave < 4) { LAS float* row = sc + F.wave * 1024; float m = NEGB;
        for (int i = F.lane; i < NK; i += 64) m = fmaxf(m, row[i]);
        m = wave_max(m);
        float sum = 0.f;
        for (int i = F.lane; i < NK; i += 64) { const float x = row[i]; const float e = (x > -1.0e29f) ? __expf(x - m) : 0.f; row[i] = e; sum += e; }
        sum = wave_sum(sum); const float inv = 1.f / fmaxf(sum, 1.0e-30f);
        for (int i = F.lane; i < NK; i += 64) row[i] *= inv; }
    __syncthreads();
    { const int part = F.tid >> 6, d = F.tid & 63; float o0 = 0.f, o1 = 0.f, o2 = 0.f, o3 = 0.f;
      int i = part;
      for (; i + 56 < NK; i += 64) { float v[8];
#pragma unroll
          for (int u = 0; u < 8; ++u) v[u] = ((const float*)(uintptr_t)kptr[i + 8 * u])[128 + d];
#pragma unroll
          for (int u = 0; u < 8; ++u) { const int k = i + 8 * u; o0 += sc[k] * v[u]; o1 += sc[1024 + k] * v[u]; o2 += sc[2048 + k] * v[u]; o3 += sc[3072 + k] * v[u]; } }
      for (; i < NK; i += 8) { const float v = ((const float*)(uintptr_t)kptr[i])[128 + d]; o0 += sc[i] * v; o1 += sc[1024 + i] * v; o2 += sc[2048 + i] * v; o3 += sc[3072 + i] * v; }
      po[(part * 4 + 0) * 64 + d] = o0; po[(part * 4 + 1) * 64 + d] = o1; po[(part * 4 + 2) * 64 + d] = o2; po[(part * 4 + 3) * 64 + d] = o3; }
    __syncthreads();
    float res = 0.f;
    { const int r = (F.tid >> 6) & 3, d = F.tid & 63;
#pragma unroll
      for (int p = 0; p < 8; ++p) res += po[(p * 4 + r) * 64 + d]; }
    return res;
}
__device__ __forceinline__ void nsa_sample(Frame& F0, const Args& a) { Frame F = launder(F0);
    unsigned char* ws = a.ws; const bf16* ZB = (const bf16*)(ws + WS_ZB); const float* narrow = (const float*)(ws + WS_NARROW); bf16* ATT = (bf16*)(ws + WS_ATT);
    const float* kcvs = (const float*)(ws + WS_KCVS); const float* cslc = (const float*)a.in[4]; const float* cwin = (const float*)a.in[5]; const int* table = (const int*)a.in[6];
    LAS float* sc = (LAS float*)(F.lds + RING_OFF); LAS unsigned long long* kptr = (LAS unsigned long long*)(F.lds + RING_OFF + 16384); LAS float* qs = (LAS float*)(F.lds + RING_OFF + 24576);
    LAS float* score = (LAS float*)(F.lds + RING_OFF + 25600); LAS unsigned* flag = (LAS unsigned*)(F.lds + RING_OFF + 26656); LAS int* sel = (LAS int*)(F.lds + RING_OFF + 27712);
    LAS float* red = (LAS float*)(F.lds + RING_OFF + 27776); LAS float* po = (LAS float*)(F.lds + RING_OFF + 28032);
    for (int unit = blockIdx.x; unit < 256; unit += F.G) { const int b = unit >> 3, g = (unit >> 2) & 1, s = unit & 3, tq = 16384 + s; const size_t row = (size_t)RP + b * 4 + s;
        if (F.tid < 256) qs[F.tid] = bf2f(ZB[row * ZN + PZ_QN + (g * 4 + (F.tid >> 6)) * 64 + (F.tid & 63)]);
        __syncthreads();
        const float* kc = kcvs + (size_t)b * 1023 * 256 + g * 64;
        const float oc = attend512(F, 1023, [&](int i) -> const float* { return kc + (size_t)i * 256; }, sc, kptr, qs, kc, po);
        for (int j = F.tid; j < 257; j += NTHR) { float im = 0.f;
            for (int i = 4 * j - 1; i <= 4 * j + 3; ++i) if (i >= 0 && i < 1023) im += (sc[i] + sc[1024 + i]) + (sc[2048 + i] + sc[3072 + i]);
            score[j] = im + ((j == 0 || j >= 255) ? 1.0e4f : 0.f); }
        __syncthreads();
        for (int j = F.tid; j < 257; j += NTHR) { const float sj = score[j]; int cnt = 0;
            for (int k = 0; k < 257; ++k) { const float sk = score[k]; cnt += (sk > sj || (sk == sj && k < j)) ? 1 : 0; }
            flag[j] = cnt < 16 ? 1u : 0u; }
        __syncthreads();
        for (int j = F.tid; j < 257; j += NTHR) if (flag[j]) { int pos = 0; for (int k = 0; k < j; ++k) pos += (int)flag[k]; sel[pos] = j; }
        __syncthreads();
        const float os = attend512(F, 1024, [&](int i) -> const float* { const int pos = sel[i >> 6] * 64 + (i & 63); if (pos > tq) return nullptr;
            if (pos < 16384) return cslc + ((size_t)table[b * 128 + (pos >> 7)] * 128 + (pos & 127)) * 256 + g * 64;
            return a.out + O_SKS + (size_t)(b * 4 + (pos - 16384)) * 256 + g * 64; }, sc, kptr, qs, kc, po);
        const float ow = attend512(F, 516, [&](int i) -> const float* { const int tw = 15872 + i; if (tw > tq || tw <= tq - 512) return nullptr;
            return i < 512 ? cwin + ((size_t)b * 512 + i) * 256 + g * 64 : a.out + O_WKS + ((size_t)b * 512 + 508 + (i - 512)) * 256 + g * 64; }, sc, kptr, qs, kc, po);
        if (F.tid < 256) { const int h = g * 4 + (F.tid >> 6), d = F.tid & 63; const float* gn = narrow + row * 64 + 16 + h * 3;
            const float o = oc / (1.f + __expf(-gn[0])) + os / (1.f + __expf(-gn[1])) + ow / (1.f + __expf(-gn[2]));
            ATT[row * 1024 + 512 + h * 64 + d] = (bf16)f2bf(o); }
        __syncthreads();
    }
}

__global__ void __launch_bounds__(NTHR, 2) mega(Args args) {
    extern __shared__ __attribute__((aligned(16))) unsigned char lds[];
    Frame F; F.lds = (LAS unsigned char*)lds; F.tid = threadIdx.x; F.lane = F.tid & 63; F.wave = __builtin_amdgcn_readfirstlane(F.tid >> 6);
    F.G = gridDim.x; { const int bx = blockIdx.x; F.vcu = (F.G % 8 == 0) ? (bx % 8) * (F.G / 8) + bx / 8 : bx; }
    unsigned char* ws = args.ws; F.ctl = (gu32*)(ws + WS_CTL);
    for (int u = F.tid; u < (LDS_BYTES - LDSCTL_OFF) / 4; u += NTHR) ((LAS unsigned*)(F.lds + LDSCTL_OFF))[u] = 0u;
    __syncthreads();
    const int lo = args.ph_lo, hi = args.ph_hi;
    const bool multi = (hi - lo) > 1;
    unsigned* barw = (unsigned*)(F.ctl + CW_BAR) + args.li * XCD_BAR_WORDS;
    XcdBarrier bar; bar.bar = barw; bar.x = 0; bar.st = nullptr;
    if (multi) bar = xcd_barrier_post(barw, (volatile LAS unsigned*)(F.lds + MISC_OFF) + 8);
#ifndef MK_REP
#define MK_REP 0
#endif
#define IN(k) (lo <= (k) && (k) < hi)
#define REP2(k) if constexpr (((MK_REP >> (k)) & 1) != 0)
#define SEAM(k) do { if (IN(k) && IN((k) + 1)) xcd_barrier(bar); } while (0)
    if (IN(0)) { { p0_prologue(F, args); } REP2(0) { p0_prologue(F, args); } } SEAM(0);
    if (IN(1)) { { p1_ln_mod(F, args); } REP2(1) { p1_ln_mod(F, args); } } SEAM(1);
    if (IN(2)) { { pg8::Gemm g{(const pg8::bf16_t*)(ws + WS_U), (const pg8::bf16_t*)(ws + WS_WT_IN), MP, ZN, 1024}; pg8::ComboOrder S; S.init(F.G, (int)blockIdx.x);
        pg8::EpiZ E{(pg8::bf16_t*)(ws + WS_ZB), args.out, (float*)(ws + WS_NARROW), (pg8::bf16_t*)(ws + WS_PCMP)};
        pg8::gemm_phase<pg8::EpiZ, pg8::ComboOrder, true, true>(F.lds + RING_OFF, g, S, E); } REP2(2) { pg8::Gemm g{(const pg8::bf16_t*)(ws + WS_U), (const pg8::bf16_t*)(ws + WS_WT_IN), MP, ZN, 1024}; pg8::ComboOrder S; S.init(F.G, (int)blockIdx.x);
        pg8::EpiZ E{(pg8::bf16_t*)(ws + WS_ZB), args.out, (float*)(ws + WS_NARROW), (pg8::bf16_t*)(ws + WS_PCMP)};
        pg8::gemm_phase<pg8::EpiZ, pg8::ComboOrder, true, true>(F.lds + RING_OFF, g, S, E); } } SEAM(2);
    if (IN(3)) { { cmp_post_sample(F, args); cmp_prompt(F, args); gla_a(F, args); make_vt(F, args); } REP2(3) { cmp_post_sample(F, args); cmp_prompt(F, args); gla_a(F, args); make_vt(F, args); } } SEAM(3);
    if (IN(4)) { { gla_scan(F, args); } REP2(4) { gla_scan(F, args); } } SEAM(4);
    if (IN(5)) { { nsa_prompt(F, args); gla_c(F, args); gla_sample(F, args); nsa_sample(F, args); } REP2(5) { nsa_prompt(F, args); gla_c(F, args); gla_sample(F, args); nsa_sample(F, args); } } SEAM(5);
    if (IN(6)) { { pg8::Gemm g{(const pg8::bf16_t*)(ws + WS_ATT), (const pg8::bf16_t*)(ws + WS_WT_O), MP, 1024, 1024}; pg8::StaticOrder S; S.init(MP, 1024, F.G, (int)blockIdx.x);
        pg8::EpiF32 E{(float*)(ws + WS_H1), 1024};
        pg8::gemm_phase<pg8::EpiF32, pg8::StaticOrder, true, true>(F.lds + RING_OFF, g, S, E); } REP2(6) { pg8::Gemm g{(const pg8::bf16_t*)(ws + WS_ATT), (const pg8::bf16_t*)(ws + WS_WT_O), MP, 1024, 1024}; pg8::StaticOrder S; S.init(MP, 1024, F.G, (int)blockIdx.x);
        pg8::EpiF32 E{(float*)(ws + WS_H1), 1024};
        pg8::gemm_phase<pg8::EpiF32, pg8::StaticOrder, true, true>(F.lds + RING_OFF, g, S, E); } } SEAM(6);
    if (IN(7)) { { p_res_ln<0>(F, args); } REP2(7) { p_res_ln<0>(F, args); } } SEAM(7);
    if (IN(8)) { { pg8::Gemm g{(const pg8::bf16_t*)(ws + WS_U), (const pg8::bf16_t*)(ws + WS_WT_F1), MP, F1N, 1024}; pg8::StaticOrder S; S.init(MP, F1N, F.G, (int)blockIdx.x);
        pg8::EpiSwiglu E{(pg8::bf16_t*)(ws + WS_HM)};
        pg8::gemm_phase<pg8::EpiSwiglu, pg8::StaticOrder, true, true>(F.lds + RING_OFF, g, S, E); } REP2(8) { pg8::Gemm g{(const pg8::bf16_t*)(ws + WS_U), (const pg8::bf16_t*)(ws + WS_WT_F1), MP, F1N, 1024}; pg8::StaticOrder S; S.init(MP, F1N, F.G, (int)blockIdx.x);
        pg8::EpiSwiglu E{(pg8::bf16_t*)(ws + WS_HM)};
        pg8::gemm_phase<pg8::EpiSwiglu, pg8::StaticOrder, true, true>(F.lds + RING_OFF, g, S, E); } } SEAM(8);
    if (IN(9)) { { pg8::Gemm g{(const pg8::bf16_t*)(ws + WS_HM), (const pg8::bf16_t*)(ws + WS_WT_F2), MP, 1024, DFF}; pg8::StaticOrder S; S.init(MP, 1024, F.G, (int)blockIdx.x);
        pg8::EpiF32 E{(float*)(ws + WS_H1), 1024};
        pg8::gemm_phase<pg8::EpiF32, pg8::StaticOrder, true, true>(F.lds + RING_OFF, g, S, E); } REP2(9) { pg8::Gemm g{(const pg8::bf16_t*)(ws + WS_HM), (const pg8::bf16_t*)(ws + WS_WT_F2), MP, 1024, DFF}; pg8::StaticOrder S; S.init(MP, 1024, F.G, (int)blockIdx.x);
        pg8::EpiF32 E{(float*)(ws + WS_H1), 1024};
        pg8::gemm_phase<pg8::EpiF32, pg8::StaticOrder, true, true>(F.lds + RING_OFF, g, S, E); } } SEAM(9);
    if (IN(10)) { { p_res_ln<1>(F, args); } REP2(10) { p_res_ln<1>(F, args); } }
#undef IN
#undef SEAM
}


#if defined(MK_EXTRA)
__global__ void __launch_bounds__(NTHR, 2) probe_k(Args args) {
    extern __shared__ __attribute__((aligned(16))) unsigned char lds[];
    Frame F; F.lds = (LAS unsigned char*)lds; F.tid = threadIdx.x; F.lane = F.tid & 63; F.wave = __builtin_amdgcn_readfirstlane(F.tid >> 6);
    F.G = gridDim.x; { const int bx = blockIdx.x; F.vcu = (F.G % 8 == 0) ? (bx % 8) * (F.G / 8) + bx / 8 : bx; }
    F.ctl = (gu32*)(args.ws + WS_CTL);
    if (MK_EXTRA == 11) nsa_prompt(F, args);
    if (MK_EXTRA == 12) gla_c(F, args);
    if (MK_EXTRA == 13) { gla_sample(F, args); nsa_sample(F, args); }
    if (MK_EXTRA == 14) cmp_post_sample(F, args);
    if (MK_EXTRA == 15) cmp_prompt(F, args);
    if (MK_EXTRA == 16) gla_a(F, args);
    if (MK_EXTRA == 17) make_vt(F, args);
    if (MK_EXTRA == 18) p0_prologue(F, args);
    if (MK_EXTRA == 19) p1_ln_mod(F, args);
    if (MK_EXTRA == 20) gla_scan(F, args);
    if (MK_EXTRA == 21) p_res_ln<0>(F, args);
    if (MK_EXTRA == 22) p_res_ln<1>(F, args);
}
#endif
__global__ void glue_z(const unsigned short* ZB, const float* narrow, float* Z) {
    const int r = blockIdx.x;
    for (int c = threadIdx.x; c < 2856; c += 256) { float v;
        if (c >= 1024 && c < 1040) v = narrow[(size_t)r * 64 + (c - 1024)];
        else if (c >= 2832) v = narrow[(size_t)r * 64 + 16 + (c - 2832)];
        else { const int pc = c < 1024 ? c : c - 16; v = __uint_as_float((unsigned)ZB[(size_t)r * ZN + pc] << 16); if (pc < 256 || (pc >= 1536 && pc < 2048)) v *= 8.f; }
        Z[(size_t)r * 2856 + c] = v; }
}
__global__ void glue_att(const float* ATT, unsigned short* ATTB) {
    const int r = RP + blockIdx.x; for (int c = 512 + threadIdx.x; c < 1024; c += 256) ATTB[(size_t)r * 1024 + c] = (unsigned short)f2bf(ATT[(size_t)r * 1024 + c]);
}
}
#ifndef MK_SPLIT
#define MK_SPLIT 0
#endif
static int g_grid = 0;
extern "C" void kernel_launch(void* const* d_in, const int* in_sizes, int n_in, void* d_out, int out_size, void* d_ws, size_t ws_size, hipStream_t stream) {
    (void)in_sizes; (void)n_in; (void)out_size; (void)ws_size;
    if (!g_grid) { int dev = 0, cus = 0; (void)hipGetDevice(&dev); (void)hipDeviceGetAttribute(&cus, hipDeviceAttributeMultiprocessorCount, dev);
        (void)hipFuncSetAttribute((const void*)fk::mega, hipFuncAttributeMaxDynamicSharedMemorySize, fk::LDS_BYTES); g_grid = cus > 0 ? cus : 256; }
    (void)hipMemsetAsync((char*)d_ws + fk::WS_CTL, 0, fk::CTL_ZERO_BYTES, stream);
    fk::Args a{}; for (int i = 0; i < 28; ++i) a.in[i] = d_in[i]; a.out = (float*)d_out; a.ws = (unsigned char*)d_ws;
#if MK_SPLIT
    for (int p = 0; p <= 10; ++p) { a.ph_lo = p; a.ph_hi = p + 1; a.li = 0; hipLaunchKernelGGL(fk::mega, dim3(g_grid), dim3(fk::NTHR), fk::LDS_BYTES, stream, a); }
#else
    a.ph_lo = 0; a.ph_hi = 11; a.li = 0; hipLaunchKernelGGL(fk::mega, dim3(g_grid), dim3(fk::NTHR), fk::LDS_BYTES, stream, a);
#endif
}
```

```cpp
#include <hip/hip_runtime.h>
#include <cstdio>
#include <cstdint>
#include <cmath>
namespace fc {
constexpr int D = 1024, RP = 16384, RS = 128, R = RP + RS, MP = 16640;
constexpr int ZN = 3072;
constexpr int PZ_QG = 0, PZ_KG = 256, PZ_VG = 512, PZ_RG = 1024, PZ_QN = 1536, PZ_KVC = 2048, PZ_KVS = 2304, PZ_KVW = 2560, PZ_AG = 2816, PZ_GN = 2832;
constexpr int DFF = 2816, F1N = 5632;
constexpr float ALPHA = 1.189207115002721f;
constexpr long O_YP = 0, O_YS = 16777216, O_GSP = 16908288, O_GSS = 17170432, O_CKP = 18219008, O_CKS = 22413312, O_SKP = 22446080, O_SKS = 26640384,
               O_WKP = 26673152, O_WKS = 27721728, O_END = 31916032;
}
namespace pg8 {
#define PG8_LAS __attribute__((address_space(3)))
typedef unsigned short bf16_t;
typedef short bf16x8 __attribute__((ext_vector_type(8)));
typedef float f32x4 __attribute__((ext_vector_type(4)));
typedef unsigned u32x4 __attribute__((ext_vector_type(4)));
constexpr int BM = 256, BK = 64, HALF = 128, HTB = HALF * BK * 2  , STAGE_BYTES = 8 * HTB, NXCD = 8, WGM = 8;

__host__ __device__ __forceinline__ int lds_byte(int r, int c) { const int st = (r >> 4) * 2 + (c >> 5), rr = r & 15, cc = c & 31, ob = rr * 64 + cc * 2; return st * 1024 + (ob ^ (((ob >> 9) & 1) << 5)); }
__host__ __device__ __forceinline__ void stage_rc(int b, int& R, int& C) { const int st = b / 1024, sb = b % 1024, swz = sb ^ (((sb >> 9) & 1) << 5); R = (st >> 1) * 16 + swz / 64; C = (st & 1) * 32 + (swz % 64) / 2; }
__host__ __device__ __forceinline__ int perm32(int rho) { const int n = rho >> 4, i = rho & 15; return 8 * (i >> 2) + 4 * n + (i & 3); }

struct Unit { int pm, pn; };
struct Gemm { const bf16_t* A; const bf16_t* Bt; int M, N, K; };

struct StaticOrder {
    int nM, nN, nwg, G, c;
    __host__ __device__ void init(int M, int N, int G_, int c_) { nM = M / BM; nN = N / BM; nwg = nM * nN; G = G_; c = c_; }
    __host__ __device__ bool next(int i, Unit& u) const {
        const long L = (long)i * G + c; if (L >= nwg) return false;
        int wgid = (int)L; { const int q = nwg / NXCD, r = nwg % NXCD, xcd = wgid % NXCD, off = wgid / NXCD; wgid = (xcd < r ? xcd * (q + 1) : r * (q + 1) + (xcd - r) * q) + off; }
        const int nig = WGM * nN, gid = wgid / nig, fm = gid * WGM, gsz = (nM - fm) < WGM ? (nM - fm) : WGM;
        u.pm = fm + ((wgid % nig) % gsz); u.pn = (wgid % nig) / gsz; return true;
    }
    __device__ __forceinline__ void a_ready(const Unit&) const {}
    __device__ __forceinline__ void done(const Unit&) const {}
};

__device__ __forceinline__ unsigned cvt_pk_bf16(float lo, float hi) { unsigned r; asm volatile("v_cvt_pk_bf16_f32 %0, %1, %2" : "=v"(r) : "v"(lo), "v"(hi)); return r; }
typedef float f32x2 __attribute__((ext_vector_type(2)));
__device__ __forceinline__ f32x2 gelu_pk(f32x2 v) {
    const f32x2 av = __builtin_elementwise_abs(v), d = av * 0.2316418882f + 1.0f;
    f32x2 t; t.x = __builtin_amdgcn_rcpf(d.x); t.y = __builtin_amdgcn_rcpf(d.y);
    f32x2 q = t * 0.5307027145f + (-0.7265760135f); q = q * t + 0.7107068705f; q = q * t + (-0.142248368f); q = q * t + 0.127414796f; q = q * t;
    const f32x2 s = (v * v) * (-0.72134752044f);
    f32x2 e; e.x = __builtin_amdgcn_exp2f(s.x); e.y = __builtin_amdgcn_exp2f(s.y);
    const f32x2 m = v * (q * e), r = v - m;
    f32x2 o; o.x = v.x < 0.f ? m.x : r.x; o.y = v.y < 0.f ? m.y : r.y; return o;
}

template <int ACT  > struct EpiBf16 {
    static constexpr bool PERM = true, AFTER_DRAIN = false; static_assert(ACT == 0 || ACT == 1, "EpiBf16: ACT is 0 (none) or 1 (gelu_pk)");
    bf16_t* O; int ldc; const float* bias; int split_cols; size_t split_stride; float scale0;
    __device__ __forceinline__ void operator()(const f32x4 (&acc)[2][2][4][2], const Unit& u, int wr, int wc, int fr, int fq) const {
        const int row0 = u.pm * BM + wr * 64 + fr; int colt = u.pn * BM; bf16_t* base = O;
        float sc = 1.f; if (split_cols) { const int t = colt / split_cols; base += (size_t)t * split_stride; colt -= t * split_cols; if (t == 0) sc = scale0; }
        const int col0 = colt + wc * 32 + 8 * fq, bcol0 = u.pn * BM + wc * 32 + 8 * fq;
        f32x4 bv[2][2];
#pragma unroll
        for (int bj = 0; bj < 2; ++bj)
#pragma unroll
            for (int n = 0; n < 2; ++n) bv[bj][n] = bias ? *(const f32x4*)(bias + bcol0 + bj * HALF + 4 * n) : (f32x4){0.f, 0.f, 0.f, 0.f};
#pragma unroll
        for (int ai = 0; ai < 2; ++ai)
#pragma unroll
            for (int m = 0; m < 4; ++m) { bf16_t* rowp = base + (size_t)(row0 + ai * HALF + m * 16) * ldc + col0;
#pragma unroll
                for (int bj = 0; bj < 2; ++bj) { f32x4 v0 = acc[ai][bj][m][0] + bv[bj][0], v1 = acc[ai][bj][m][1] + bv[bj][1];
                    if (ACT == 1) { f32x2 a = gelu_pk((f32x2){v0[0], v0[1]}), b = gelu_pk((f32x2){v0[2], v0[3]}), c = gelu_pk((f32x2){v1[0], v1[1]}), d = gelu_pk((f32x2){v1[2], v1[3]});
                        v0 = (f32x4){a.x, a.y, b.x, b.y}; v1 = (f32x4){c.x, c.y, d.x, d.y}; }
                    v0 = v0 * sc; v1 = v1 * sc; u32x4 w; w.x = cvt_pk_bf16(v0[0], v0[1]); w.y = cvt_pk_bf16(v0[2], v0[3]); w.z = cvt_pk_bf16(v1[0], v1[1]); w.w = cvt_pk_bf16(v1[2], v1[3]);
                    *(u32x4*)(rowp + bj * HALF) = w; } }
    }
};
struct EpiZ {
    static constexpr bool PERM = true, AFTER_DRAIN = false;
    bf16_t* ZB; float* out; float* narrow; bf16_t* pcmp;
    __device__ __forceinline__ void operator()(const f32x4 (&acc)[2][2][4][2], const Unit& u, int wr, int wc, int fr, int fq) const {
        const int pn = u.pn; const float sc = (pn == 0 || pn == 6 || pn == 7) ? 0.125f : 1.0f;
        const int row0 = u.pm * BM + wr * 64 + fr, cc0 = wc * 32 + 8 * fq;
        if (pn >= 12) {
            const int c = pn - 12; bf16_t* base = pcmp + (size_t)c * 65536 * 256 + ((size_t)(u.pm - 65 - 256 * c) * BM + wr * 64 + fr) * 256 + cc0;
#pragma unroll
            for (int ai = 0; ai < 2; ++ai)
#pragma unroll
                for (int m = 0; m < 4; ++m)
#pragma unroll
                    for (int bj = 0; bj < 2; ++bj) { const f32x4 v0 = acc[ai][bj][m][0], v1 = acc[ai][bj][m][1];
                        u32x4 w; w.x = cvt_pk_bf16(v0[0], v0[1]); w.y = cvt_pk_bf16(v0[2], v0[3]); w.z = cvt_pk_bf16(v1[0], v1[1]); w.w = cvt_pk_bf16(v1[2], v1[3]);
                        *(u32x4*)(base + (size_t)(ai * HALF + m * 16) * 256 + bj * HALF) = w; }
            return; }
#pragma unroll
        for (int ai = 0; ai < 2; ++ai)
#pragma unroll
            for (int m = 0; m < 4; ++m) { const int row = row0 + ai * HALF + m * 16; bf16_t* rowp = ZB + (size_t)row * fc::ZN + pn * BM + cc0;
                float* fdst = nullptr;
                if (pn >= 8 && pn <= 10 && row < fc::R) {
                    if (row < fc::RP) { const int b = row >> 11, t = row & 2047;
                        if (pn == 8) fdst = out + fc::O_CKP + (size_t)row * 256; else if (pn == 9) fdst = out + fc::O_SKP + (size_t)row * 256;
                        else if (t >= 1536) fdst = out + fc::O_WKP + ((size_t)b * 512 + (t - 1536)) * 256; }
                    else { const int rr = row - fc::RP;
                        if (pn == 8) fdst = out + fc::O_CKS + (size_t)rr * 256; else if (pn == 9) fdst = out + fc::O_SKS + (size_t)rr * 256;
                        else fdst = out + fc::O_WKS + ((size_t)(rr >> 2) * 512 + 508 + (rr & 3)) * 256; } }
#pragma unroll
                for (int bj = 0; bj < 2; ++bj) { const f32x4 v0 = acc[ai][bj][m][0] * sc, v1 = acc[ai][bj][m][1] * sc;
                    u32x4 w; w.x = cvt_pk_bf16(v0[0], v0[1]); w.y = cvt_pk_bf16(v0[2], v0[3]); w.z = cvt_pk_bf16(v1[0], v1[1]); w.w = cvt_pk_bf16(v1[2], v1[3]);
                    *(u32x4*)(rowp + bj * HALF) = w;
                    if (fdst) { *(f32x4*)(fdst + cc0 + bj * HALF) = v0; *(f32x4*)(fdst + cc0 + bj * HALF + 4) = v1; }
                    if (pn == 11 && bj == 0 && cc0 < 64) { *(f32x4*)(narrow + (size_t)row * 64 + cc0) = v0; *(f32x4*)(narrow + (size_t)row * 64 + cc0 + 4) = v1; } } }
    }
};
struct EpiF32 {
    static constexpr bool PERM = false, AFTER_DRAIN = false;
    float* O; int ldc;
    __device__ __forceinline__ void operator()(const f32x4 (&acc)[2][2][4][2], const Unit& u, int wr, int wc, int fr, int fq) const {
        const int row0 = u.pm * BM + wr * 64 + fr, col0 = u.pn * BM + wc * 32 + 4 * fq;
#pragma unroll
        for (int ai = 0; ai < 2; ++ai)
#pragma unroll
            for (int m = 0; m < 4; ++m) { float* rowp = O + (size_t)(row0 + ai * HALF + m * 16) * ldc + col0;
#pragma unroll
                for (int bj = 0; bj < 2; ++bj)
#pragma unroll
                    for (int n = 0; n < 2; ++n) *(f32x4*)(rowp + bj * HALF + n * 16) = acc[ai][bj][m][n]; }
    }
};
struct EpiSwiglu {
    static constexpr bool PERM = true, AFTER_DRAIN = false;
    bf16_t* HM;
    __device__ __forceinline__ void operator()(const f32x4 (&acc)[2][2][4][2], const Unit& u, int wr, int wc, int fr, int fq) const {
        const int row0 = u.pm * BM + wr * 64 + fr, col0 = u.pn * HALF + wc * 32 + 8 * fq;
#pragma unroll
        for (int ai = 0; ai < 2; ++ai)
#pragma unroll
            for (int m = 0; m < 4; ++m) { float o[8];
#pragma unroll
                for (int n = 0; n < 2; ++n)
#pragma unroll
                    for (int e = 0; e < 4; ++e) { const float g = acc[ai][0][m][n][e], up = acc[ai][1][m][n][e]; o[n * 4 + e] = g * __builtin_amdgcn_rcpf(1.0f + __builtin_amdgcn_exp2f(-1.4426950408889634f * g)) * up; }
                u32x4 w; w.x = cvt_pk_bf16(o[0], o[1]); w.y = cvt_pk_bf16(o[2], o[3]); w.z = cvt_pk_bf16(o[4], o[5]); w.w = cvt_pk_bf16(o[6], o[7]);
                *(u32x4*)(HM + (size_t)(row0 + ai * HALF + m * 16) * fc::DFF + col0) = w; }
    }
};
struct ComboOrder {
    StaticOrder so; int G, c;
    __device__ void init(int G_, int c_) { so.init(fc::RP, fc::ZN, G_, c_); G = G_; c = c_; }
    __device__ bool next(int i, Unit& u) const { const long L = (long)i * G + c; if (L < 768) return so.next(i, u); if (L >= 768 + 512) return false;
        const int j = (int)L - 768, cc = j >> 8, t = j & 255; u.pm = 65 + cc * 256 + t; u.pn = 12 + cc; return true; }
    __device__ __forceinline__ void a_ready(const Unit&) const {}
    __device__ __forceinline__ void done(const Unit&) const {}
};
template <class Epi, class Sched, bool ALIGN_EPI = false, bool SP2 = false>
__device__ __forceinline__ void gemm_phase(PG8_LAS unsigned char* lds, const Gemm g, const Sched& S, const Epi& E) {
    int tid_ = threadIdx.x; asm volatile("" : "+v"(tid_));
    const int tid = tid_, wid = __builtin_amdgcn_readfirstlane(tid >> 6), lane = tid & 63, wr = wid >> 2, wc = wid & 3, fr = lane & 15, fq = lane >> 4;
    const int K = g.K, nt = K / BK;
    unsigned voffA[2], voffB[2];
#pragma unroll
    for (int i = 0; i < 2; ++i) { int R, C; stage_rc(tid * 16 + i * 8192, R, C); const int Rb = Epi::PERM ? ((R & ~31) + perm32(R & 31)) : R;
        voffA[i] = (unsigned)(R * K + C) * 2u; voffB[i] = (unsigned)(Rb * K + C) * 2u; }
    const size_t kstep = (size_t)(BK * 2);
    const size_t hstep = (size_t)HALF * K * 2;
    const size_t tstep = 2 * hstep;
    const unsigned ldsw = (unsigned)wid * 1024u;
    const int aoff = lds_byte(wr * 64 + fr, fq * 8), boff = lds_byte(wc * 32 + fr, fq * 8);
#define PG8_SA(b, h) (((b) * 2 + (h)) * HTB)
#define PG8_SB(b, h) ((4 + (b) * 2 + (h)) * HTB)
#define PG8_STAGE(bufoff, gbase, voff) do { _Pragma("unroll") for (int _i = 0; _i < 2; ++_i) \
        __builtin_amdgcn_global_load_lds((const unsigned*)((const char*)(gbase) + (voff)[_i]), (PG8_LAS unsigned*)(lds + (bufoff) + ldsw + _i * 8192), 16, 0, 0); } while (0)
#define PG8_LDA(dst, b, h) do { _Pragma("unroll") for (int m = 0; m < 4; ++m) _Pragma("unroll") for (int k = 0; k < 2; ++k) dst[m][k] = *(const PG8_LAS bf16x8*)(lds + PG8_SA(b, h) + aoff + m * 2048 + k * 1024); } while (0)
#define PG8_LDB(dst, b, h) do { _Pragma("unroll") for (int n = 0; n < 2; ++n) _Pragma("unroll") for (int k = 0; k < 2; ++k) dst[n][k] = *(const PG8_LAS bf16x8*)(lds + PG8_SB(b, h) + boff + n * 2048 + k * 1024); } while (0)
#define PG8_MMA(ai, bj, At, Bt) do { __builtin_amdgcn_s_setprio(1); _Pragma("unroll") for (int m = 0; m < 4; ++m) _Pragma("unroll") for (int n = 0; n < 2; ++n) _Pragma("unroll") for (int k = 0; k < 2; ++k) \
        acc[ai][bj][m][n] = __builtin_amdgcn_mfma_f32_16x16x32_bf16(Bt[n][k], At[m][k], acc[ai][bj][m][n], 0, 0, 0); __builtin_amdgcn_s_setprio(0); } while (0)
#define PG8_WAIT_V(n) asm volatile("s_waitcnt vmcnt(" #n ")" ::: "memory")
#define PG8_WAIT_L(n) asm volatile("s_waitcnt lgkmcnt(" #n ")" ::: "memory")
#define PG8_BAR __builtin_amdgcn_s_barrier()
#define PG8_SCHED __builtin_amdgcn_sched_barrier(0)
    Unit cur, nxt; int ui = 0;
    if (!S.next(0, cur)) return;
    f32x4 acc[2][2][4][2];
#pragma unroll
    for (int a = 0; a < 2; ++a)
#pragma unroll
        for (int b = 0; b < 2; ++b)
#pragma unroll
            for (int m = 0; m < 4; ++m)
#pragma unroll
                for (int n = 0; n < 2; ++n) acc[a][b][m][n] = (f32x4){0.f, 0.f, 0.f, 0.f};
    bf16x8 At[4][2], B0[2][2], B1[2][2];
    const char* cA = (const char*)g.A + (size_t)cur.pm * tstep; const char* cB = (const char*)g.Bt + (size_t)cur.pn * tstep;
    S.a_ready(cur);
    if constexpr (SP2) {
        PG8_STAGE(PG8_SB(0, 0), cB, voffB); PG8_STAGE(PG8_SB(0, 1), cB + hstep, voffB); PG8_STAGE(PG8_SA(0, 0), cA, voffA); PG8_STAGE(PG8_SA(0, 1), cA + hstep, voffA);
        if (wr == 1) PG8_BAR;
        PG8_WAIT_V(2); PG8_BAR;
        PG8_STAGE(PG8_SB(1, 0), cB + kstep, voffB); PG8_STAGE(PG8_SA(1, 0), cA + kstep, voffA); PG8_STAGE(PG8_SB(1, 1), cB + hstep + kstep, voffB);
        PG8_WAIT_V(6); PG8_BAR;
    } else {
        PG8_STAGE(PG8_SB(0, 0), cB, voffB); PG8_STAGE(PG8_SA(0, 0), cA, voffA); PG8_STAGE(PG8_SB(0, 1), cB + hstep, voffB); PG8_STAGE(PG8_SA(0, 1), cA + hstep, voffA);
        if (wr == 1) PG8_BAR;
        PG8_WAIT_V(4); PG8_BAR;
        PG8_STAGE(PG8_SB(1, 0), cB + kstep, voffB); PG8_STAGE(PG8_SA(1, 0), cA + kstep, voffA); PG8_STAGE(PG8_SB(1, 1), cB + hstep + kstep, voffB);
        PG8_WAIT_V(6); PG8_BAR;
    }
    for (;;) {
        const bool has_next = S.next(ui + 1, nxt);
        const char* nA = has_next ? (const char*)g.A + (size_t)nxt.pm * tstep : cA; const char* nB = has_next ? (const char*)g.Bt + (size_t)nxt.pn * tstep : cB;
        for (int t = 0; t < nt; t += 2) {
            const bool last = (t == nt - 2);
            const char* a1 = cA + (size_t)(t + 1) * kstep;
            const char* a2 = last ? nA : cA + (size_t)(t + 2) * kstep; const char* b2 = last ? nB : cB + (size_t)(t + 2) * kstep;
            const char* a3 = a2 + kstep; const char* b3 = b2 + kstep;
            if (last && has_next) S.a_ready(nxt);
            if constexpr (SP2) {
            PG8_LDB(B0, 0, 0); PG8_LDB(B1, 0, 1); PG8_SCHED; PG8_LDA(At, 0, 0); PG8_STAGE(PG8_SA(1, 1), a1 + hstep, voffA);
            PG8_WAIT_V(8); PG8_WAIT_L(0); PG8_BAR; PG8_MMA(0, 0, At, B0); PG8_MMA(0, 1, At, B1); PG8_BAR; PG8_SCHED;
            PG8_LDA(At, 0, 1); PG8_STAGE(PG8_SB(0, 0), b2, voffB); PG8_STAGE(PG8_SB(0, 1), b2 + hstep, voffB); PG8_STAGE(PG8_SA(0, 0), a2, voffA);
            PG8_WAIT_V(8); PG8_WAIT_L(0); PG8_BAR; PG8_MMA(1, 0, At, B0); PG8_MMA(1, 1, At, B1); PG8_BAR; PG8_SCHED;
            PG8_LDB(B0, 1, 0); PG8_LDB(B1, 1, 1); PG8_SCHED; PG8_LDA(At, 1, 0); PG8_STAGE(PG8_SA(0, 1), a2 + hstep, voffA);
            PG8_WAIT_V(8); PG8_WAIT_L(0); PG8_BAR; PG8_MMA(0, 0, At, B0); PG8_MMA(0, 1, At, B1); PG8_BAR; PG8_SCHED;
            PG8_LDA(At, 1, 1); PG8_STAGE(PG8_SB(1, 0), b3, voffB); PG8_STAGE(PG8_SB(1, 1), b3 + hstep, voffB); PG8_STAGE(PG8_SA(1, 0), a3, voffA);
            PG8_WAIT_V(8); PG8_WAIT_L(0); PG8_BAR; PG8_MMA(1, 0, At, B0); PG8_MMA(1, 1, At, B1); PG8_BAR; PG8_SCHED;
            } else {
            PG8_LDB(B0, 0, 0); PG8_SCHED; PG8_LDA(At, 0, 0); PG8_STAGE(PG8_SA(1, 1), a1 + hstep, voffA);
            PG8_WAIT_L(8); PG8_BAR; PG8_WAIT_L(0); PG8_MMA(0, 0, At, B0); PG8_BAR; PG8_SCHED;
            PG8_LDB(B1, 0, 1); PG8_STAGE(PG8_SB(0, 0), b2, voffB);
            PG8_BAR; PG8_WAIT_L(0); PG8_MMA(0, 1, At, B1); PG8_BAR;
            PG8_LDA(At, 0, 1); PG8_STAGE(PG8_SA(0, 0), a2, voffA);
            PG8_BAR; PG8_WAIT_L(0); PG8_MMA(1, 0, At, B0); PG8_BAR; PG8_SCHED;
            PG8_STAGE(PG8_SB(0, 1), b2 + hstep, voffB);
            PG8_WAIT_V(6); PG8_BAR; PG8_MMA(1, 1, At, B1); PG8_BAR;
            PG8_LDB(B0, 1, 0); PG8_SCHED; PG8_LDA(At, 1, 0); PG8_STAGE(PG8_SA(0, 1), a2 + hstep, voffA);
            PG8_WAIT_L(8); PG8_BAR; PG8_WAIT_L(0); PG8_MMA(0, 0, At, B0); PG8_BAR; PG8_SCHED;
            PG8_LDB(B1, 1, 1); PG8_STAGE(PG8_SB(1, 0), b3, voffB);
            PG8_BAR; PG8_WAIT_L(0); PG8_MMA(0, 1, At, B1); PG8_BAR;
            PG8_LDA(At, 1, 1); PG8_STAGE(PG8_SA(1, 0), a3, voffA);
            PG8_BAR; PG8_WAIT_L(0); PG8_MMA(1, 0, At, B0); PG8_BAR; PG8_SCHED;
            PG8_STAGE(PG8_SB(1, 1), b3 + hstep, voffB);
            PG8_WAIT_V(6); PG8_BAR; PG8_MMA(1, 1, At, B1); PG8_BAR;
            }
        }
        if constexpr (ALIGN_EPI) { if (wr == 0) PG8_BAR; }
        if constexpr (!Epi::AFTER_DRAIN) { E(acc, cur, wr, wc, fr, fq); S.done(cur); }
        if (!has_next) break;
#pragma unroll
        for (int a = 0; a < 2; ++a)
#pragma unroll
            for (int b = 0; b < 2; ++b)
#pragma unroll
                for (int m = 0; m < 4; ++m)
#pragma unroll
                    for (int n = 0; n < 2; ++n) acc[a][b][m][n] = (f32x4){0.f, 0.f, 0.f, 0.f};
        cur = nxt; cA = nA; cB = nB; ++ui;
        if constexpr (ALIGN_EPI) { if (wr == 1) PG8_BAR; }
    }
    PG8_WAIT_V(0);
    if constexpr (!ALIGN_EPI) { if (wr == 0) PG8_BAR; }
    PG8_BAR;
    if constexpr (Epi::AFTER_DRAIN) { E.fused(acc, cur, wr, wc, fr, fq, lds, wid, lane); S.done(cur); }
#undef PG8_SA
#undef PG8_SB
#undef PG8_STAGE
#undef PG8_LDA
#undef PG8_LDB
#undef PG8_MMA
#undef PG8_WAIT_V
#undef PG8_WAIT_L
#undef PG8_BAR
#undef PG8_SCHED
}
}
#define GAS __attribute__((address_space(1)))
#define LAS __attribute__((address_space(3)))
typedef unsigned short bf16;
typedef unsigned v4u __attribute__((ext_vector_type(4)));
typedef float f32x4 __attribute__((ext_vector_type(4)));
typedef short bf16x8 __attribute__((ext_vector_type(8)));
typedef GAS unsigned gu32;
typedef GAS unsigned long long gu64;
#define RLX_AGENT __ATOMIC_RELAXED, __HIP_MEMORY_SCOPE_AGENT
#define LDS_WAIT() asm volatile("s_waitcnt lgkmcnt(0)" ::: "memory")
#define VM_WAIT() asm volatile("s_waitcnt vmcnt(0)" ::: "memory")
__device__ __forceinline__ unsigned long long rt() { return __builtin_amdgcn_s_memrealtime(); }
__device__ __forceinline__ unsigned f2bf(float f) { unsigned u = __builtin_bit_cast(unsigned, f); return (u + 0x7fffu + ((u >> 16) & 1u)) >> 16; }
__device__ __forceinline__ unsigned pk2(float lo, float hi) { return f2bf(lo) | (f2bf(hi) << 16); }
#define XB_TMO      128
#define XB_XCNT(j)  (256  + 64 * (j))
#define XB_XSUB(j)  (1280 + 64 * (j))
#define XB_XGEN(j)  (2304 + 64 * (j))
#define XB_TOP      3328
#define XB_TOPGEN   3392
#define XCD_BAR_WORDS 3456
#define XB_SPIN_CAP (1u << 18)

__device__ __forceinline__ unsigned xb_ld(unsigned* p)              { return __hip_atomic_load(p, __ATOMIC_RELAXED, __HIP_MEMORY_SCOPE_AGENT); }
__device__ __forceinline__ unsigned xb_add(unsigned* p, unsigned v) { return __hip_atomic_fetch_add(p, v, __ATOMIC_RELAXED, __HIP_MEMORY_SCOPE_AGENT); }
__device__ __forceinline__ unsigned xb_xcc_id() { return (unsigned)__builtin_amdgcn_s_getreg((3 << 11) | 20) & 0xFu; }
#define XB_SPIN(cond, bar) do { unsigned _sp = 0; while (cond) { __builtin_amdgcn_s_sleep(1); \
    if ((++_sp & 255u) == 0u) { if (xb_ld(&(bar)[XB_TMO])) break; if (_sp > XB_SPIN_CAP) { atomicAdd(&(bar)[XB_TMO], 1u); break; } } } } while (0)

struct XcdBarrier {
    unsigned* bar; unsigned x;
    volatile LAS unsigned* st;
};

__device__ __forceinline__ XcdBarrier xcd_barrier_post(unsigned* bar, volatile LAS unsigned* st) {
    XcdBarrier b; b.bar = bar; b.x = xb_xcc_id(); b.st = st;
    if (threadIdx.x == 0) (void)xb_add(&bar[XB_XCNT(b.x)], 1u);
    return b;
}
__device__ __forceinline__ void xcd_barrier_complete(unsigned* bar, unsigned x, unsigned& nloc, unsigned& nx) {
    const unsigned G = gridDim.x * gridDim.y * gridDim.z;
    unsigned sum, cnt, mine, sp = 0u;
    for (;;) {
        sum = 0u; cnt = 0u; mine = 0u;
#pragma unroll
        for (unsigned j = 0; j < 16; ++j) { const unsigned c = xb_ld(&bar[XB_XCNT(j)]); sum += c; cnt += (c > 0u) ? 1u : 0u; mine = (j == x) ? c : mine; }
        if (sum == G) break;
        __builtin_amdgcn_s_sleep(1);
        if ((++sp & 255u) == 0u) { if (xb_ld(&bar[XB_TMO])) break; if (sp > XB_SPIN_CAP) { atomicAdd(&bar[XB_TMO], 1u); break; } }
    }
    nloc = mine > 0u ? mine : 1u; nx = cnt > 0u ? cnt : 1u;
}

__device__ __forceinline__ void xcd_barrier(const XcdBarrier& b) {
    asm volatile("s_waitcnt vmcnt(0)" ::: "memory");
    __syncthreads();
    if (threadIdx.x == 0) {
        unsigned* bar = b.bar;
        __builtin_amdgcn_s_waitcnt(0);
        unsigned nloc = b.st[0], nx = b.st[1];
        if (nloc == 0u) { xcd_barrier_complete(bar, b.x, nloc, nx); b.st[0] = nloc; b.st[1] = nx; }
        const unsigned old = xb_add(&bar[XB_XSUB(b.x)], 1u);
        const unsigned gen = old / nloc;
        if (old + 1u == (gen + 1u) * nloc) {
            __builtin_amdgcn_fence(__ATOMIC_RELEASE, "agent");
            asm volatile("s_waitcnt vmcnt(0)" ::: "memory");
            const unsigned og = xb_add(&bar[XB_TOP], 1u);
            const unsigned tg = og / nx;
            if (og + 1u == (tg + 1u) * nx) xb_add(&bar[XB_TOPGEN], 1u);
            else XB_SPIN(xb_ld(&bar[XB_TOPGEN]) == tg, bar);
            __builtin_amdgcn_fence(__ATOMIC_ACQUIRE, "agent");
            xb_add(&bar[XB_XGEN(b.x)], 1u);
            asm volatile("s_waitcnt vmcnt(0)" ::: "memory");
        } else {
            XB_SPIN(xb_ld(&bar[XB_XGEN(b.x)]) == gen, bar);
            __builtin_amdgcn_fence(__ATOMIC_ACQUIRE, "agent");
            asm volatile("s_waitcnt vmcnt(0)" ::: "memory");
        }
    }
    __syncthreads();
}
namespace fk {
using namespace fc;
constexpr int NWAVES = 8, NTHR = 512;
constexpr size_t MiB = 1u << 20;
constexpr size_t WS_CTL = 0, CTL_ZERO_BYTES = 1 * MiB;
constexpr int CW_BAR = 4096;
constexpr size_t FB = 1536 * MiB;
constexpr size_t WS_WT_IN = FB + 0 * MiB;
constexpr size_t WS_W1R = FB + 6 * MiB;
constexpr size_t WS_WT_O = FB + 8 * MiB;
constexpr size_t WS_WT_F1 = FB + 10 * MiB;
constexpr size_t WS_WT_F2 = FB + 21 * MiB;
constexpr size_t WS_MODP = FB + 27 * MiB;
constexpr size_t WS_MODF = FB + 35 * MiB;
constexpr size_t WS_STATS = FB + 36 * MiB;
constexpr size_t WS_CBIAS = FB + 36 * MiB + 512 * 1024;
constexpr size_t WS_W2T = FB + 36 * MiB + 768 * 1024;
constexpr size_t WS_NARROW = FB + 37 * MiB;
constexpr size_t WS_U = FB + 42 * MiB;
constexpr size_t WS_ACMP = WS_U + (size_t)MP * 1024 * 2;
constexpr size_t WS_ZB = FB + 331 * MiB;
constexpr size_t WS_PCMP = FB + 429 * MiB;
constexpr size_t WS_KCVP = FB + 493 * MiB;
constexpr size_t WS_KCVS = FB + 494 * MiB;
constexpr size_t WS_KC = FB + 41 * MiB + 256 * 1024;
constexpr size_t WS_VTC = FB + 41 * MiB + 512 * 1024;
constexpr size_t WS_GLAS = FB + 526 * MiB;
constexpr size_t WS_GLAD = FB + 558 * MiB;
constexpr size_t WS_ATT = FB + 559 * MiB;
constexpr size_t WS_H1 = FB + 592 * MiB;
constexpr size_t WS_X1 = FB + 657 * MiB;
constexpr size_t WS_HM = FB + 722 * MiB;
constexpr size_t WS_VTS = FB + 812 * MiB;
constexpr size_t WS_VTW = FB + 816 * MiB;
constexpr size_t WS_END = FB + 820 * MiB;
constexpr int RING_OFF = 0, RING_BYTES = 131072, LDSCTL_OFF = RING_BYTES, MISC_OFF = LDSCTL_OFF + 320, LDS_BYTES = 147456;


struct Args { const void* in[28]; float* out; unsigned char* ws; int ph_lo, ph_hi, li, pad; };
struct Frame { LAS unsigned char* lds; gu32* ctl; int tid, lane, wave, vcu, G; };

template <int X> __device__ __forceinline__ float xor_f(float v) {
    if constexpr (X == 32) { auto rr = __builtin_amdgcn_permlane32_swap(__float_as_uint(v), __float_as_uint(v), false, false); const unsigned me = __float_as_uint(v); return __uint_as_float(rr[0] == me ? rr[1] : rr[0]); }
    else return __int_as_float(__builtin_amdgcn_ds_swizzle(__float_as_int(v), (X << 10) | 0x1f));
}
__device__ __forceinline__ float swap32_sum(float v) { auto rr = __builtin_amdgcn_permlane32_swap(__float_as_uint(v), __float_as_uint(v), false, false); return __uint_as_float(rr[0]) + __uint_as_float(rr[1]); }
__device__ __forceinline__ float swap32_max(float v) { auto rr = __builtin_amdgcn_permlane32_swap(__float_as_uint(v), __float_as_uint(v), false, false); return fmaxf(__uint_as_float(rr[0]), __uint_as_float(rr[1])); }
__device__ __forceinline__ float wave_sum(float v) { v += xor_f<1>(v); v += xor_f<2>(v); v += xor_f<4>(v); v += xor_f<8>(v); v += xor_f<16>(v); return swap32_sum(v); }
__device__ __forceinline__ float wave_max(float v) { v = fmaxf(v, xor_f<1>(v)); v = fmaxf(v, xor_f<2>(v)); v = fmaxf(v, xor_f<4>(v)); v = fmaxf(v, xor_f<8>(v)); v = fmaxf(v, xor_f<16>(v)); return swap32_max(v); }
__device__ __forceinline__ Frame launder(const Frame& F0) { Frame F = F0; int t = F0.tid; asm volatile("" : "+v"(t)); F.tid = t; F.lane = t & 63; F.wave = __builtin_amdgcn_readfirstlane(t >> 6); return F; }
__device__ __forceinline__ float silu_f(float x) { return x / (1.f + __expf(-x)); }
__device__ __forceinline__ int mod_row(int r) { return r < RP ? (r >> 11) : 8 + ((r - RP) >> 2); }

template <class SrcCol> __device__ __forceinline__ void transpose_item(const float* W, int K, int N, bf16* WT, int n0, int k0, LAS float* scr, int lane, SrcCol src) {
    const int sc = src(n0 + (lane & 31));
#pragma unroll 8
    for (int i = 0; i < 32; ++i) { const int kk = 2 * i + (lane >> 5); scr[kk * 33 + (lane & 31)] = sc >= 0 ? W[(size_t)(k0 + kk) * N + sc] : 0.f; }
    LDS_WAIT(); asm volatile("" ::: "memory");
    const int c = lane & 7;
#pragma unroll
    for (int j = 0; j < 4; ++j) { const int n = (lane >> 3) + 8 * j; const LAS float* s = scr + (8 * c) * 33 + n;
        v4u o; o.x = pk2(s[0 * 33], s[1 * 33]); o.y = pk2(s[2 * 33], s[3 * 33]); o.z = pk2(s[4 * 33], s[5 * 33]); o.w = pk2(s[6 * 33], s[7 * 33]);
        *(GAS v4u*)(WT + (size_t)(n0 + n) * K + k0 + 8 * c) = o; }
    LDS_WAIT(); asm volatile("" ::: "memory");
}
__device__ __forceinline__ int src_win(int n) { return n < 1024 ? n : (n < 2816 ? n + 16 : (n < 2832 ? 1024 + (n - 2816) : (n < 2856 ? n : -1))); }
__device__ __forceinline__ int src_f1(int n) { return ((n >> 7) & 1) * DFF + (n >> 8) * 128 + (n & 127); }

__device__ __forceinline__ void p0_prologue(Frame& F0, const Args& a) { Frame F = launder(F0);
    const float* w_in = (const float*)a.in[13]; const float* w_o = (const float*)a.in[21]; const float* w_f1 = (const float*)a.in[24]; const float* w_f2 = (const float*)a.in[25];
    const float* w1 = (const float*)a.in[18]; const float* b1 = (const float*)a.in[19]; const float* pe = (const float*)a.in[17];
    unsigned char* ws = a.ws;
    {
        LAS float* sl = (LAS float*)(F.lds + RING_OFF);
        const float* cp = (const float*)a.in[7]; const float* cs = (const float*)a.in[8]; const float* w_ada = (const float*)a.in[11];
        float* modp = (float*)(ws + WS_MODP);
        for (int j = blockIdx.x; j < 256; j += F.G) { const int cg = j & 31, kg = j >> 5;
            for (int i = F.tid; i < 40 * 128; i += NTHR) { const int r = i >> 7, k = i & 127; const float c = r < 8 ? cp[r * D + kg * 128 + k] : cs[(r - 8) * D + kg * 128 + k]; sl[i] = silu_f(c); }
            __syncthreads();
            float acc[40];
#pragma unroll
            for (int r = 0; r < 40; ++r) acc[r] = 0.f;
            const int col = F.tid % 192, kh = F.tid / 192;
            if (F.tid < 384) { const float* wp = w_ada + (size_t)(kg * 128 + kh * 64) * 6144 + cg * 192 + col;
                for (int k = 0; k < 64; k += 4) { const float w0 = wp[(size_t)k * 6144], w1 = wp[(size_t)(k + 1) * 6144], w2 = wp[(size_t)(k + 2) * 6144], w3 = wp[(size_t)(k + 3) * 6144];
#pragma unroll
                    for (int r = 0; r < 40; ++r) { const f32x4 s4 = *(const LAS f32x4*)(sl + r * 128 + kh * 64 + k); acc[r] += (s4.x * w0 + s4.y * w1) + (s4.z * w2 + s4.w * w3); } } }
            __syncthreads();
            LAS float* cb = sl + 40 * 128;
            if (F.tid >= 192 && F.tid < 384) {
#pragma unroll
                for (int r = 0; r < 40; ++r) cb[r * 192 + col] = acc[r]; }
            __syncthreads();
            if (F.tid < 192) {
#pragma unroll
                for (int r = 0; r < 40; ++r) modp[((size_t)kg * 40 + r) * 6144 + cg * 192 + col] = acc[r] + cb[r * 192 + col]; }
            __syncthreads();
        }
    }
    LAS float* scr = (LAS float*)(F.lds + RING_OFF + F.wave * 16384);
    const int gw = F.vcu * NWAVES + F.wave, NGW = F.G * NWAVES;
    constexpr int I_IN = 16 * 96, I_O = 16 * 32, I_F1 = 16 * 176, I_F2 = 44 * 32, I_W1 = 4 * 16 * 4;
    constexpr int NITEMS = I_IN + I_O + I_F1 + I_F2 + I_W1;
    for (int it = gw; it < NITEMS; it += NGW) { int r = it;
        if (r < I_IN) { transpose_item(w_in, 1024, 2856, (bf16*)(ws + WS_WT_IN), (r % 96) * 32, (r / 96) * 64, scr, F.lane, [](int n) { return src_win(n); }); continue; } r -= I_IN;
        if (r < I_O) { transpose_item(w_o, 1024, 1024, (bf16*)(ws + WS_WT_O), (r % 32) * 32, (r / 32) * 64, scr, F.lane, [](int n) { return n; }); continue; } r -= I_O;
        if (r < I_F1) { transpose_item(w_f1, 1024, F1N, (bf16*)(ws + WS_WT_F1), (r % 176) * 32, (r / 176) * 64, scr, F.lane, [](int n) { return src_f1(n); }); continue; } r -= I_F1;
        if (r < I_F2) { transpose_item(w_f2, DFF, 1024, (bf16*)(ws + WS_WT_F2), (r % 32) * 32, (r / 32) * 64, scr, F.lane, [](int n) { return n; }); continue; } r -= I_F2;
        { const int cm = r >> 6, q = r & 63;
          transpose_item(w1 + (size_t)cm * 1024 * 128, 1024, 128, (bf16*)(ws + WS_W1R) + (size_t)cm * 128 * 1024, (q % 4) * 32, (q / 4) * 64, scr, F.lane, [](int n) { return n; }); }
    }
    { float* cbias = (float*)(ws + WS_CBIAS);
      for (int o = gw; o < 256; o += NGW) { const int c = o >> 7, hid = o & 127; float s = 0.f;
          for (int k = F.lane; k < 2048; k += 64) s += pe[((k >> 6) * 2 + c) * 64 + (k & 63)] * w1[((size_t)c * 2048 + k) * 128 + hid];
          s = wave_sum(s); if (F.lane == 0) cbias[o] = s + b1[o]; } }
    { const float* w2 = (const float*)a.in[20]; bf16* w2t = (bf16*)(ws + WS_W2T);
      for (int i = gw * 64 + F.lane; i < 16384; i += NGW * 64) { const int c = i >> 13, d = (i >> 7) & 63, hid = i & 127; w2t[i] = (bf16)f2bf(w2[((size_t)c * 128 + hid) * 64 + d]); } }
    { const float* cw = (const float*)a.in[5]; float* ow = a.out + O_WKS;
      for (int it0 = gw; it0 < 32 * 508; it0 += 8 * NGW) { f32x4 v[8];
#pragma unroll
          for (int u = 0; u < 8; ++u) { const int it = it0 + u * NGW; v[u] = (f32x4){0.f, 0.f, 0.f, 0.f}; if (it < 32 * 508) { const int b = it / 508, j = it % 508; v[u] = *(const GAS f32x4*)(cw + ((size_t)b * 512 + j + 4) * 256 + F.lane * 4); } }
#pragma unroll
          for (int u = 0; u < 8; ++u) { const int it = it0 + u * NGW; if (it < 32 * 508) { const int b = it / 508, j = it % 508; *(GAS f32x4*)(ow + ((size_t)b * 512 + j) * 256 + F.lane * 4) = v[u]; } } } }
    { const float* cc = (const float*)a.in[3]; const int* table = (const int*)a.in[6]; bf16* A = (bf16*)(ws + WS_ACMP);
      const int c = F.lane >> 5, g = (F.lane >> 4) & 1, d = (F.lane & 15) * 4;
      for (int it = gw; it < 32 * 128; it += NGW) { const int b = it >> 7, pg = it & 127; const float* src = cc + (size_t)table[it] * 128 * 256 + F.lane * 4;
          bf16* dst = A + (size_t)c * 65536 * 1024 + ((size_t)(b * 1024 + pg * 8) * 2 + g) * 1024 + d;
          for (int t0 = 0; t0 < 128; t0 += 16) { f32x4 v[16];
#pragma unroll
              for (int u = 0; u < 16; ++u) v[u] = __builtin_nontemporal_load((const GAS f32x4*)(src + (size_t)(t0 + u) * 256));
#pragma unroll
              for (int u = 0; u < 16; ++u) { const unsigned long long w = (unsigned long long)pk2(v[u].x, v[u].y) | ((unsigned long long)pk2(v[u].z, v[u].w) << 32);
                  *(GAS unsigned long long*)(dst + (size_t)(t0 >> 4) * 2048 + u * 64) = w; } } } }
}
__device__ __forceinline__ void p1_ln_mod(Frame& F0, const Args& a) { Frame F = launder(F0);
    unsigned char* ws = a.ws; const float* modp = (const float*)(ws + WS_MODP); const float* b_ada = (const float*)a.in[12];
    const float* ln_g = (const float*)a.in[9]; const float* ln_b = (const float*)a.in[10];
    const int gw = F.vcu * NWAVES + F.wave, NGW = F.G * NWAVES;
    { float* modf = (float*)(ws + WS_MODF);
      for (int i = blockIdx.x * NTHR + F.tid; i < 40 * 6144; i += F.G * NTHR) { float s = b_ada[i % 6144];
#pragma unroll
          for (int kg = 0; kg < 8; ++kg) s += modp[(size_t)kg * 40 * 6144 + i];
          modf[i] = s; } }
    bf16* U = (bf16*)(ws + WS_U); float* stats = (float*)(ws + WS_STATS);
    LAS float* msc = (LAS float*)(F.lds + RING_OFF); LAS float* msh = msc + 1024;
    auto do_row = [&](int r, auto loadmod) {
        const float* xrow = r < RP ? (const float*)a.in[0] + (size_t)r * D : (const float*)a.in[1] + (size_t)(r - RP) * D;
        const GAS f32x4* xr = (const GAS f32x4*)xrow + F.lane; f32x4 v[4]; float s_ = 0.f;
#pragma unroll
        for (int j = 0; j < 4; ++j) { v[j] = xr[64 * j]; s_ += (v[j].x + v[j].y) + (v[j].z + v[j].w); }
        const float mean = wave_sum(s_) * (1.f / D); float s2 = 0.f;
#pragma unroll
        for (int j = 0; j < 4; ++j) { v[j] = v[j] - mean; s2 += (v[j].x * v[j].x + v[j].y * v[j].y) + (v[j].z * v[j].z + v[j].w * v[j].w); }
        const float rstd = 1.f / sqrtf(wave_sum(s2) * (1.f / D) + 1e-5f);
        if (F.lane == 0) { stats[2 * r] = mean; stats[2 * r + 1] = rstd; }
        GAS unsigned long long* o8 = (GAS unsigned long long*)(U + (size_t)r * D) + F.lane;
#pragma unroll
        for (int j = 0; j < 4; ++j) { const int c = 256 * j + 4 * F.lane; f32x4 sh, sc; loadmod(c, sc, sh);
            const f32x4 g = *(const f32x4*)(ln_g + c), bb = *(const f32x4*)(ln_b + c); const f32x4 y = (v[j] * rstd * g + bb) * sc + sh;
            o8[64 * j] = (unsigned long long)pk2(y.x, y.y) | ((unsigned long long)pk2(y.z, y.w) << 32); } };
    for (int chunk = blockIdx.x; chunk < 256; chunk += F.G) { const int mr = chunk >> 5;
        for (int c = F.tid; c < 1024; c += NTHR) { float sh = b_ada[c], sc = b_ada[1024 + c] + 1.f;
#pragma unroll
            for (int kg = 0; kg < 8; ++kg) { sh += modp[((size_t)kg * 40 + mr) * 6144 + c]; sc += modp[((size_t)kg * 40 + mr) * 6144 + 1024 + c]; }
            msc[c] = sc; msh[c] = sh; }
        __syncthreads();
        for (int i = 0; i < 8; ++i) do_row(chunk * 64 + F.wave * 8 + i, [&](int c, f32x4& sc, f32x4& sh) { sc = *(const LAS f32x4*)(msc + c); sh = *(const LAS f32x4*)(msh + c); });
        __syncthreads();
    }
    for (int sr = gw; sr < RS; sr += NGW) { const int mr = 8 + (sr >> 2);
        do_row(RP + sr, [&](int c, f32x4& sc, f32x4& sh) { sh = *(const f32x4*)(b_ada + c); sc = *(const f32x4*)(b_ada + 1024 + c) + 1.f;
#pragma unroll
            for (int kg = 0; kg < 8; ++kg) { sh += *(const f32x4*)(modp + ((size_t)kg * 40 + mr) * 6144 + c); sc += *(const f32x4*)(modp + ((size_t)kg * 40 + mr) * 6144 + 1024 + c); } }); }
}

template <int WHICH> __device__ __forceinline__ void p_res_ln(Frame& F0, const Args& a, int r_lo, int r_hi) { Frame F = launder(F0);
    unsigned char* ws = a.ws; const float* modf = (const float*)(ws + WS_MODF); const float* stats = (const float*)(ws + WS_STATS);
    const float* mixb = (const float*)(ws + WS_H1); float* X1 = (float*)(ws + WS_X1); bf16* U = (bf16*)(ws + WS_U);
    const float* ln_g = (const float*)a.in[9]; const float* ln_b = (const float*)a.in[10];
    const float* lg = (const float*)a.in[WHICH == 0 ? 22 : 26]; const float* lb = (const float*)a.in[WHICH == 0 ? 23 : 27];
    const int gw = F.vcu * NWAVES + F.wave, NGW = F.G * NWAVES;
    for (int r = r_lo + gw; r < r_hi; r += NGW) {
        const int mr = mod_row(r); const float* mrow = modf + (size_t)mr * 6144;
        f32x4 v[4]; float s = 0.f;
        if (WHICH == 0) { const float* xrow = r < RP ? (const float*)a.in[0] + (size_t)r * D : (const float*)a.in[1] + (size_t)(r - RP) * D;
            const float mean = stats[2 * r], rstd = stats[2 * r + 1];
#pragma unroll
            for (int j = 0; j < 4; ++j) { const int c = 256 * j + 4 * F.lane; const f32x4 x = *(const GAS f32x4*)(xrow + c), m = *(const GAS f32x4*)(mixb + (size_t)r * D + c);
                const f32x4 xp = (x - mean) * rstd * *(const f32x4*)(ln_g + c) + *(const f32x4*)(ln_b + c);
                v[j] = xp * ALPHA + *(const f32x4*)(mrow + 2048 + c) * m; s += (v[j].x + v[j].y) + (v[j].z + v[j].w); } }
        else {
#pragma unroll
            for (int j = 0; j < 4; ++j) { const int c = 256 * j + 4 * F.lane; const f32x4 x1 = *(const GAS f32x4*)(X1 + (size_t)r * D + c), m = *(const GAS f32x4*)(mixb + (size_t)r * D + c);
                v[j] = x1 * ALPHA + *(const f32x4*)(mrow + 5120 + c) * m; s += (v[j].x + v[j].y) + (v[j].z + v[j].w); } }
        const float mean2 = wave_sum(s) * (1.f / D); float s2 = 0.f;
#pragma unroll
        for (int j = 0; j < 4; ++j) { v[j] = v[j] - mean2; s2 += (v[j].x * v[j].x + v[j].y * v[j].y) + (v[j].z * v[j].z + v[j].w * v[j].w); }
        const float rstd2 = 1.f / sqrtf(wave_sum(s2) * (1.f / D) + 1e-5f);
#pragma unroll
        for (int j = 0; j < 4; ++j) { const int c = 256 * j + 4 * F.lane; const f32x4 y = v[j] * rstd2 * *(const f32x4*)(lg + c) + *(const f32x4*)(lb + c);
            if (WHICH == 0) { *(GAS f32x4*)(X1 + (size_t)r * D + c) = y;
                const f32x4 u = y * (*(const f32x4*)(mrow + 4096 + c) + 1.f) + *(const f32x4*)(mrow + 3072 + c);
                *(GAS unsigned long long*)(U + (size_t)r * D + c) = (unsigned long long)pk2(u.x, u.y) | ((unsigned long long)pk2(u.z, u.w) << 32); }
            else { float* o = r < RP ? a.out + O_YP + (size_t)r * D : a.out + O_YS + (size_t)(r - RP) * D; *(GAS f32x4*)(o + c) = y; } }
    }
}


typedef float f32x4_ __attribute__((ext_vector_type(4)));
__device__ __forceinline__ float bf2f(unsigned short h) { return __uint_as_float((unsigned)h << 16); }
__device__ __forceinline__ float gelu_tanh(float x) { const float u = 0.7978845608028654f * (x + 0.044715f * x * x * x); const float e = __expf(2.f * u); return x * (1.f - 1.f / (e + 1.f)); }
__device__ __forceinline__ void cmp_post_sample(Frame& F0, const Args& a) { Frame F = launder(F0);
    unsigned char* ws = a.ws; const bf16* P = (const bf16*)(ws + WS_PCMP); const bf16* w2t = (const bf16*)(ws + WS_W2T); const float* cbias = (const float*)(ws + WS_CBIAS);
    float* kcvs = (float*)(ws + WS_KCVS);
    const int gw = F.vcu * NWAVES + F.wave, NGW = F.G * NWAVES, lr = F.lane & 15, quad = F.lane >> 4;
    for (int c = 0; c < 2; ++c) { bf16x8 wf[4][4];
#pragma unroll
      for (int nt = 0; nt < 4; ++nt)
#pragma unroll
        for (int ks = 0; ks < 4; ++ks) wf[nt][ks] = *(const bf16x8*)(w2t + ((size_t)c * 64 + 16 * nt + lr) * 128 + 32 * ks + 8 * quad);
      f32x4 cb[4][2];
#pragma unroll
      for (int ks = 0; ks < 4; ++ks) { cb[ks][0] = *(const f32x4*)(cbias + c * 128 + 32 * ks + 8 * quad); cb[ks][1] = *(const f32x4*)(cbias + c * 128 + 32 * ks + 8 * quad + 4); }
      for (int tt = gw; tt < 4092; tt += NGW) {
        const int rho = tt * 16 + lr; const bool valid = rho < 65472; const int rc = valid ? rho : 65471;
        const int b = rc / 2046, rem = rc % 2046, n = rem >> 1, g = rem & 1;
        const bf16* p0 = P + (size_t)c * 65536 * 256 + ((size_t)(b * 1024 + n) * 2 + g) * 256; const bf16* p1 = p0 + 2 * 256 + 128;
        bf16x8 x0[4], x1[4];
#pragma unroll
        for (int ks = 0; ks < 4; ++ks) { x0[ks] = *(const bf16x8*)(p0 + 32 * ks + 8 * quad); x1[ks] = *(const bf16x8*)(p1 + 32 * ks + 8 * quad); }
        bf16x8 hf[4];
#pragma unroll
        for (int ks = 0; ks < 4; ++ks) { float h[8];
#pragma unroll
            for (int e = 0; e < 8; ++e) h[e] = gelu_tanh(bf2f((unsigned short)x0[ks][e]) + bf2f((unsigned short)x1[ks][e]) + (e < 4 ? cb[ks][0][e] : cb[ks][1][e - 4]));
            v4u w; w.x = pk2(h[0], h[1]); w.y = pk2(h[2], h[3]); w.z = pk2(h[4], h[5]); w.w = pk2(h[6], h[7]); hf[ks] = __builtin_bit_cast(bf16x8, w); }
#pragma unroll
        for (int nt = 0; nt < 4; ++nt) { f32x4 acc = {0.f, 0.f, 0.f, 0.f};
#pragma unroll
            for (int ks = 0; ks < 4; ++ks) acc = __builtin_amdgcn_mfma_f32_16x16x32_bf16(wf[nt][ks], hf[ks], acc, 0, 0, 0);
            if (valid) *(GAS f32x4*)(kcvs + (((size_t)b * 1023 + n) * 2 + c) * 128 + g * 64 + 16 * nt + 4 * quad) = acc; }
      } }
}
__device__ __forceinline__ void cmp_prompt(Frame& F0, const Args& a) { Frame F = launder(F0);
    unsigned char* ws = a.ws; const bf16* ZB = (const bf16*)(ws + WS_ZB); const bf16* w1r = (const bf16*)(ws + WS_W1R); const bf16* w2t = (const bf16*)(ws + WS_W2T);
    const float* cbias = (const float*)(ws + WS_CBIAS); float* kcvp = (float*)(ws + WS_KCVP);
    LAS float* red = (LAS float*)(F.lds + RING_OFF);
    LAS bf16* H = (LAS bf16*)(F.lds + RING_OFF + 65536);
    const int lr = F.lane & 15, quad = F.lane >> 4;
    for (int unit = blockIdx.x; unit < 2 * 127; unit += F.G) { const int c = unit / 127, tt = unit % 127;
        const int rho = tt * 16 + lr; const int b = rho / 254, rem = rho % 254, n = rem >> 1, g = rem & 1;
        const bf16* arow = ZB + ((size_t)b * 2048 + 16 * n) * ZN + PZ_KVC + c * 128 + g * 64;
        f32x4 acc[8];
#pragma unroll
        for (int nt = 0; nt < 8; ++nt) acc[nt] = (f32x4){0.f, 0.f, 0.f, 0.f};
#pragma unroll 2
        for (int ks = 0; ks < 8; ++ks) { const int k = F.wave * 256 + ks * 32 + quad * 8;
            const bf16x8 af = *(const bf16x8*)(arow + (size_t)(k >> 6) * ZN + (k & 63));
            const bf16* wb = w1r + ((size_t)c * 256 + (k >> 10) * 128 + lr) * 1024 + (k & 1023);
#pragma unroll
            for (int nt = 0; nt < 8; ++nt) { const bf16x8 bf = *(const bf16x8*)(wb + (size_t)nt * 16 * 1024); acc[nt] = __builtin_amdgcn_mfma_f32_16x16x32_bf16(af, bf, acc[nt], 0, 0, 0); } }
#pragma unroll
        for (int nt = 0; nt < 8; ++nt)
#pragma unroll
            for (int e = 0; e < 4; ++e) red[(F.wave * 16 + 4 * quad + e) * 128 + 16 * nt + lr] = acc[nt][e];
        __syncthreads();
        { const int row = F.tid >> 5, h4 = (F.tid & 31) * 4; f32x4 s = *(const f32x4*)(cbias + c * 128 + h4);
#pragma unroll
          for (int w = 0; w < 8; ++w) s += *(const LAS f32x4*)(red + (w * 16 + row) * 128 + h4);
          *(LAS unsigned long long*)(H + row * 136 + h4) = (unsigned long long)pk2(gelu_tanh(s.x), gelu_tanh(s.y)) | ((unsigned long long)pk2(gelu_tanh(s.z), gelu_tanh(s.w)) << 32); }
        __syncthreads();
        if (F.wave < 4) { const int nt = F.wave; f32x4 o = {0.f, 0.f, 0.f, 0.f};
#pragma unroll
            for (int ks = 0; ks < 4; ++ks) { const bf16x8 wf = *(const bf16x8*)(w2t + ((size_t)c * 64 + 16 * nt + lr) * 128 + 32 * ks + 8 * quad);
                const bf16x8 hf = *(const LAS bf16x8*)(H + lr * 136 + 32 * ks + 8 * quad);
                o = __builtin_amdgcn_mfma_f32_16x16x32_bf16(wf, hf, o, 0, 0, 0); }
            *(GAS f32x4*)(kcvp + (((size_t)b * 127 + n) * 2 + c) * 128 + g * 64 + 16 * nt + 4 * quad) = o;
            const int d0 = 16 * nt + 4 * quad;
            if (c == 0) *(GAS unsigned long long*)((bf16*)(ws + WS_KC) + ((size_t)(b * 2 + g) * 128 + n) * 64 + d0) = (unsigned long long)pk2(o.x, o.y) | ((unsigned long long)pk2(o.z, o.w) << 32);
            else { bf16* vt = (bf16*)(ws + WS_VTC) + ((size_t)(b * 2 + g) * 64 + d0) * 128 + n; vt[0] = (bf16)f2bf(o.x); vt[128] = (bf16)f2bf(o.y); vt[256] = (bf16)f2bf(o.z); vt[384] = (bf16)f2bf(o.w); } }
        __syncthreads();
    }
    if (blockIdx.x == 0) for (int i = F.tid; i < 16 * 64; i += NTHR) { const int bg = i >> 6, d = i & 63; ((bf16*)(ws + WS_KC))[((size_t)bg * 128 + 127) * 64 + d] = 0; ((bf16*)(ws + WS_VTC))[((size_t)bg * 64 + d) * 128 + 127] = 0; }
}


__device__ __forceinline__ float logsig_f(float x) { return fminf(x, 0.f) - __logf(1.f + __expf(-fabsf(x))); }
__device__ __forceinline__ void gla_cumsum(Frame& F, const Args& a, int row0, int h, LAS float* Bc, LAS float* seg) {
    const float* narrow = (const float*)(a.ws + WS_NARROW); const float* w_a2 = (const float*)a.in[14]; const float* b_a = (const float*)a.in[15];
    { const int c = F.tid >> 3, dk0 = (F.tid & 7) * 8; const float* ar = narrow + (size_t)(row0 + c) * 64;
      const f32x4 a0 = *(const f32x4*)(ar), a1 = *(const f32x4*)(ar + 4), a2 = *(const f32x4*)(ar + 8), a3 = *(const f32x4*)(ar + 12);
      const float ag[16] = {a0.x, a0.y, a0.z, a0.w, a1.x, a1.y, a1.z, a1.w, a2.x, a2.y, a2.z, a2.w, a3.x, a3.y, a3.z, a3.w};
      f32x4 l0 = *(const f32x4*)(b_a + h * 64 + dk0), l1 = *(const f32x4*)(b_a + h * 64 + dk0 + 4);
#pragma unroll
      for (int r = 0; r < 16; ++r) { l0 += *(const f32x4*)(w_a2 + r * 256 + h * 64 + dk0) * ag[r]; l1 += *(const f32x4*)(w_a2 + r * 256 + h * 64 + dk0 + 4) * ag[r]; }
#pragma unroll
      for (int e = 0; e < 4; ++e) { Bc[c * 65 + dk0 + e] = logsig_f(l0[e]) * 0.0625f; Bc[c * 65 + dk0 + 4 + e] = logsig_f(l1[e]) * 0.0625f; } }
    __syncthreads();
    const int dk = F.tid & 63, sg = F.tid >> 6;
    { float run = 0.f;
#pragma unroll
      for (int i = 0; i < 8; ++i) { run += Bc[(sg * 8 + i) * 65 + dk]; Bc[(sg * 8 + i) * 65 + dk] = run; }
      seg[sg * 64 + dk] = run; }
    __syncthreads();
    { float off = 0.f;
#pragma unroll
      for (int s2 = 0; s2 < 8; ++s2) off += (s2 < sg) ? seg[s2 * 64 + dk] : 0.f;
#pragma unroll
      for (int i = 0; i < 8; ++i) Bc[(sg * 8 + i) * 65 + dk] += off; }
    __syncthreads();
}
__device__ __forceinline__ void gla_load_vt(Frame& F, const bf16* ZB, int row0, int h, LAS bf16* VT) {
#pragma unroll
    for (int q = 0; q < 2; ++q) { const int ch = F.tid + q * NTHR, c = ch >> 4, dv0 = (ch & 15) * 8;
        const bf16x8 vx = *(const bf16x8*)(ZB + (size_t)(row0 + c) * ZN + PZ_VG + h * 128 + dv0);
#pragma unroll
        for (int e = 0; e < 8; ++e) VT[(dv0 + e) * 72 + c] = (bf16)vx[e]; }
}
__device__ __forceinline__ void gla_a(Frame& F0, const Args& a) { Frame F = launder(F0);
    unsigned char* ws = a.ws; const bf16* ZB = (const bf16*)(ws + WS_ZB); float* glas = (float*)(ws + WS_GLAS); float* glad = (float*)(ws + WS_GLAD);
    LAS float* Bc = (LAS float*)(F.lds + RING_OFF); LAS float* seg = (LAS float*)(F.lds + RING_OFF + 16640);
    LAS bf16* KT = (LAS bf16*)(F.lds + RING_OFF + 18688); LAS bf16* VT = (LAS bf16*)(F.lds + RING_OFF + 73984);
    const int lr = F.lane & 15, quad = F.lane >> 4;
    for (int unit = blockIdx.x; unit < 1024; unit += F.G) { const int b = unit >> 7, h = (unit >> 5) & 3, n = unit & 31, row0 = b * 2048 + n * 64;
        gla_cumsum(F, a, row0, h, Bc, seg);
        { const int c = F.tid >> 3, dk0 = (F.tid & 7) * 8; const bf16x8 kx = *(const bf16x8*)(ZB + (size_t)(row0 + c) * ZN + PZ_KG + h * 64 + dk0);
#pragma unroll
          for (int e = 0; e < 8; ++e) KT[(dk0 + e) * 72 + c] = (bf16)f2bf(bf2f((unsigned short)kx[e]) * __expf(Bc[63 * 65 + dk0 + e] - Bc[c * 65 + dk0 + e])); }
        gla_load_vt(F, ZB, row0, h, VT);
        if (F.tid < 64) glad[(size_t)unit * 64 + F.tid] = __expf(Bc[63 * 65 + F.tid]);
        __syncthreads();
#pragma unroll
        for (int it = 0; it < 4; ++it) { f32x4 acc = {0.f, 0.f, 0.f, 0.f};
#pragma unroll
            for (int ks = 0; ks < 2; ++ks) { const bf16x8 af = *(const LAS bf16x8*)(KT + (16 * it + lr) * 72 + 32 * ks + 8 * quad), bf = *(const LAS bf16x8*)(VT + (16 * F.wave + lr) * 72 + 32 * ks + 8 * quad);
                acc = __builtin_amdgcn_mfma_f32_16x16x32_bf16(af, bf, acc, 0, 0, 0); }
            *(GAS f32x4*)(glas + ((size_t)unit * 128 + 16 * F.wave + lr) * 64 + 16 * it + 4 * quad) = acc; }
        __syncthreads();
    }
}
__device__ __forceinline__ void gla_scan(Frame& F0, const Args& a) { Frame F = launder(F0);
    float* glas = (float*)(a.ws + WS_GLAS); const float* glad = (const float*)(a.ws + WS_GLAD);
    for (int idx = blockIdx.x * NTHR + F.tid; idx < 32 * 8192; idx += F.G * NTHR) { const int bh = idx >> 13, rest = idx & 8191, dk = rest & 63, dv = rest >> 6;
        float kv[32], d[32];
#pragma unroll
        for (int n = 0; n < 32; ++n) { kv[n] = glas[((size_t)(bh * 32 + n)) * 8192 + rest]; d[n] = glad[(size_t)(bh * 32 + n) * 64 + dk]; }
        float S = 0.f;
#pragma unroll
        for (int n = 0; n < 32; ++n) { glas[((size_t)(bh * 32 + n)) * 8192 + rest] = S; S = d[n] * S + kv[n]; }
        a.out[O_GSP + ((size_t)bh * 64 + dk) * 128 + dv] = S; }
}
__device__ __forceinline__ void gla_c(Frame& F0, const Args& a) { Frame F = launder(F0);
    unsigned char* ws = a.ws; const bf16* ZB = (const bf16*)(ws + WS_ZB); const float* glas = (const float*)(ws + WS_GLAS); bf16* ATT = (bf16*)(ws + WS_ATT);
    const float* gamma = (const float*)a.in[16];
    LAS float* Bc = (LAS float*)(F.lds + RING_OFF); LAS float* seg = (LAS float*)(F.lds + RING_OFF + 16640);
    LAS bf16* QH = (LAS bf16*)(F.lds + RING_OFF + 18688); LAS bf16* KH = (LAS bf16*)(F.lds + RING_OFF + 27904); LAS bf16* QT = (LAS bf16*)(F.lds + RING_OFF + 37120);
    LAS bf16* AM = (LAS bf16*)(F.lds + RING_OFF + 46336); LAS bf16* ST = (LAS bf16*)(F.lds + RING_OFF + 55552); LAS bf16* VT = (LAS bf16*)(F.lds + RING_OFF + 73984);
    LAS float* ssq = (LAS float*)(F.lds + RING_OFF + 92416);
    const int lr = F.lane & 15, quad = F.lane >> 4;
    for (int unit = blockIdx.x; unit < 1024; unit += F.G) { const int b = unit >> 7, h = (unit >> 5) & 3, n = unit & 31, row0 = b * 2048 + n * 64;
        gla_cumsum(F, a, row0, h, Bc, seg);
        { const int c = F.tid >> 3, dk0 = (F.tid & 7) * 8; const bf16* zr = ZB + (size_t)(row0 + c) * ZN + h * 64 + dk0;
          const bf16x8 qx = *(const bf16x8*)(zr + PZ_QG), kx = *(const bf16x8*)(zr + PZ_KG); float qh[8], kh[8], qt[8];
#pragma unroll
          for (int e = 0; e < 8; ++e) { const float bc = Bc[c * 65 + dk0 + e], bm = Bc[31 * 65 + dk0 + e], q = bf2f((unsigned short)qx[e]), k = bf2f((unsigned short)kx[e]);
              qh[e] = q * __expf(bc - bm); kh[e] = k * __expf(bm - bc); qt[e] = q * __expf(bc); }
          v4u w; w.x = pk2(qh[0], qh[1]); w.y = pk2(qh[2], qh[3]); w.z = pk2(qh[4], qh[5]); w.w = pk2(qh[6], qh[7]); *(LAS v4u*)(QH + c * 72 + dk0) = w;
          w.x = pk2(kh[0], kh[1]); w.y = pk2(kh[2], kh[3]); w.z = pk2(kh[4], kh[5]); w.w = pk2(kh[6], kh[7]); *(LAS v4u*)(KH + c * 72 + dk0) = w;
          w.x = pk2(qt[0], qt[1]); w.y = pk2(qt[2], qt[3]); w.z = pk2(qt[4], qt[5]); w.w = pk2(qt[6], qt[7]); *(LAS v4u*)(QT + c * 72 + dk0) = w; }
#pragma unroll
        for (int q = 0; q < 2; ++q) { const int ch = F.tid + q * NTHR, dv = ch >> 3, dk0 = (ch & 7) * 8; const float* sp = glas + ((size_t)unit * 128 + dv) * 64 + dk0;
            const f32x4 s0 = *(const GAS f32x4*)sp, s1 = *(const GAS f32x4*)(sp + 4);
            v4u w; w.x = pk2(s0.x, s0.y); w.y = pk2(s0.z, s0.w); w.z = pk2(s1.x, s1.y); w.w = pk2(s1.z, s1.w); *(LAS v4u*)(ST + dv * 72 + dk0) = w; }
        gla_load_vt(F, ZB, row0, h, VT);
        __syncthreads();
        { const int it = F.wave >> 1;
#pragma unroll
          for (int jj = 0; jj < 2; ++jj) { const int jt = 2 * (F.wave & 1) + jj; f32x4 acc = {0.f, 0.f, 0.f, 0.f};
#pragma unroll
              for (int ks = 0; ks < 2; ++ks) { const bf16x8 af = *(const LAS bf16x8*)(QH + (16 * it + lr) * 72 + 32 * ks + 8 * quad), bf = *(const LAS bf16x8*)(KH + (16 * jt + lr) * 72 + 32 * ks + 8 * quad);
                  acc = __builtin_amdgcn_mfma_f32_16x16x32_bf16(af, bf, acc, 0, 0, 0); }
#pragma unroll
              for (int e = 0; e < 4; ++e) { const int i = 16 * it + 4 * quad + e, j = 16 * jt + lr; AM[i * 72 + j] = (bf16)f2bf(j <= i ? acc[e] : 0.f); } } }
        __syncthreads();
        { const int it = F.wave >> 1; f32x4 acc[4]; float sq = 0.f;
#pragma unroll
          for (int mm = 0; mm < 4; ++mm) { const int mt = 4 * (F.wave & 1) + mm; acc[mm] = (f32x4){0.f, 0.f, 0.f, 0.f};
#pragma unroll
              for (int ks = 0; ks < 2; ++ks) { const bf16x8 af = *(const LAS bf16x8*)(VT + (16 * mt + lr) * 72 + 32 * ks + 8 * quad), bf = *(const LAS bf16x8*)(AM + (16 * it + lr) * 72 + 32 * ks + 8 * quad);
                  acc[mm] = __builtin_amdgcn_mfma_f32_16x16x32_bf16(af, bf, acc[mm], 0, 0, 0); }
#pragma unroll
              for (int ks = 0; ks < 2; ++ks) { const bf16x8 af = *(const LAS bf16x8*)(ST + (16 * mt + lr) * 72 + 32 * ks + 8 * quad), bf = *(const LAS bf16x8*)(QT + (16 * it + lr) * 72 + 32 * ks + 8 * quad);
                  acc[mm] = __builtin_amdgcn_mfma_f32_16x16x32_bf16(af, bf, acc[mm], 0, 0, 0); }
              sq += (acc[mm].x * acc[mm].x + acc[mm].y * acc[mm].y) + (acc[mm].z * acc[mm].z + acc[mm].w * acc[mm].w); }
          sq += xor_f<16>(sq); sq = swap32_sum(sq);
          if (quad == 0) ssq[(F.wave & 1) * 64 + 16 * it + lr] = sq;
          __syncthreads();
          const int i = 16 * it + lr; const float rs = rsqrtf((ssq[i] + ssq[64 + i]) * (1.f / 128.f) + 1e-6f);
#pragma unroll
          for (int mm = 0; mm < 4; ++mm) { const int dv0 = 16 * (4 * (F.wave & 1) + mm) + 4 * quad; const f32x4 gm = *(const f32x4*)(gamma + dv0);
              const unsigned long long rgw = *(const GAS unsigned long long*)(ZB + (size_t)(row0 + i) * ZN + PZ_RG + h * 128 + dv0); float o[4];
#pragma unroll
              for (int e = 0; e < 4; ++e) { const float rg = bf2f((unsigned short)(rgw >> (16 * e))); o[e] = acc[mm][e] * rs * gm[e] * rg / (1.f + __expf(-rg)); }
              *(GAS unsigned long long*)(ATT + (size_t)(row0 + i) * 1024 + h * 128 + dv0) = (unsigned long long)pk2(o[0], o[1]) | ((unsigned long long)pk2(o[2], o[3]) << 32); } }
        __syncthreads();
    }
}
__device__ __forceinline__ void gla_sample(Frame& F0, const Args& a) { Frame F = launder(F0);
    unsigned char* ws = a.ws; const bf16* ZB = (const bf16*)(ws + WS_ZB); const float* narrow = (const float*)(ws + WS_NARROW); bf16* ATT = (bf16*)(ws + WS_ATT);
    const float* st0 = (const float*)a.in[2]; const float* w_a2 = (const float*)a.in[14]; const float* b_a = (const float*)a.in[15]; const float* gamma = (const float*)a.in[16];
    LAS float* par = (LAS float*)(F.lds + RING_OFF); LAS float* tot = (LAS float*)(F.lds + RING_OFF + 4096); LAS float* gk = (LAS float*)(F.lds + RING_OFF + 8192);
    const int dv = F.tid & 127, dq = F.tid >> 7;
    for (int unit = blockIdx.x; unit < 128; unit += F.G) { const int b = unit >> 2, h = unit & 3;
        float S[16];
#pragma unroll
        for (int e = 0; e < 16; ++e) S[e] = st0[((size_t)unit * 64 + dq * 16 + e) * 128 + dv];
        for (int t = 0; t < 4; ++t) { const size_t row = (size_t)RP + b * 4 + t;
            if (F.tid < 64) { const int dk = h * 64 + F.tid; const float* ar = narrow + row * 64; float lg = b_a[dk];
#pragma unroll
                for (int r = 0; r < 16; ++r) lg += ar[r] * w_a2[r * 256 + dk];
                gk[F.tid] = __expf(logsig_f(lg) * 0.0625f); gk[64 + F.tid] = bf2f(ZB[row * ZN + PZ_KG + dk]); gk[128 + F.tid] = bf2f(ZB[row * ZN + PZ_QG + dk]); }
            __syncthreads();
            const float vv = bf2f(ZB[row * ZN + PZ_VG + h * 128 + dv]); float op = 0.f;
#pragma unroll
            for (int e = 0; e < 16; ++e) { const int dl = dq * 16 + e; S[e] = gk[dl] * S[e] + gk[64 + dl] * vv; op += gk[128 + dl] * S[e]; }
            par[dq * 128 + dv] = op; __syncthreads();
            const float o = (par[dv] + par[128 + dv]) + (par[256 + dv] + par[384 + dv]);
            if (F.tid < 128) { const float q = wave_sum(o * o); if (F.lane == 0) tot[F.wave] = q; }
            __syncthreads();
            if (F.tid < 128) { const float rs = rsqrtf((tot[0] + tot[1]) * (1.f / 128.f) + 1e-6f); const float rg = bf2f(ZB[row * ZN + PZ_RG + h * 128 + dv]);
                ATT[row * 1024 + h * 128 + dv] = (bf16)f2bf(o * rs * gamma[dv] * rg / (1.f + __expf(-rg))); }
            __syncthreads(); }
#pragma unroll
        for (int e = 0; e < 16; ++e) a.out[O_GSS + ((size_t)unit * 64 + dq * 16 + e) * 128 + dv] = S[e];
    }
}


__device__ __forceinline__ void make_vt(Frame& F0, const Args& a) { Frame F = launder(F0);
    unsigned char* ws = a.ws; const bf16* ZB = (const bf16*)(ws + WS_ZB);
    LAS bf16* T = (LAS bf16*)(F.lds + RING_OFF + F.wave * 9216);
    const int gw = F.vcu * NWAVES + F.wave, NGW = F.G * NWAVES;
    for (int it = gw; it < 1024; it += NGW) { const int which = it >> 9, b = (it >> 6) & 7, g = (it >> 5) & 1, tile = it & 31;
        const bf16* src = ZB + ((size_t)b * 2048 + 64 * tile) * ZN + (which ? PZ_KVW : PZ_KVS) + 128 + g * 64;
        bf16* dst = (bf16*)(ws + (which ? WS_VTW : WS_VTS)) + ((size_t)(b * 2 + g) * 64) * 2048 + 64 * tile;
#pragma unroll
        for (int i = 0; i < 8; ++i) { const int ch = i * 64 + F.lane, tok = ch >> 3, c8 = ch & 7; const bf16x8 x = *(const bf16x8*)(src + (size_t)tok * ZN + c8 * 8);
#pragma unroll
            for (int e = 0; e < 8; ++e) T[(c8 * 8 + e) * 72 + tok] = (bf16)x[e]; }
        LDS_WAIT(); asm volatile("" ::: "memory");
#pragma unroll
        for (int i = 0; i < 8; ++i) { const int ch = i * 64 + F.lane, d = ch >> 3, c8 = ch & 7; *(GAS v4u*)(dst + (size_t)d * 2048 + c8 * 8) = *(const LAS v4u*)(T + d * 72 + c8 * 8); }
        LDS_WAIT(); asm volatile("" ::: "memory");
    }
}
typedef float f32x16 __attribute__((ext_vector_type(16)));
constexpr float L2E = 1.4426950408889634f, NEGB = -1.0e30f;
constexpr int A_K0 = 0, A_K1 = 9216, A_V0 = 18432, A_V1 = 27136, A_IMPH = 36864, A_IMPC = 70656, A_SC = 104448, A_MASK = 112896;
struct AttnSt { float m, l; f32x16 o0, o1; };
__device__ __forceinline__ unsigned bfpair(float lo, float hi) { return pk2(lo, hi); }
__device__ __forceinline__ void attn_tile(const LAS bf16* Kb, const LAS bf16* Vb, const bf16x8 (&qr)[4], AttnSt& st, int mode, int itok, bool on, int lane) {
    const int q = lane & 31, hi = lane >> 5;
    f32x16 p0, p1;
#pragma unroll
    for (int r = 0; r < 16; ++r) { p0[r] = 0.f; p1[r] = 0.f; }
#pragma unroll
    for (int ds = 0; ds < 4; ++ds) { const bf16x8 k0 = *(const LAS bf16x8*)(Kb + q * 72 + 16 * ds + 8 * hi), k1 = *(const LAS bf16x8*)(Kb + (q + 32) * 72 + 16 * ds + 8 * hi);
        p0 = __builtin_amdgcn_mfma_f32_32x32x16_bf16(k0, qr[ds], p0, 0, 0, 0); p1 = __builtin_amdgcn_mfma_f32_32x32x16_bf16(k1, qr[ds], p1, 0, 0, 0); __builtin_amdgcn_sched_barrier(0); }
    float mx = NEGB;
#pragma unroll
    for (int r = 0; r < 16; ++r) { const int kv = (r & 3) + 8 * (r >> 2) + 4 * hi;
        const bool ok0 = on && (mode == 0 || (mode == 1 ? kv <= itok : kv > itok)), ok1 = on && (mode == 0 || (mode == 1 ? kv + 32 <= itok : kv + 32 > itok));
        p0[r] = ok0 ? p0[r] * L2E : NEGB; p1[r] = ok1 ? p1[r] * L2E : NEGB; mx = fmaxf(mx, fmaxf(p0[r], p1[r])); }
    mx = swap32_max(mx);
    const float mn = fmaxf(st.m, mx), alpha = __builtin_amdgcn_exp2f(st.m - mn); st.m = mn;
    float sum = 0.f;
#pragma unroll
    for (int r = 0; r < 16; ++r) { p0[r] = __builtin_amdgcn_exp2f(p0[r] - mn); p1[r] = __builtin_amdgcn_exp2f(p1[r] - mn); sum += p0[r] + p1[r]; }
    st.l = st.l * alpha + sum;
    if (__any(alpha != 1.0f)) { st.o0 *= alpha; st.o1 *= alpha; }
    __builtin_amdgcn_sched_barrier(0);
    bf16x8 pf[4];
#pragma unroll
    for (int s = 0; s < 4; ++s) { const f32x16& p = (s < 2) ? p0 : p1; const int o = 8 * (s & 1);
        v4u w; w.x = bfpair(p[o], p[o + 1]); w.y = bfpair(p[o + 2], p[o + 3]); w.z = bfpair(p[o + 4], p[o + 5]); w.w = bfpair(p[o + 6], p[o + 7]); pf[s] = __builtin_bit_cast(bf16x8, w); }
    __builtin_amdgcn_sched_barrier(0);
#pragma unroll
    for (int s = 0; s < 4; ++s) {
        typedef unsigned long long u64; typedef u64 u64x2 __attribute__((ext_vector_type(2)));
        u64x2 va, vb; va.x = *(const LAS u64*)(Vb + q * 68 + 16 * s + 4 * hi); va.y = *(const LAS u64*)(Vb + q * 68 + 16 * s + 8 + 4 * hi);
        vb.x = *(const LAS u64*)(Vb + (q + 32) * 68 + 16 * s + 4 * hi); vb.y = *(const LAS u64*)(Vb + (q + 32) * 68 + 16 * s + 8 + 4 * hi);
        st.o0 = __builtin_amdgcn_mfma_f32_32x32x16_bf16(__builtin_bit_cast(bf16x8, va), pf[s], st.o0, 0, 0, 0);
        st.o1 = __builtin_amdgcn_mfma_f32_32x32x16_bf16(__builtin_bit_cast(bf16x8, vb), pf[s], st.o1, 0, 0, 0); __builtin_amdgcn_sched_barrier(0); }
}
struct TileRegs { v4u k, v; };
__device__ __forceinline__ void tile_fetch(TileRegs& t, const bf16* kbase, size_t kpitch, const bf16* vbase, size_t vpitch, int tid) {
    const int row = tid >> 3, c8 = tid & 7; t.k = *(const GAS v4u*)(kbase + (size_t)row * kpitch + c8 * 8); t.v = *(const GAS v4u*)(vbase + (size_t)row * vpitch + c8 * 8); }
__device__ __forceinline__ void tile_store(const TileRegs& t, LAS bf16* Kb, LAS bf16* Vb, int tid) {
    typedef unsigned long long u64; const int row = tid >> 3, c8 = tid & 7; *(LAS v4u*)(Kb + row * 72 + c8 * 8) = t.k;
    *(LAS u64*)(Vb + row * 68 + c8 * 8) = (u64)t.v.x | ((u64)t.v.y << 32); *(LAS u64*)(Vb + row * 68 + c8 * 8 + 4) = (u64)t.v.z | ((u64)t.v.w << 32); }

__device__ __forceinline__ void nsa_prompt_unit(Frame& F, const Args& a, int b, int g, int qb) {
    unsigned char* ws = a.ws; const bf16* ZB = (const bf16*)(ws + WS_ZB); const float* narrow = (const float*)(ws + WS_NARROW); bf16* ATT = (bf16*)(ws + WS_ATT);
    LAS bf16* KB0 = (LAS bf16*)(F.lds + RING_OFF + A_K0); LAS bf16* KB1 = (LAS bf16*)(F.lds + RING_OFF + A_K1); LAS bf16* VB0 = (LAS bf16*)(F.lds + RING_OFF + A_V0); LAS bf16* VB1 = (LAS bf16*)(F.lds + RING_OFF + A_V1);
    LAS float* IMPH = (LAS float*)(F.lds + RING_OFF + A_IMPH); LAS float* IMPC = (LAS float*)(F.lds + RING_OFF + A_IMPC); LAS float* SC = (LAS float*)(F.lds + RING_OFF + A_SC);
    LAS unsigned* MASK = (LAS unsigned*)(F.lds + RING_OFF + A_MASK);
    const int lane = F.lane, q = lane & 31, hi = lane >> 5, r = F.wave >> 1, th = F.wave & 1, itok = 32 * th + q, t0 = 64 * qb, t = t0 + itok, h = g * 4 + r;
    const size_t row = (size_t)b * 2048 + t;
    bf16x8 qr[4];
#pragma unroll
    for (int ds = 0; ds < 4; ++ds) qr[ds] = *(const bf16x8*)(ZB + row * ZN + PZ_QN + h * 64 + 16 * ds + 8 * hi);
    float gate[3];
#pragma unroll
    for (int br = 0; br < 3; ++br) { const float gx = narrow[row * 64 + 16 + h * 3 + br]; gate[br] = 1.f / (1.f + __expf(-gx)); }
    f32x16 oc0, oc1;
    LAS float* stg = (LAS float*)(F.lds + RING_OFF + A_IMPH) + F.wave * 2048 + lane;
    { const bf16* kc = (const bf16*)(ws + WS_KC) + (size_t)(b * 2 + g) * 128 * 64; const bf16* vtc = (const bf16*)(ws + WS_VTC) + (size_t)(b * 2 + g) * 64 * 128;
      TileRegs ta, tb; tile_fetch(ta, kc, 64, vtc, 128, F.tid); tile_fetch(tb, kc + 64 * 64, 64, vtc + 64, 128, F.tid);
      tile_store(ta, KB0, VB0, F.tid); tile_store(tb, KB1, VB1, F.tid);
      __syncthreads();
      f32x16 pa0, pa1, pb0, pb1;
#pragma unroll
      for (int rr = 0; rr < 16; ++rr) { pa0[rr] = 0.f; pa1[rr] = 0.f; pb0[rr] = 0.f; pb1[rr] = 0.f; }
#pragma unroll
      for (int ds = 0; ds < 4; ++ds) { const int ko = 16 * ds + 8 * hi;
          pa0 = __builtin_amdgcn_mfma_f32_32x32x16_bf16(*(const LAS bf16x8*)(KB0 + q * 72 + ko), qr[ds], pa0, 0, 0, 0); pa1 = __builtin_amdgcn_mfma_f32_32x32x16_bf16(*(const LAS bf16x8*)(KB0 + (q + 32) * 72 + ko), qr[ds], pa1, 0, 0, 0);
          pb0 = __builtin_amdgcn_mfma_f32_32x32x16_bf16(*(const LAS bf16x8*)(KB1 + q * 72 + ko), qr[ds], pb0, 0, 0, 0); pb1 = __builtin_amdgcn_mfma_f32_32x32x16_bf16(*(const LAS bf16x8*)(KB1 + (q + 32) * 72 + ko), qr[ds], pb1, 0, 0, 0); }
      const int nmax = t >= 31 ? ((t - 31) >> 4) : -1; float mx = NEGB;
#pragma unroll
      for (int rr = 0; rr < 16; ++rr) { const int kv = (rr & 3) + 8 * (rr >> 2) + 4 * hi;
          pa0[rr] = (kv <= nmax) ? pa0[rr] * L2E : NEGB; pa1[rr] = (kv + 32 <= nmax) ? pa1[rr] * L2E : NEGB; pb0[rr] = (kv + 64 <= nmax) ? pb0[rr] * L2E : NEGB; pb1[rr] = (kv + 96 <= nmax) ? pb1[rr] * L2E : NEGB;
          mx = fmaxf(fmaxf(mx, fmaxf(pa0[rr], pa1[rr])), fmaxf(pb0[rr], pb1[rr])); }
      mx = swap32_max(mx); float sum = 0.f;
#pragma unroll
      for (int rr = 0; rr < 16; ++rr) { const int kv = (rr & 3) + 8 * (rr >> 2) + 4 * hi;
          pa0[rr] = (kv <= nmax) ? __builtin_amdgcn_exp2f(pa0[rr] - mx) : 0.f; pa1[rr] = (kv + 32 <= nmax) ? __builtin_amdgcn_exp2f(pa1[rr] - mx) : 0.f;
          pb0[rr] = (kv + 64 <= nmax) ? __builtin_amdgcn_exp2f(pb0[rr] - mx) : 0.f; pb1[rr] = (kv + 96 <= nmax) ? __builtin_amdgcn_exp2f(pb1[rr] - mx) : 0.f;
          sum += (pa0[rr] + pa1[rr]) + (pb0[rr] + pb1[rr]); }
      sum = swap32_sum(sum); const float inv = sum > 0.f ? 1.f / sum : 0.f;
#pragma unroll
      for (int rr = 0; rr < 16; ++rr) { pa0[rr] *= inv; pa1[rr] *= inv; pb0[rr] *= inv; pb1[rr] *= inv; }
      { LAS float* ih = IMPH + (r * 64 + itok) * 33; LAS float* ic = IMPC + (r * 64 + itok) * 33;
        if (hi == 0) ic[0] = 0.f;
#pragma unroll
        for (int rg = 0; rg < 4; ++rg) {
            const int j0 = 2 * rg + hi;
            ih[j0] = (pa0[4 * rg] + pa0[4 * rg + 1]) + (pa0[4 * rg + 2] + pa0[4 * rg + 3]); ic[j0 + 1] = pa0[4 * rg + 3];
            ih[j0 + 8] = (pa1[4 * rg] + pa1[4 * rg + 1]) + (pa1[4 * rg + 2] + pa1[4 * rg + 3]); ic[j0 + 9] = pa1[4 * rg + 3];
            ih[j0 + 16] = (pb0[4 * rg] + pb0[4 * rg + 1]) + (pb0[4 * rg + 2] + pb0[4 * rg + 3]); ic[j0 + 17] = pb0[4 * rg + 3];
            ih[j0 + 24] = (pb1[4 * rg] + pb1[4 * rg + 1]) + (pb1[4 * rg + 2] + pb1[4 * rg + 3]); ic[j0 + 25] = pb1[4 * rg + 3]; } }
#pragma unroll
      for (int rr = 0; rr < 16; ++rr) { oc0[rr] = 0.f; oc1[rr] = 0.f; }
#pragma unroll
      for (int s = 0; s < 8; ++s) { const f32x16& p = (s < 2) ? pa0 : (s < 4) ? pa1 : (s < 6) ? pb0 : pb1; const int o = 8 * (s & 1); const LAS bf16* Vb = (s < 4) ? VB0 : VB1; const int sl = s & 3;
          v4u w; w.x = bfpair(p[o], p[o + 1]); w.y = bfpair(p[o + 2], p[o + 3]); w.z = bfpair(p[o + 4], p[o + 5]); w.w = bfpair(p[o + 6], p[o + 7]); const bf16x8 pf = __builtin_bit_cast(bf16x8, w);
          typedef unsigned long long u64; typedef u64 u64x2 __attribute__((ext_vector_type(2)));
          u64x2 va, vb; va.x = *(const LAS u64*)(Vb + q * 68 + 16 * sl + 4 * hi); va.y = *(const LAS u64*)(Vb + q * 68 + 16 * sl + 8 + 4 * hi);
          vb.x = *(const LAS u64*)(Vb + (q + 32) * 68 + 16 * sl + 4 * hi); vb.y = *(const LAS u64*)(Vb + (q + 32) * 68 + 16 * sl + 8 + 4 * hi);
          oc0 = __builtin_amdgcn_mfma_f32_32x32x16_bf16(__builtin_bit_cast(bf16x8, va), pf, oc0, 0, 0, 0); oc1 = __builtin_amdgcn_mfma_f32_32x32x16_bf16(__builtin_bit_cast(bf16x8, vb), pf, oc1, 0, 0, 0); }
      oc0 *= gate[0]; oc1 *= gate[0];
    }
    __syncthreads();
    if (qb >= 16) {
        const int tok = F.tid >> 3, jg = F.tid & 7;
#pragma unroll
        for (int e = 0; e < 4; ++e) { const int j = jg * 4 + e; float im = 0.f;
#pragma unroll
            for (int hh = 0; hh < 4; ++hh) im += IMPH[(hh * 64 + tok) * 33 + j] + IMPC[(hh * 64 + tok) * 33 + j];
            const bool forced = (j == 0) || (j == qb) || (j == qb - 1);
            SC[tok * 33 + j] = (j <= qb) ? im + (forced ? 1.0e4f : 0.f) : -INFINITY; }
        __syncthreads();
        unsigned bits = 0u;
#pragma unroll
        for (int e = 0; e < 4; ++e) { const int j = jg * 4 + e; const float sj = SC[tok * 33 + j]; int cnt = 0;
            for (int k = 0; k < 32; ++k) { const float sk = SC[tok * 33 + k]; cnt += (sk > sj || (sk == sj && k < j)) ? 1 : 0; }
            bits |= (cnt < 16 ? 1u : 0u) << j; }
        MASK[tok * 8 + jg] = bits;
        __syncthreads();
    }
    unsigned selmask = 0xffffffffu;
    if (qb >= 16) { const v4u m0 = *(const LAS v4u*)(MASK + itok * 8), m1 = *(const LAS v4u*)(MASK + itok * 8 + 4); selmask = (m0.x | m0.y) | (m0.z | m0.w) | (m1.x | m1.y) | (m1.z | m1.w); }
#pragma unroll
    for (int rr = 0; rr < 16; ++rr) { stg[rr * 64] = oc0[rr]; stg[(16 + rr) * 64] = oc1[rr]; }
    { AttnSt st; st.m = NEGB; st.l = 0.f;
#pragma unroll
      for (int rr = 0; rr < 16; ++rr) { st.o0[rr] = 0.f; st.o1[rr] = 0.f; }
      const bf16* kb = ZB + (size_t)b * 2048 * ZN + PZ_KVS + g * 64; const bf16* vb = (const bf16*)(ws + WS_VTS) + (size_t)(b * 2 + g) * 64 * 2048;
      TileRegs tr; tile_fetch(tr, kb, ZN, vb, 2048, F.tid);
      for (int j = 0; j <= qb; ++j) { LAS bf16* Kb = (j & 1) ? KB1 : KB0; LAS bf16* Vb = (j & 1) ? VB1 : VB0;
          tile_store(tr, Kb, Vb, F.tid); __syncthreads();
          if (j < qb) tile_fetch(tr, kb + (size_t)(j + 1) * 64 * ZN, ZN, vb + (j + 1) * 64, 2048, F.tid);
          attn_tile(Kb, Vb, qr, st, j == qb ? 1 : 0, itok, (selmask >> j) & 1u, lane); }
      const float l = swap32_sum(st.l), f = gate[1] / l;
#pragma unroll
      for (int rr = 0; rr < 16; ++rr) { stg[rr * 64] += st.o0[rr] * f; stg[(16 + rr) * 64] += st.o1[rr] * f; } }
    __syncthreads();
    { AttnSt st; st.m = NEGB; st.l = 0.f;
#pragma unroll
      for (int rr = 0; rr < 16; ++rr) { st.o0[rr] = 0.f; st.o1[rr] = 0.f; }
      const bf16* kb = ZB + (size_t)b * 2048 * ZN + PZ_KVW + g * 64; const bf16* vb = (const bf16*)(ws + WS_VTW) + (size_t)(b * 2 + g) * 64 * 2048;
      const int jlo = qb >= 8 ? qb - 8 : 0;
      TileRegs tr; tile_fetch(tr, kb + (size_t)qb * 64 * ZN, ZN, vb + qb * 64, 2048, F.tid);
      for (int j = qb, it = 0; j >= jlo; --j, ++it) { LAS bf16* Kb = (it & 1) ? KB1 : KB0; LAS bf16* Vb = (it & 1) ? VB1 : VB0;
          tile_store(tr, Kb, Vb, F.tid); __syncthreads();
          if (j > jlo) tile_fetch(tr, kb + (size_t)(j - 1) * 64 * ZN, ZN, vb + (j - 1) * 64, 2048, F.tid);
          attn_tile(Kb, Vb, qr, st, j == qb ? 1 : (j == qb - 8 ? 2 : 0), itok, true, lane); }
      const float l = swap32_sum(st.l), f = gate[2] / l;
#pragma unroll
      for (int rr = 0; rr < 16; ++rr) { oc0[rr] = stg[rr * 64] + st.o0[rr] * f; oc1[rr] = stg[(16 + rr) * 64] + st.o1[rr] * f; } }
    __syncthreads();
    { const f32x16& tot0 = oc0; const f32x16& tot1 = oc1; bf16* orow = ATT + row * 1024 + 512 + h * 64;
#pragma unroll
      for (int rg = 0; rg < 4; ++rg) { const int d0 = 8 * rg + 4 * hi;
          *(GAS unsigned long long*)(orow + d0) = (unsigned long long)pk2(tot0[4 * rg], tot0[4 * rg + 1]) | ((unsigned long long)pk2(tot0[4 * rg + 2], tot0[4 * rg + 3]) << 32);
          *(GAS unsigned long long*)(orow + 32 + d0) = (unsigned long long)pk2(tot1[4 * rg], tot1[4 * rg + 1]) | ((unsigned long long)pk2(tot1[4 * rg + 2], tot1[4 * rg + 3]) << 32); } }
}
__device__ __forceinline__ void nsa_prompt(Frame& F0, const Args& a) { Frame F = launder(F0);
    for (int v = blockIdx.x; v < 256; v += F.G) { const int bg = v >> 4, s = v & 15;
        nsa_prompt_unit(F, a, bg >> 1, bg & 1, 31 - s);
        nsa_prompt_unit(F, a, bg >> 1, bg & 1, s); }
}


template <class KP> __device__ __forceinline__ float attend512(Frame& F, int NK, KP kp, LAS float* sc, LAS unsigned long long* kptr, const LAS float* qs, const float* dummy, LAS float* po) {
    int i0 = F.tid; asm volatile("" : "+v"(i0));
    for (int i = i0; i < NK; i += NTHR) { const float* k = kp(i); kptr[i] = (unsigned long long)(uintptr_t)(k ? k : dummy);
        float s0 = NEGB, s1 = NEGB, s2 = NEGB, s3 = NEGB;
        if (k) { s0 = 0.f; s1 = 0.f; s2 = 0.f; s3 = 0.f;
#pragma unroll
            for (int c = 0; c < 16; ++c) { const f32x4 kv = *(const GAS f32x4*)(k + 4 * c);
                const f32x4 q0 = *(const LAS f32x4*)(qs + 4 * c), q1 = *(const LAS f32x4*)(qs + 64 + 4 * c), q2 = *(const LAS f32x4*)(qs + 128 + 4 * c), q3 = *(const LAS f32x4*)(qs + 192 + 4 * c);
                s0 += (kv.x * q0.x + kv.y * q0.y) + (kv.z * q0.z + kv.w * q0.w); s1 += (kv.x * q1.x + kv.y * q1.y) + (kv.z * q1.z + kv.w * q1.w);
                s2 += (kv.x * q2.x + kv.y * q2.y) + (kv.z * q2.z + kv.w * q2.w); s3 += (kv.x * q3.x + kv.y * q3.y) + (kv.z * q3.z + kv.w * q3.w); } }
        sc[i] = s0; sc[1024 + i] = s1; sc[2048 + i] = s2; sc[3072 + i] = s3; }
    __syncthreads();
    if (F.wave < 4) { LAS float* row = sc + F.wave * 1024; float m = NEGB;
        for (int i = F.lane; i < NK; i += 64) m = fmaxf(m, row[i]);
        m = wave_max(m);
        float sum = 0.f;
        for (int i = F.lane; i < NK; i += 64) { const float x = row[i]; const float e = (x > -1.0e29f) ? __expf(x - m) : 0.f; row[i] = e; sum += e; }
        sum = wave_sum(sum); const float inv = 1.f / fmaxf(sum, 1.0e-30f);
        for (int i = F.lane; i < NK; i += 64) row[i] *= inv; }
    __syncthreads();
    { const int ks = F.tid >> 4, dq = (F.tid & 15) * 4; f32x4 o0 = {0.f, 0.f, 0.f, 0.f}, o1 = o0, o2 = o0, o3 = o0;
      int i = ks;
      for (; i + 224 < NK; i += 256) { f32x4 v[8];
#pragma unroll
          for (int u = 0; u < 8; ++u) v[u] = *(const GAS f32x4*)((const float*)(uintptr_t)kptr[i + 32 * u] + 128 + dq);
#pragma unroll
          for (int u = 0; u < 8; ++u) { const int k = i + 32 * u; o0 += v[u] * sc[k]; o1 += v[u] * sc[1024 + k]; o2 += v[u] * sc[2048 + k]; o3 += v[u] * sc[3072 + k]; } }
      for (; i < NK; i += 32) { const f32x4 v = *(const GAS f32x4*)((const float*)(uintptr_t)kptr[i] + 128 + dq); o0 += v * sc[i]; o1 += v * sc[1024 + i]; o2 += v * sc[2048 + i]; o3 += v * sc[3072 + i]; }
      *(LAS f32x4*)(po + (ks * 4 + 0) * 64 + dq) = o0; *(LAS f32x4*)(po + (ks * 4 + 1) * 64 + dq) = o1; *(LAS f32x4*)(po + (ks * 4 + 2) * 64 + dq) = o2; *(LAS f32x4*)(po + (ks * 4 + 3) * 64 + dq) = o3; }
    __syncthreads();
    float res = 0.f;
    { const int r = (F.tid >> 6) & 3, d = F.tid & 63;
#pragma unroll 4
      for (int p = 0; p < 32; ++p) res += po[(p * 4 + r) * 64 + d]; }
    return res;
}
__device__ __forceinline__ void nsa_sample(Frame& F0, const Args& a) { Frame F = launder(F0);
    unsigned char* ws = a.ws; const bf16* ZB = (const bf16*)(ws + WS_ZB); const float* narrow = (const float*)(ws + WS_NARROW); bf16* ATT = (bf16*)(ws + WS_ATT);
    const float* kcvs = (const float*)(ws + WS_KCVS); const float* cslc = (const float*)a.in[4]; const float* cwin = (const float*)a.in[5]; const int* table = (const int*)a.in[6];
    LAS float* sc = (LAS float*)(F.lds + RING_OFF); LAS unsigned long long* kptr = (LAS unsigned long long*)(F.lds + RING_OFF + 16384); LAS float* qs = (LAS float*)(F.lds + RING_OFF + 24576);
    LAS float* score = (LAS float*)(F.lds + RING_OFF + 25600); LAS unsigned* flag = (LAS unsigned*)(F.lds + RING_OFF + 26656); LAS int* sel = (LAS int*)(F.lds + RING_OFF + 27712);
    LAS float* red = (LAS float*)(F.lds + RING_OFF + 27776); LAS float* po = (LAS float*)(F.lds + RING_OFF + 32768);
    for (int unit = blockIdx.x; unit < 256; unit += F.G) { const int b = unit >> 3, g = (unit >> 2) & 1, s = unit & 3, tq = 16384 + s; const size_t row = (size_t)RP + b * 4 + s;
        if (F.tid < 256) qs[F.tid] = bf2f(ZB[row * ZN + PZ_QN + (g * 4 + (F.tid >> 6)) * 64 + (F.tid & 63)]);
        __syncthreads();
        const float* kc = kcvs + (size_t)b * 1023 * 256 + g * 64;
        const float oc = attend512(F, 1023, [&](int i) -> const float* { return kc + (size_t)i * 256; }, sc, kptr, qs, kc, po);
        for (int j = F.tid; j < 257; j += NTHR) { float im = 0.f;
            for (int i = 4 * j - 1; i <= 4 * j + 3; ++i) if (i >= 0 && i < 1023) im += (sc[i] + sc[1024 + i]) + (sc[2048 + i] + sc[3072 + i]);
            score[j] = im + ((j == 0 || j >= 255) ? 1.0e4f : 0.f); }
        __syncthreads();
        for (int j = F.tid; j < 257; j += NTHR) { const float sj = score[j]; int cnt = 0;
            for (int k = 0; k < 257; ++k) { const float sk = score[k]; cnt += (sk > sj || (sk == sj && k < j)) ? 1 : 0; }
            flag[j] = cnt < 16 ? 1u : 0u; }
        __syncthreads();
        for (int j = F.tid; j < 257; j += NTHR) if (flag[j]) { int pos = 0; for (int k = 0; k < j; ++k) pos += (int)flag[k]; sel[pos] = j; }
        __syncthreads();
        const float os = attend512(F, 1024, [&](int i) -> const float* { const int pos = sel[i >> 6] * 64 + (i & 63); if (pos > tq) return nullptr;
            if (pos < 16384) return cslc + ((size_t)table[b * 128 + (pos >> 7)] * 128 + (pos & 127)) * 256 + g * 64;
            return a.out + O_SKS + (size_t)(b * 4 + (pos - 16384)) * 256 + g * 64; }, sc, kptr, qs, kc, po);
        const float ow = attend512(F, 516, [&](int i) -> const float* { const int tw = 15872 + i; if (tw > tq || tw <= tq - 512) return nullptr;
            return i < 512 ? cwin + ((size_t)b * 512 + i) * 256 + g * 64 : a.out + O_WKS + ((size_t)b * 512 + 508 + (i - 512)) * 256 + g * 64; }, sc, kptr, qs, kc, po);
        if (F.tid < 256) { const int h = g * 4 + (F.tid >> 6), d = F.tid & 63; const float* gn = narrow + row * 64 + 16 + h * 3;
            const float o = oc / (1.f + __expf(-gn[0])) + os / (1.f + __expf(-gn[1])) + ow / (1.f + __expf(-gn[2]));
            ATT[row * 1024 + 512 + h * 64 + d] = (bf16)f2bf(o); }
        __syncthreads();
    }
}


template <int NB, class BRow, class Epi> __device__ __forceinline__ void mini_gemm(Frame& F, const bf16* A, const bf16* Bt, int K, int nunits, BRow brow, Epi epi) {
    const int lr = F.lane & 15, quad = F.lane >> 4;
    for (int u = blockIdx.x; u < nunits; u += F.G) {
        const bf16* ap = A + (size_t)(16 * F.wave + lr) * K + 8 * quad; const bf16* bp0 = Bt + (size_t)(brow(u, 0) + lr) * K + 8 * quad; const bf16* bp1 = Bt + (size_t)(brow(u, NB - 1) + lr) * K + 8 * quad;
        f32x4 acc0 = {0.f, 0.f, 0.f, 0.f}, acc1 = {0.f, 0.f, 0.f, 0.f};
        for (int k0 = 0; k0 < K; k0 += 256) { bf16x8 af[8], b0[8], b1[8];
#pragma unroll
            for (int j = 0; j < 8; ++j) { af[j] = *(const bf16x8*)(ap + k0 + 32 * j); b0[j] = *(const bf16x8*)(bp0 + k0 + 32 * j); if (NB == 2) b1[j] = *(const bf16x8*)(bp1 + k0 + 32 * j); }
#pragma unroll
            for (int j = 0; j < 8; ++j) { acc0 = __builtin_amdgcn_mfma_f32_16x16x32_bf16(b0[j], af[j], acc0, 0, 0, 0); if (NB == 2) acc1 = __builtin_amdgcn_mfma_f32_16x16x32_bf16(b1[j], af[j], acc1, 0, 0, 0); } }
        epi(u, 16 * F.wave + lr, quad, acc0, acc1);
    }
}


__device__ __forceinline__ void mini_gemm_kq(Frame& F, const bf16* A, const bf16* Bt, int K, float* out) {
    const int lr = F.lane & 15, quad = F.lane >> 4, mt = F.wave & 1, kq = F.wave >> 1, KQ = K / 4;
    LAS float* red = (LAS float*)(F.lds + RING_OFF);
    for (int u = blockIdx.x; u < 256; u += F.G) { const int cg = u & 63, rg = u >> 6;
        const bf16* ap = A + (size_t)(32 * rg + 16 * mt + lr) * K + kq * KQ + 8 * quad; const bf16* bp = Bt + (size_t)(16 * cg + lr) * K + kq * KQ + 8 * quad;
        f32x4 acc = {0.f, 0.f, 0.f, 0.f};
        int k0 = 0;
        for (; k0 + 256 <= KQ; k0 += 256) { bf16x8 af[8], bfr[8];
#pragma unroll
            for (int j = 0; j < 8; ++j) { af[j] = *(const bf16x8*)(ap + k0 + 32 * j); bfr[j] = *(const bf16x8*)(bp + k0 + 32 * j); }
#pragma unroll
            for (int j = 0; j < 8; ++j) acc = __builtin_amdgcn_mfma_f32_16x16x32_bf16(bfr[j], af[j], acc, 0, 0, 0); }
        for (; k0 < KQ; k0 += 32) { const bf16x8 af = *(const bf16x8*)(ap + k0), bfr = *(const bf16x8*)(bp + k0); acc = __builtin_amdgcn_mfma_f32_16x16x32_bf16(bfr, af, acc, 0, 0, 0); }
        *(LAS f32x4*)(red + ((kq * 2 + mt) * 64 + F.lane) * 4) = acc;
        __syncthreads();
        if (kq == 0) { f32x4 t = acc;
#pragma unroll
            for (int q = 1; q < 4; ++q) t += *(const LAS f32x4*)(red + ((q * 2 + mt) * 64 + F.lane) * 4);
            *(GAS f32x4*)(out + (size_t)(32 * rg + 16 * mt + lr) * 1024 + 16 * cg + 4 * quad) = t; }
        __syncthreads();
    }
}

__global__ void __launch_bounds__(NTHR, 2) mega(Args args) {
    extern __shared__ __attribute__((aligned(16))) unsigned char lds[];
    Frame F; F.lds = (LAS unsigned char*)lds; F.tid = threadIdx.x; F.lane = F.tid & 63; F.wave = __builtin_amdgcn_readfirstlane(F.tid >> 6);
    F.G = gridDim.x; { const int bx = blockIdx.x; F.vcu = (F.G % 8 == 0) ? (bx % 8) * (F.G / 8) + bx / 8 : bx; }
    unsigned char* ws = args.ws; F.ctl = (gu32*)(ws + WS_CTL);
    for (int u = F.tid; u < (LDS_BYTES - LDSCTL_OFF) / 4; u += NTHR) ((LAS unsigned*)(F.lds + LDSCTL_OFF))[u] = 0u;
    __syncthreads();
    const int lo = args.ph_lo, hi = args.ph_hi;
    const bool multi = (hi - lo) > 1;
    unsigned* barw = (unsigned*)(F.ctl + CW_BAR) + args.li * XCD_BAR_WORDS;
    XcdBarrier bar; bar.bar = barw; bar.x = 0; bar.st = nullptr;
    if (multi) bar = xcd_barrier_post(barw, (volatile LAS unsigned*)(F.lds + MISC_OFF) + 8);
#ifndef MK_REP
#define MK_REP 0
#endif
#define IN(k) (lo <= (k) && (k) < hi)
#define REP2(k) if constexpr (((MK_REP >> (k)) & 1) != 0)
#define SEAM(k) do { if (IN(k) && IN((k) + 1)) xcd_barrier(bar); } while (0)
    if (IN(0)) { { p0_prologue(F, args); } REP2(0) { p0_prologue(F, args); } } SEAM(0);
    if (IN(1)) { { p1_ln_mod(F, args); } REP2(1) { p1_ln_mod(F, args); } } SEAM(1);
    if (IN(2)) { { pg8::Gemm g{(const pg8::bf16_t*)(ws + WS_U), (const pg8::bf16_t*)(ws + WS_WT_IN), RP, ZN, 1024}; pg8::ComboOrder S; S.init(F.G, (int)blockIdx.x);
        pg8::EpiZ E{(pg8::bf16_t*)(ws + WS_ZB), args.out, (float*)(ws + WS_NARROW), (pg8::bf16_t*)(ws + WS_PCMP)};
        pg8::gemm_phase<pg8::EpiZ, pg8::ComboOrder, true, true>(F.lds + RING_OFF, g, S, E);
        Frame Fm = launder(F); bf16* ZBs = (bf16*)(ws + WS_ZB) + (size_t)RP * ZN; float* nar = (float*)(ws + WS_NARROW) + (size_t)RP * 64; float* outp = args.out;
        mini_gemm<1>(Fm, (const bf16*)(ws + WS_U) + (size_t)RP * 1024, (const bf16*)(ws + WS_WT_IN), 1024, ZN / 16, [](int u, int) { return 16 * u; },
            [&](int u, int row, int quad, const f32x4& a0, const f32x4&) { const int n0 = 16 * u + 4 * quad, pn = n0 >> 8, cc = n0 & 255; const float sc = (pn == 0 || pn == 6 || pn == 7) ? 0.125f : 1.0f; const f32x4 v = a0 * sc;
                *(GAS unsigned long long*)(ZBs + (size_t)row * ZN + n0) = (unsigned long long)pk2(v.x, v.y) | ((unsigned long long)pk2(v.z, v.w) << 32);
                if (pn == 8) *(GAS f32x4*)(outp + O_CKS + (size_t)row * 256 + cc) = v; else if (pn == 9) *(GAS f32x4*)(outp + O_SKS + (size_t)row * 256 + cc) = v;
                else if (pn == 10) *(GAS f32x4*)(outp + O_WKS + ((size_t)(row >> 2) * 512 + 508 + (row & 3)) * 256 + cc) = v;
                else if (pn == 11 && cc < 64) *(GAS f32x4*)(nar + (size_t)row * 64 + cc) = v; }); } } SEAM(2);
    if (IN(3)) { { cmp_post_sample(F, args); cmp_prompt(F, args); gla_a(F, args); make_vt(F, args); } REP2(3) { cmp_post_sample(F, args); cmp_prompt(F, args); gla_a(F, args); make_vt(F, args); } } SEAM(3);
    if (IN(4)) { { gla_scan(F, args); } REP2(4) { gla_scan(F, args); } } SEAM(4);
    if (IN(5)) { { nsa_prompt(F, args); gla_c(F, args); gla_sample(F, args); nsa_sample(F, args); } REP2(5) { nsa_prompt(F, args); gla_c(F, args); gla_sample(F, args); nsa_sample(F, args); } } SEAM(5);
    if (IN(6)) { { pg8::Gemm g{(const pg8::bf16_t*)(ws + WS_ATT), (const pg8::bf16_t*)(ws + WS_WT_O), RP, 1024, 1024}; pg8::StaticOrder S; S.init(RP, 1024, F.G, (int)blockIdx.x);
        pg8::EpiF32 E{(float*)(ws + WS_H1), 1024};
        pg8::gemm_phase<pg8::EpiF32, pg8::StaticOrder, true, true>(F.lds + RING_OFF, g, S, E);
        Frame Fm = launder(F); float* h1s = (float*)(ws + WS_H1) + (size_t)RP * 1024;
        mini_gemm_kq(Fm, (const bf16*)(ws + WS_ATT) + (size_t)RP * 1024, (const bf16*)(ws + WS_WT_O), 1024, h1s); } } SEAM(6);
    if (IN(7)) { { p_res_ln<0>(F, args, 0, R); } REP2(7) { p_res_ln<0>(F, args, 0, R); } } SEAM(7);
    if (IN(8)) { { pg8::Gemm g{(const pg8::bf16_t*)(ws + WS_U), (const pg8::bf16_t*)(ws + WS_WT_F1), RP, F1N, 1024}; pg8::StaticOrder S; S.init(RP, F1N, F.G, (int)blockIdx.x);
        pg8::EpiSwiglu E{(pg8::bf16_t*)(ws + WS_HM)};
        pg8::gemm_phase<pg8::EpiSwiglu, pg8::StaticOrder, true, true>(F.lds + RING_OFF, g, S, E);
        Frame Fm = launder(F); bf16* hms = (bf16*)(ws + WS_HM) + (size_t)RP * DFF;
        mini_gemm<2>(Fm, (const bf16*)(ws + WS_U) + (size_t)RP * 1024, (const bf16*)(ws + WS_WT_F1), 1024, DFF / 16, [](int u, int which) { const int j0 = 16 * u; return 256 * (j0 >> 7) + (j0 & 127) + 128 * which; },
            [&](int u, int row, int quad, const f32x4& g4, const f32x4& u4) { float o[4];
#pragma unroll
                for (int e = 0; e < 4; ++e) o[e] = g4[e] * __builtin_amdgcn_rcpf(1.0f + __builtin_amdgcn_exp2f(-1.4426950408889634f * g4[e])) * u4[e];
                *(GAS unsigned long long*)(hms + (size_t)row * DFF + 16 * u + 4 * quad) = (unsigned long long)pk2(o[0], o[1]) | ((unsigned long long)pk2(o[2], o[3]) << 32); }); } } SEAM(8);
    if (IN(9)) { { pg8::Gemm g{(const pg8::bf16_t*)(ws + WS_HM), (const pg8::bf16_t*)(ws + WS_WT_F2), RP, 1024, DFF}; pg8::StaticOrder S; S.init(RP, 1024, F.G, (int)blockIdx.x);
        pg8::EpiF32 E{(float*)(ws + WS_H1), 1024};
        pg8::gemm_phase<pg8::EpiF32, pg8::StaticOrder, true, true>(F.lds + RING_OFF, g, S, E);
        Frame Fm = launder(F); float* h1s = (float*)(ws + WS_H1) + (size_t)RP * 1024;
        mini_gemm_kq(Fm, (const bf16*)(ws + WS_HM) + (size_t)RP * DFF, (const bf16*)(ws + WS_WT_F2), DFF, h1s); } } SEAM(9);
    if (IN(10)) { { p_res_ln<1>(F, args, 0, R); } REP2(10) { p_res_ln<1>(F, args, 0, R); } }
#undef IN
#undef SEAM
}


#if defined(MK_EXTRA)
__global__ void __launch_bounds__(NTHR, 2) probe_k(Args args) {
    extern __shared__ __attribute__((aligned(16))) unsigned char lds[];
    Frame F; F.lds = (LAS unsigned char*)lds; F.tid = threadIdx.x; F.lane = F.tid & 63; F.wave = __builtin_amdgcn_readfirstlane(F.tid >> 6);
    F.G = gridDim.x; { const int bx = blockIdx.x; F.vcu = (F.G % 8 == 0) ? (bx % 8) * (F.G / 8) + bx / 8 : bx; }
    F.ctl = (gu32*)(args.ws + WS_CTL);
    if (MK_EXTRA == 11) nsa_prompt(F, args);
    if (MK_EXTRA == 12) gla_c(F, args);
    if (MK_EXTRA == 13) { gla_sample(F, args); nsa_sample(F, args); }
    if (MK_EXTRA == 14) cmp_post_sample(F, args);
    if (MK_EXTRA == 15) cmp_prompt(F, args);
    if (MK_EXTRA == 16) gla_a(F, args);
    if (MK_EXTRA == 17) make_vt(F, args);
    if (MK_EXTRA == 18) p0_prologue(F, args);
    if (MK_EXTRA == 19) p1_ln_mod(F, args);
    if (MK_EXTRA == 20) gla_scan(F, args);
    if (MK_EXTRA == 21) p_res_ln<0>(F, args, 0, R);
    if (MK_EXTRA == 22) p_res_ln<1>(F, args, 0, R);
}
#endif
__global__ void glue_z(const unsigned short* ZB, const float* narrow, float* Z) {
    const int r = blockIdx.x;
    for (int c = threadIdx.x; c < 2856; c += 256) { float v;
        if (c >= 1024 && c < 1040) v = narrow[(size_t)r * 64 + (c - 1024)];
        else if (c >= 2832) v = narrow[(size_t)r * 64 + 16 + (c - 2832)];
        else { const int pc = c < 1024 ? c : c - 16; v = __uint_as_float((unsigned)ZB[(size_t)r * ZN + pc] << 16); if (pc < 256 || (pc >= 1536 && pc < 2048)) v *= 8.f; }
        Z[(size_t)r * 2856 + c] = v; }
}
__global__ void glue_att(const float* ATT, unsigned short* ATTB) {
    const int r = RP + blockIdx.x; for (int c = 512 + threadIdx.x; c < 1024; c += 256) ATTB[(size_t)r * 1024 + c] = (unsigned short)f2bf(ATT[(size_t)r * 1024 + c]);
}
}
#ifndef MK_SPLIT
#define MK_SPLIT 0
#endif
static int g_grid = 0;
extern "C" void kernel_launch(void* const* d_in, const int* in_sizes, int n_in, void* d_out, int out_size, void* d_ws, size_t ws_size, hipStream_t stream) {
    (void)in_sizes; (void)n_in; (void)out_size; (void)ws_size;
    if (!g_grid) { int dev = 0, cus = 0; (void)hipGetDevice(&dev); (void)hipDeviceGetAttribute(&cus, hipDeviceAttributeMultiprocessorCount, dev);
        (void)hipFuncSetAttribute((const void*)fk::mega, hipFuncAttributeMaxDynamicSharedMemorySize, fk::LDS_BYTES); g_grid = cus > 0 ? cus : 256; }
    (void)hipMemsetAsync((char*)d_ws + fk::WS_CTL, 0, fk::CTL_ZERO_BYTES, stream);
    fk::Args a{}; for (int i = 0; i < 28; ++i) a.in[i] = d_in[i]; a.out = (float*)d_out; a.ws = (unsigned char*)d_ws;
#if MK_SPLIT
    for (int p = 0; p <= 10; ++p) { a.ph_lo = p; a.ph_hi = p + 1; a.li = 0; hipLaunchKernelGGL(fk::mega, dim3(g_grid), dim3(fk::NTHR), fk::LDS_BYTES, stream, a); }
#else
    a.ph_lo = 0; a.ph_hi = 11; a.li = 0; hipLaunchKernelGGL(fk::mega, dim3(g_grid), dim3(fk::NTHR), fk::LDS_BYTES, stream, a);
#endif
}
```

```cpp
#include <hip/hip_runtime.h>
#include <cstdio>
#include <cstdint>
#include <cmath>
namespace fc {
constexpr int D = 1024, RP = 16384, RS = 128, R = RP + RS, MP = 16640;
constexpr int ZN = 3072;
constexpr int PZ_QG = 0, PZ_KG = 256, PZ_VG = 512, PZ_RG = 1024, PZ_QN = 1536, PZ_KVC = 2048, PZ_KVS = 2304, PZ_KVW = 2560, PZ_AG = 2816, PZ_GN = 2832;
constexpr int DFF = 2816, F1N = 5632;
constexpr float ALPHA = 1.189207115002721f;
constexpr long O_YP = 0, O_YS = 16777216, O_GSP = 16908288, O_GSS = 17170432, O_CKP = 18219008, O_CKS = 22413312, O_SKP = 22446080, O_SKS = 26640384,
               O_WKP = 26673152, O_WKS = 27721728, O_END = 31916032;
}
namespace pg8 {
#define PG8_LAS __attribute__((address_space(3)))
typedef unsigned short bf16_t;
typedef short bf16x8 __attribute__((ext_vector_type(8)));
typedef float f32x4 __attribute__((ext_vector_type(4)));
typedef unsigned u32x4 __attribute__((ext_vector_type(4)));
constexpr int BM = 256, BK = 64, HALF = 128, HTB = HALF * BK * 2  , STAGE_BYTES = 8 * HTB, NXCD = 8, WGM = 8;

__host__ __device__ __forceinline__ int lds_byte(int r, int c) { const int st = (r >> 4) * 2 + (c >> 5), rr = r & 15, cc = c & 31, ob = rr * 64 + cc * 2; return st * 1024 + (ob ^ (((ob >> 9) & 1) << 5)); }
__host__ __device__ __forceinline__ void stage_rc(int b, int& R, int& C) { const int st = b / 1024, sb = b % 1024, swz = sb ^ (((sb >> 9) & 1) << 5); R = (st >> 1) * 16 + swz / 64; C = (st & 1) * 32 + (swz % 64) / 2; }
__host__ __device__ __forceinline__ int perm32(int rho) { const int n = rho >> 4, i = rho & 15; return 8 * (i >> 2) + 4 * n + (i & 3); }

struct Unit { int pm, pn; };
struct Gemm { const bf16_t* A; const bf16_t* Bt; int M, N, K; };

struct StaticOrder {
    int nM, nN, nwg, G, c;
    __host__ __device__ void init(int M, int N, int G_, int c_) { nM = M / BM; nN = N / BM; nwg = nM * nN; G = G_; c = c_; }
    __host__ __device__ bool next(int i, Unit& u) const {
        const long L = (long)i * G + c; if (L >= nwg) return false;
        int wgid = (int)L; { const int q = nwg / NXCD, r = nwg % NXCD, xcd = wgid % NXCD, off = wgid / NXCD; wgid = (xcd < r ? xcd * (q + 1) : r * (q + 1) + (xcd - r) * q) + off; }
        const int nig = WGM * nN, gid = wgid / nig, fm = gid * WGM, gsz = (nM - fm) < WGM ? (nM - fm) : WGM;
        u.pm = fm + ((wgid % nig) % gsz); u.pn = (wgid % nig) / gsz; return true;
    }
    __device__ __forceinline__ void a_ready(const Unit&) const {}
    __device__ __forceinline__ void done(const Unit&) const {}
};

__device__ __forceinline__ unsigned cvt_pk_bf16(float lo, float hi) { unsigned r; asm volatile("v_cvt_pk_bf16_f32 %0, %1, %2" : "=v"(r) : "v"(lo), "v"(hi)); return r; }
typedef float f32x2 __attribute__((ext_vector_type(2)));
__device__ __forceinline__ f32x2 gelu_pk(f32x2 v) {
    const f32x2 av = __builtin_elementwise_abs(v), d = av * 0.2316418882f + 1.0f;
    f32x2 t; t.x = __builtin_amdgcn_rcpf(d.x); t.y = __builtin_amdgcn_rcpf(d.y);
    f32x2 q = t * 0.5307027145f + (-0.7265760135f); q = q * t + 0.7107068705f; q = q * t + (-0.142248368f); q = q * t + 0.127414796f; q = q * t;
    const f32x2 s = (v * v) * (-0.72134752044f);
    f32x2 e; e.x = __builtin_amdgcn_exp2f(s.x); e.y = __builtin_amdgcn_exp2f(s.y);
    const f32x2 m = v * (q * e), r = v - m;
    f32x2 o; o.x = v.x < 0.f ? m.x : r.x; o.y = v.y < 0.f ? m.y : r.y; return o;
}

template <int ACT  > struct EpiBf16 {
    static constexpr bool PERM = true, AFTER_DRAIN = false; static_assert(ACT == 0 || ACT == 1, "EpiBf16: ACT is 0 (none) or 1 (gelu_pk)");
    bf16_t* O; int ldc; const float* bias; int split_cols; size_t split_stride; float scale0;
    __device__ __forceinline__ void operator()(const f32x4 (&acc)[2][2][4][2], const Unit& u, int wr, int wc, int fr, int fq) const {
        const int row0 = u.pm * BM + wr * 64 + fr; int colt = u.pn * BM; bf16_t* base = O;
        float sc = 1.f; if (split_cols) { const int t = colt / split_cols; base += (size_t)t * split_stride; colt -= t * split_cols; if (t == 0) sc = scale0; }
        const int col0 = colt + wc * 32 + 8 * fq, bcol0 = u.pn * BM + wc * 32 + 8 * fq;
        f32x4 bv[2][2];
#pragma unroll
        for (int bj = 0; bj < 2; ++bj)
#pragma unroll
            for (int n = 0; n < 2; ++n) bv[bj][n] = bias ? *(const f32x4*)(bias + bcol0 + bj * HALF + 4 * n) : (f32x4){0.f, 0.f, 0.f, 0.f};
#pragma unroll
        for (int ai = 0; ai < 2; ++ai)
#pragma unroll
            for (int m = 0; m < 4; ++m) { bf16_t* rowp = base + (size_t)(row0 + ai * HALF + m * 16) * ldc + col0;
#pragma unroll
                for (int bj = 0; bj < 2; ++bj) { f32x4 v0 = acc[ai][bj][m][0] + bv[bj][0], v1 = acc[ai][bj][m][1] + bv[bj][1];
                    if (ACT == 1) { f32x2 a = gelu_pk((f32x2){v0[0], v0[1]}), b = gelu_pk((f32x2){v0[2], v0[3]}), c = gelu_pk((f32x2){v1[0], v1[1]}), d = gelu_pk((f32x2){v1[2], v1[3]});
                        v0 = (f32x4){a.x, a.y, b.x, b.y}; v1 = (f32x4){c.x, c.y, d.x, d.y}; }
                    v0 = v0 * sc; v1 = v1 * sc; u32x4 w; w.x = cvt_pk_bf16(v0[0], v0[1]); w.y = cvt_pk_bf16(v0[2], v0[3]); w.z = cvt_pk_bf16(v1[0], v1[1]); w.w = cvt_pk_bf16(v1[2], v1[3]);
                    *(u32x4*)(rowp + bj * HALF) = w; } }
    }
};
struct EpiZ {
    static constexpr bool PERM = true, AFTER_DRAIN = false;
    bf16_t* ZB; float* out; float* narrow; bf16_t* pcmp;
    __device__ __forceinline__ void operator()(const f32x4 (&acc)[2][2][4][2], const Unit& u, int wr, int wc, int fr, int fq) const {
        const int pn = u.pn; const float sc = (pn == 0 || pn == 6 || pn == 7) ? 0.125f : 1.0f;
        const int row0 = u.pm * BM + wr * 64 + fr, cc0 = wc * 32 + 8 * fq;
        if (pn >= 12) {
            const int c = pn - 12; bf16_t* base = pcmp + (size_t)c * 65536 * 256 + ((size_t)(u.pm - 65 - 256 * c) * BM + wr * 64 + fr) * 256 + cc0;
#pragma unroll
            for (int ai = 0; ai < 2; ++ai)
#pragma unroll
                for (int m = 0; m < 4; ++m)
#pragma unroll
                    for (int bj = 0; bj < 2; ++bj) { const f32x4 v0 = acc[ai][bj][m][0], v1 = acc[ai][bj][m][1];
                        u32x4 w; w.x = cvt_pk_bf16(v0[0], v0[1]); w.y = cvt_pk_bf16(v0[2], v0[3]); w.z = cvt_pk_bf16(v1[0], v1[1]); w.w = cvt_pk_bf16(v1[2], v1[3]);
                        *(u32x4*)(base + (size_t)(ai * HALF + m * 16) * 256 + bj * HALF) = w; }
            return; }
#pragma unroll
        for (int ai = 0; ai < 2; ++ai)
#pragma unroll
            for (int m = 0; m < 4; ++m) { const int row = row0 + ai * HALF + m * 16; bf16_t* rowp = ZB + (size_t)row * fc::ZN + pn * BM + cc0;
                float* fdst = nullptr;
                if (pn >= 8 && pn <= 10 && row < fc::R) {
                    if (row < fc::RP) { const int b = row >> 11, t = row & 2047;
                        if (pn == 8) fdst = out + fc::O_CKP + (size_t)row * 256; else if (pn == 9) fdst = out + fc::O_SKP + (size_t)row * 256;
                        else if (t >= 1536) fdst = out + fc::O_WKP + ((size_t)b * 512 + (t - 1536)) * 256; }
                    else { const int rr = row - fc::RP;
                        if (pn == 8) fdst = out + fc::O_CKS + (size_t)rr * 256; else if (pn == 9) fdst = out + fc::O_SKS + (size_t)rr * 256;
                        else fdst = out + fc::O_WKS + ((size_t)(rr >> 2) * 512 + 508 + (rr & 3)) * 256; } }
#pragma unroll
                for (int bj = 0; bj < 2; ++bj) { const f32x4 v0 = acc[ai][bj][m][0] * sc, v1 = acc[ai][bj][m][1] * sc;
                    u32x4 w; w.x = cvt_pk_bf16(v0[0], v0[1]); w.y = cvt_pk_bf16(v0[2], v0[3]); w.z = cvt_pk_bf16(v1[0], v1[1]); w.w = cvt_pk_bf16(v1[2], v1[3]);
                    *(u32x4*)(rowp + bj * HALF) = w;
                    if (fdst) { *(f32x4*)(fdst + cc0 + bj * HALF) = v0; *(f32x4*)(fdst + cc0 + bj * HALF + 4) = v1; }
                    if (pn == 11 && bj == 0 && cc0 < 64) { *(f32x4*)(narrow + (size_t)row * 64 + cc0) = v0; *(f32x4*)(narrow + (size_t)row * 64 + cc0 + 4) = v1; } } }
    }
};
struct EpiF32 {
    static constexpr bool PERM = false, AFTER_DRAIN = false;
    float* O; int ldc;
    __device__ __forceinline__ void operator()(const f32x4 (&acc)[2][2][4][2], const Unit& u, int wr, int wc, int fr, int fq) const {
        const int row0 = u.pm * BM + wr * 64 + fr, col0 = u.pn * BM + wc * 32 + 4 * fq;
#pragma unroll
        for (int ai = 0; ai < 2; ++ai)
#pragma unroll
            for (int m = 0; m < 4; ++m) { float* rowp = O + (size_t)(row0 + ai * HALF + m * 16) * ldc + col0;
#pragma unroll
                for (int bj = 0; bj < 2; ++bj)
#pragma unroll
                    for (int n = 0; n < 2; ++n) *(f32x4*)(rowp + bj * HALF + n * 16) = acc[ai][bj][m][n]; }
    }
};
struct EpiSwiglu {
    static constexpr bool PERM = true, AFTER_DRAIN = false;
    bf16_t* HM;
    __device__ __forceinline__ void operator()(const f32x4 (&acc)[2][2][4][2], const Unit& u, int wr, int wc, int fr, int fq) const {
        const int row0 = u.pm * BM + wr * 64 + fr, col0 = u.pn * HALF + wc * 32 + 8 * fq;
#pragma unroll
        for (int ai = 0; ai < 2; ++ai)
#pragma unroll
            for (int m = 0; m < 4; ++m) { float o[8];
#pragma unroll
                for (int n = 0; n < 2; ++n)
#pragma unroll
                    for (int e = 0; e < 4; ++e) { const float g = acc[ai][0][m][n][e], up = acc[ai][1][m][n][e]; o[n * 4 + e] = g * __builtin_amdgcn_rcpf(1.0f + __builtin_amdgcn_exp2f(-1.4426950408889634f * g)) * up; }
                u32x4 w; w.x = cvt_pk_bf16(o[0], o[1]); w.y = cvt_pk_bf16(o[2], o[3]); w.z = cvt_pk_bf16(o[4], o[5]); w.w = cvt_pk_bf16(o[6], o[7]);
                *(u32x4*)(HM + (size_t)(row0 + ai * HALF + m * 16) * fc::DFF + col0) = w; }
    }
};
struct ComboOrder {
    StaticOrder so; int G, c;
    __device__ void init(int G_, int c_) { so.init(fc::RP, fc::ZN, G_, c_); G = G_; c = c_; }
    __device__ bool next(int i, Unit& u) const { const long L = (long)i * G + c; if (L < 768) return so.next(i, u); if (L >= 768 + 512) return false;
        const int j = (int)L - 768, cc = j >> 8, t = j & 255; u.pm = 65 + cc * 256 + t; u.pn = 12 + cc; return true; }
    __device__ __forceinline__ void a_ready(const Unit&) const {}
    __device__ __forceinline__ void done(const Unit&) const {}
};
template <class Epi, class Sched, bool ALIGN_EPI = false, bool SP2 = false>
__device__ __forceinline__ void gemm_phase(PG8_LAS unsigned char* lds, const Gemm g, const Sched& S, const Epi& E) {
    int tid_ = threadIdx.x; asm volatile("" : "+v"(tid_));
    const int tid = tid_, wid = __builtin_amdgcn_readfirstlane(tid >> 6), lane = tid & 63, wr = wid >> 2, wc = wid & 3, fr = lane & 15, fq = lane >> 4;
    const int K = g.K, nt = K / BK;
    unsigned voffA[2], voffB[2];
#pragma unroll
    for (int i = 0; i < 2; ++i) { int R, C; stage_rc(tid * 16 + i * 8192, R, C); const int Rb = Epi::PERM ? ((R & ~31) + perm32(R & 31)) : R;
        voffA[i] = (unsigned)(R * K + C) * 2u; voffB[i] = (unsigned)(Rb * K + C) * 2u; }
    const size_t kstep = (size_t)(BK * 2);
    const size_t hstep = (size_t)HALF * K * 2;
    const size_t tstep = 2 * hstep;
    const unsigned ldsw = (unsigned)wid * 1024u;
    const int aoff = lds_byte(wr * 64 + fr, fq * 8), boff = lds_byte(wc * 32 + fr, fq * 8);
#define PG8_SA(b, h) (((b) * 2 + (h)) * HTB)
#define PG8_SB(b, h) ((4 + (b) * 2 + (h)) * HTB)
#define PG8_STAGE(bufoff, gbase, voff) do { _Pragma("unroll") for (int _i = 0; _i < 2; ++_i) \
        __builtin_amdgcn_global_load_lds((const unsigned*)((const char*)(gbase) + (voff)[_i]), (PG8_LAS unsigned*)(lds + (bufoff) + ldsw + _i * 8192), 16, 0, 0); } while (0)
#define PG8_LDA(dst, b, h) do { _Pragma("unroll") for (int m = 0; m < 4; ++m) _Pragma("unroll") for (int k = 0; k < 2; ++k) dst[m][k] = *(const PG8_LAS bf16x8*)(lds + PG8_SA(b, h) + aoff + m * 2048 + k * 1024); } while (0)
#define PG8_LDB(dst, b, h) do { _Pragma("unroll") for (int n = 0; n < 2; ++n) _Pragma("unroll") for (int k = 0; k < 2; ++k) dst[n][k] = *(const PG8_LAS bf16x8*)(lds + PG8_SB(b, h) + boff + n * 2048 + k * 1024); } while (0)
#define PG8_MMA(ai, bj, At, Bt) do { __builtin_amdgcn_s_setprio(1); _Pragma("unroll") for (int m = 0; m < 4; ++m) _Pragma("unroll") for (int n = 0; n < 2; ++n) _Pragma("unroll") for (int k = 0; k < 2; ++k) \
        acc[ai][bj][m][n] = __builtin_amdgcn_mfma_f32_16x16x32_bf16(Bt[n][k], At[m][k], acc[ai][bj][m][n], 0, 0, 0); __builtin_amdgcn_s_setprio(0); } while (0)
#define PG8_WAIT_V(n) asm volatile("s_waitcnt vmcnt(" #n ")" ::: "memory")
#define PG8_WAIT_L(n) asm volatile("s_waitcnt lgkmcnt(" #n ")" ::: "memory")
#define PG8_BAR __builtin_amdgcn_s_barrier()
#define PG8_SCHED __builtin_amdgcn_sched_barrier(0)
    Unit cur, nxt; int ui = 0;
    if (!S.next(0, cur)) return;
    f32x4 acc[2][2][4][2];
#pragma unroll
    for (int a = 0; a < 2; ++a)
#pragma unroll
        for (int b = 0; b < 2; ++b)
#pragma unroll
            for (int m = 0; m < 4; ++m)
#pragma unroll
                for (int n = 0; n < 2; ++n) acc[a][b][m][n] = (f32x4){0.f, 0.f, 0.f, 0.f};
    bf16x8 At[4][2], B0[2][2], B1[2][2];
    const char* cA = (const char*)g.A + (size_t)cur.pm * tstep; const char* cB = (const char*)g.Bt + (size_t)cur.pn * tstep;
    S.a_ready(cur);
    if constexpr (SP2) {
        PG8_STAGE(PG8_SB(0, 0), cB, voffB); PG8_STAGE(PG8_SB(0, 1), cB + hstep, voffB); PG8_STAGE(PG8_SA(0, 0), cA, voffA); PG8_STAGE(PG8_SA(0, 1), cA + hstep, voffA);
        if (wr == 1) PG8_BAR;
        PG8_WAIT_V(2); PG8_BAR;
        PG8_STAGE(PG8_SB(1, 0), cB + kstep, voffB); PG8_STAGE(PG8_SA(1, 0), cA + kstep, voffA); PG8_STAGE(PG8_SB(1, 1), cB + hstep + kstep, voffB);
        PG8_WAIT_V(6); PG8_BAR;
    } else {
        PG8_STAGE(PG8_SB(0, 0), cB, voffB); PG8_STAGE(PG8_SA(0, 0), cA, voffA); PG8_STAGE(PG8_SB(0, 1), cB + hstep, voffB); PG8_STAGE(PG8_SA(0, 1), cA + hstep, voffA);
        if (wr == 1) PG8_BAR;
        PG8_WAIT_V(4); PG8_BAR;
        PG8_STAGE(PG8_SB(1, 0), cB + kstep, voffB); PG8_STAGE(PG8_SA(1, 0), cA + kstep, voffA); PG8_STAGE(PG8_SB(1, 1), cB + hstep + kstep, voffB);
        PG8_WAIT_V(6); PG8_BAR;
    }
    for (;;) {
        const bool has_next = S.next(ui + 1, nxt);
        const char* nA = has_next ? (const char*)g.A + (size_t)nxt.pm * tstep : cA; const char* nB = has_next ? (const char*)g.Bt + (size_t)nxt.pn * tstep : cB;
        for (int t = 0; t < nt; t += 2) {
            const bool last = (t == nt - 2);
            const char* a1 = cA + (size_t)(t + 1) * kstep;
            const char* a2 = last ? nA : cA + (size_t)(t + 2) * kstep; const char* b2 = last ? nB : cB + (size_t)(t + 2) * kstep;
            const char* a3 = a2 + kstep; const char* b3 = b2 + kstep;
            if (last && has_next) S.a_ready(nxt);
            if constexpr (SP2) {
            PG8_LDB(B0, 0, 0); PG8_LDB(B1, 0, 1); PG8_SCHED; PG8_LDA(At, 0, 0); PG8_STAGE(PG8_SA(1, 1), a1 + hstep, voffA);
            PG8_WAIT_V(8); PG8_WAIT_L(0); PG8_BAR; PG8_MMA(0, 0, At, B0); PG8_MMA(0, 1, At, B1); PG8_BAR; PG8_SCHED;
            PG8_LDA(At, 0, 1); PG8_STAGE(PG8_SB(0, 0), b2, voffB); PG8_STAGE(PG8_SB(0, 1), b2 + hstep, voffB); PG8_STAGE(PG8_SA(0, 0), a2, voffA);
            PG8_WAIT_V(8); PG8_WAIT_L(0); PG8_BAR; PG8_MMA(1, 0, At, B0); PG8_MMA(1, 1, At, B1); PG8_BAR; PG8_SCHED;
            PG8_LDB(B0, 1, 0); PG8_LDB(B1, 1, 1); PG8_SCHED; PG8_LDA(At, 1, 0); PG8_STAGE(PG8_SA(0, 1), a2 + hstep, voffA);
            PG8_WAIT_V(8); PG8_WAIT_L(0); PG8_BAR; PG8_MMA(0, 0, At, B0); PG8_MMA(0, 1, At, B1); PG8_BAR; PG8_SCHED;
            PG8_LDA(At, 1, 1); PG8_STAGE(PG8_SB(1, 0), b3, voffB); PG8_STAGE(PG8_SB(1, 1), b3 + hstep, voffB); PG8_STAGE(PG8_SA(1, 0), a3, voffA);
            PG8_WAIT_V(8); PG8_WAIT_L(0); PG8_BAR; PG8_MMA(1, 0, At, B0); PG8_MMA(1, 1, At, B1); PG8_BAR; PG8_SCHED;
            } else {
            PG8_LDB(B0, 0, 0); PG8_SCHED; PG8_LDA(At, 0, 0); PG8_STAGE(PG8_SA(1, 1), a1 + hstep, voffA);
            PG8_WAIT_L(8); PG8_BAR; PG8_WAIT_L(0); PG8_MMA(0, 0, At, B0); PG8_BAR; PG8_SCHED;
            PG8_LDB(B1, 0, 1); PG8_STAGE(PG8_SB(0, 0), b2, voffB);
            PG8_BAR; PG8_WAIT_L(0); PG8_MMA(0, 1, At, B1); PG8_BAR;
            PG8_LDA(At, 0, 1); PG8_STAGE(PG8_SA(0, 0), a2, voffA);
            PG8_BAR; PG8_WAIT_L(0); PG8_MMA(1, 0, At, B0); PG8_BAR; PG8_SCHED;
            PG8_STAGE(PG8_SB(0, 1), b2 + hstep, voffB);
            PG8_WAIT_V(6); PG8_BAR; PG8_MMA(1, 1, At, B1); PG8_BAR;
            PG8_LDB(B0, 1, 0); PG8_SCHED; PG8_LDA(At, 1, 0); PG8_STAGE(PG8_SA(0, 1), a2 + hstep, voffA);
            PG8_WAIT_L(8); PG8_BAR; PG8_WAIT_L(0); PG8_MMA(0, 0, At, B0); PG8_BAR; PG8_SCHED;
            PG8_LDB(B1, 1, 1); PG8_STAGE(PG8_SB(1, 0), b3, voffB);
            PG8_BAR; PG8_WAIT_L(0); PG8_MMA(0, 1, At, B1); PG8_BAR;
            PG8_LDA(At, 1, 1); PG8_STAGE(PG8_SA(1, 0), a3, voffA);
            PG8_BAR; PG8_WAIT_L(0); PG8_MMA(1, 0, At, B0); PG8_BAR; PG8_SCHED;
            PG8_STAGE(PG8_SB(1, 1), b3 + hstep, voffB);
            PG8_WAIT_V(6); PG8_BAR; PG8_MMA(1, 1, At, B1); PG8_BAR;
            }
        }
        if constexpr (ALIGN_EPI) { if (wr == 0) PG8_BAR; }
        if constexpr (!Epi::AFTER_DRAIN) { E(acc, cur, wr, wc, fr, fq); S.done(cur); }
        if (!has_next) break;
#pragma unroll
        for (int a = 0; a < 2; ++a)
#pragma unroll
            for (int b = 0; b < 2; ++b)
#pragma unroll
                for (int m = 0; m < 4; ++m)
#pragma unroll
                    for (int n = 0; n < 2; ++n) acc[a][b][m][n] = (f32x4){0.f, 0.f, 0.f, 0.f};
        cur = nxt; cA = nA; cB = nB; ++ui;
        if constexpr (ALIGN_EPI) { if (wr == 1) PG8_BAR; }
    }
    PG8_WAIT_V(0);
    if constexpr (!ALIGN_EPI) { if (wr == 0) PG8_BAR; }
    PG8_BAR;
    if constexpr (Epi::AFTER_DRAIN) { E.fused(acc, cur, wr, wc, fr, fq, lds, wid, lane); S.done(cur); }
#undef PG8_SA
#undef PG8_SB
#undef PG8_STAGE
#undef PG8_LDA
#undef PG8_LDB
#undef PG8_MMA
#undef PG8_WAIT_V
#undef PG8_WAIT_L
#undef PG8_BAR
#undef PG8_SCHED
}
}
#define GAS __attribute__((address_space(1)))
#define LAS __attribute__((address_space(3)))
typedef unsigned short bf16;
typedef unsigned v4u __attribute__((ext_vector_type(4)));
typedef float f32x4 __attribute__((ext_vector_type(4)));
typedef short bf16x8 __attribute__((ext_vector_type(8)));
typedef GAS unsigned gu32;
typedef GAS unsigned long long gu64;
#define RLX_AGENT __ATOMIC_RELAXED, __HIP_MEMORY_SCOPE_AGENT
#define LDS_WAIT() asm volatile("s_waitcnt lgkmcnt(0)" ::: "memory")
#define VM_WAIT() asm volatile("s_waitcnt vmcnt(0)" ::: "memory")
__device__ __forceinline__ unsigned long long rt() { return __builtin_amdgcn_s_memrealtime(); }
__device__ __forceinline__ unsigned f2bf(float f) { unsigned u = __builtin_bit_cast(unsigned, f); return (u + 0x7fffu + ((u >> 16) & 1u)) >> 16; }
__device__ __forceinline__ unsigned pk2(float lo, float hi) { return f2bf(lo) | (f2bf(hi) << 16); }
#define XB_TMO      128
#define XB_XCNT(j)  (256  + 64 * (j))
#define XB_XSUB(j)  (1280 + 64 * (j))
#define XB_XGEN(j)  (2304 + 64 * (j))
#define XB_TOP      3328
#define XB_TOPGEN   3392
#define XCD_BAR_WORDS 3456
#define XB_SPIN_CAP (1u << 18)

__device__ __forceinline__ unsigned xb_ld(unsigned* p)              { return __hip_atomic_load(p, __ATOMIC_RELAXED, __HIP_MEMORY_SCOPE_AGENT); }
__device__ __forceinline__ unsigned xb_add(unsigned* p, unsigned v) { return __hip_atomic_fetch_add(p, v, __ATOMIC_RELAXED, __HIP_MEMORY_SCOPE_AGENT); }
__device__ __forceinline__ unsigned xb_xcc_id() { return (unsigned)__builtin_amdgcn_s_getreg((3 << 11) | 20) & 0xFu; }
#define XB_SPIN(cond, bar) do { unsigned _sp = 0; while (cond) { __builtin_amdgcn_s_sleep(1); \
    if ((++_sp & 255u) == 0u) { if (xb_ld(&(bar)[XB_TMO])) break; if (_sp > XB_SPIN_CAP) { atomicAdd(&(bar)[XB_TMO], 1u); break; } } } } while (0)

struct XcdBarrier {
    unsigned* bar; unsigned x;
    volatile LAS unsigned* st;
};

__device__ __forceinline__ XcdBarrier xcd_barrier_post(unsigned* bar, volatile LAS unsigned* st) {
    XcdBarrier b; b.bar = bar; b.x = xb_xcc_id(); b.st = st;
    if (threadIdx.x == 0) (void)xb_add(&bar[XB_XCNT(b.x)], 1u);
    return b;
}
__device__ __forceinline__ void xcd_barrier_complete(unsigned* bar, unsigned x, unsigned& nloc, unsigned& nx) {
    const unsigned G = gridDim.x * gridDim.y * gridDim.z;
    unsigned sum, cnt, mine, sp = 0u;
    for (;;) {
        sum = 0u; cnt = 0u; mine = 0u;
#pragma unroll
        for (unsigned j = 0; j < 16; ++j) { const unsigned c = xb_ld(&bar[XB_XCNT(j)]); sum += c; cnt += (c > 0u) ? 1u : 0u; mine = (j == x) ? c : mine; }
        if (sum == G) break;
        __builtin_amdgcn_s_sleep(1);
        if ((++sp & 255u) == 0u) { if (xb_ld(&bar[XB_TMO])) break; if (sp > XB_SPIN_CAP) { atomicAdd(&bar[XB_TMO], 1u); break; } }
    }
    nloc = mine > 0u ? mine : 1u; nx = cnt > 0u ? cnt : 1u;
}

__device__ __forceinline__ void xcd_barrier(const XcdBarrier& b) {
    asm volatile("s_waitcnt vmcnt(0)" ::: "memory");
    __syncthreads();
    if (threadIdx.x == 0) {
        unsigned* bar = b.bar;
        __builtin_amdgcn_s_waitcnt(0);
        unsigned nloc = b.st[0], nx = b.st[1];
        if (nloc == 0u) { xcd_barrier_complete(bar, b.x, nloc, nx); b.st[0] = nloc; b.st[1] = nx; }
        const unsigned old = xb_add(&bar[XB_XSUB(b.x)], 1u);
        const unsigned gen = old / nloc;
        if (old + 1u == (gen + 1u) * nloc) {
            __builtin_amdgcn_fence(__ATOMIC_RELEASE, "agent");
            asm volatile("s_waitcnt vmcnt(0)" ::: "memory");
            const unsigned og = xb_add(&bar[XB_TOP], 1u);
            const unsigned tg = og / nx;
            if (og + 1u == (tg + 1u) * nx) xb_add(&bar[XB_TOPGEN], 1u);
            else XB_SPIN(xb_ld(&bar[XB_TOPGEN]) == tg, bar);
            __builtin_amdgcn_fence(__ATOMIC_ACQUIRE, "agent");
            xb_add(&bar[XB_XGEN(b.x)], 1u);
            asm volatile("s_waitcnt vmcnt(0)" ::: "memory");
        } else {
            XB_SPIN(xb_ld(&bar[XB_XGEN(b.x)]) == gen, bar);
            __builtin_amdgcn_fence(__ATOMIC_ACQUIRE, "agent");
            asm volatile("s_waitcnt vmcnt(0)" ::: "memory");
        }
    }
    __syncthreads();
}
namespace fk {
using namespace fc;
constexpr int NWAVES = 8, NTHR = 512;
constexpr size_t MiB = 1u << 20;
constexpr size_t WS_CTL = 0, CTL_ZERO_BYTES = 1 * MiB;
constexpr int CW_BAR = 4096;
constexpr size_t FB = 1536 * MiB;
constexpr size_t WS_WT_IN = FB + 0 * MiB;
constexpr size_t WS_W1R = FB + 6 * MiB;
constexpr size_t WS_WT_O = FB + 8 * MiB;
constexpr size_t WS_WT_F1 = FB + 10 * MiB;
constexpr size_t WS_WT_F2 = FB + 21 * MiB;
constexpr size_t WS_MODP = FB + 27 * MiB;
constexpr size_t WS_MODF = FB + 35 * MiB;
constexpr size_t WS_STATS = FB + 36 * MiB;
constexpr size_t WS_CBIAS = FB + 36 * MiB + 512 * 1024;
constexpr size_t WS_W2T = FB + 36 * MiB + 768 * 1024;
constexpr size_t WS_NARROW = FB + 37 * MiB;
constexpr size_t WS_U = FB + 42 * MiB;
constexpr size_t WS_ACMP = WS_U + (size_t)MP * 1024 * 2;
constexpr size_t WS_ZB = FB + 331 * MiB;
constexpr size_t WS_PCMP = FB + 429 * MiB;
constexpr size_t WS_KCVP = FB + 493 * MiB;
constexpr size_t WS_KCVS = FB + 494 * MiB;
constexpr size_t WS_KC = FB + 41 * MiB + 256 * 1024;
constexpr size_t WS_VTC = FB + 41 * MiB + 512 * 1024;
constexpr size_t WS_GLAS = FB + 526 * MiB;
constexpr size_t WS_GLAD = FB + 558 * MiB;
constexpr size_t WS_ATT = FB + 559 * MiB;
constexpr size_t WS_H1 = FB + 592 * MiB;
constexpr size_t WS_X1 = FB + 657 * MiB;
constexpr size_t WS_HM = FB + 722 * MiB;
constexpr size_t WS_VTS = FB + 812 * MiB;
constexpr size_t WS_VTW = FB + 816 * MiB;
constexpr size_t WS_END = FB + 820 * MiB;
constexpr int RING_OFF = 0, RING_BYTES = 131072, LDSCTL_OFF = RING_BYTES, MISC_OFF = LDSCTL_OFF + 320, LDS_BYTES = 147456;


struct Args { const void* in[28]; float* out; unsigned char* ws; int ph_lo, ph_hi, li, pad; };
struct Frame { LAS unsigned char* lds; gu32* ctl; int tid, lane, wave, vcu, G; };

template <int X> __device__ __forceinline__ float xor_f(float v) {
    if constexpr (X == 32) { auto rr = __builtin_amdgcn_permlane32_swap(__float_as_uint(v), __float_as_uint(v), false, false); const unsigned me = __float_as_uint(v); return __uint_as_float(rr[0] == me ? rr[1] : rr[0]); }
    else return __int_as_float(__builtin_amdgcn_ds_swizzle(__float_as_int(v), (X << 10) | 0x1f));
}
__device__ __forceinline__ float swap32_sum(float v) { auto rr = __builtin_amdgcn_permlane32_swap(__float_as_uint(v), __float_as_uint(v), false, false); return __uint_as_float(rr[0]) + __uint_as_float(rr[1]); }
__device__ __forceinline__ float swap32_max(float v) { auto rr = __builtin_amdgcn_permlane32_swap(__float_as_uint(v), __float_as_uint(v), false, false); return fmaxf(__uint_as_float(rr[0]), __uint_as_float(rr[1])); }
__device__ __forceinline__ float wave_sum(float v) { v += xor_f<1>(v); v += xor_f<2>(v); v += xor_f<4>(v); v += xor_f<8>(v); v += xor_f<16>(v); return swap32_sum(v); }
__device__ __forceinline__ float wave_max(float v) { v = fmaxf(v, xor_f<1>(v)); v = fmaxf(v, xor_f<2>(v)); v = fmaxf(v, xor_f<4>(v)); v = fmaxf(v, xor_f<8>(v)); v = fmaxf(v, xor_f<16>(v)); return swap32_max(v); }
__device__ __forceinline__ Frame launder(const Frame& F0) { Frame F = F0; int t = F0.tid; asm volatile("" : "+v"(t)); F.tid = t; F.lane = t & 63; F.wave = __builtin_amdgcn_readfirstlane(t >> 6); return F; }
__device__ __forceinline__ float silu_f(float x) { return x / (1.f + __expf(-x)); }
__device__ __forceinline__ int mod_row(int r) { return r < RP ? (r >> 11) : 8 + ((r - RP) >> 2); }

template <class SrcCol> __device__ __forceinline__ void transpose_item(const float* W, int K, int N, bf16* WT, int n0, int k0, LAS float* scr, int lane, SrcCol src) {
    const int sc = src(n0 + (lane & 31));
#pragma unroll 8
    for (int i = 0; i < 32; ++i) { const int kk = 2 * i + (lane >> 5); scr[kk * 33 + (lane & 31)] = sc >= 0 ? W[(size_t)(k0 + kk) * N + sc] : 0.f; }
    LDS_WAIT(); asm volatile("" ::: "memory");
    const int c = lane & 7;
#pragma unroll
    for (int j = 0; j < 4; ++j) { const int n = (lane >> 3) + 8 * j; const LAS float* s = scr + (8 * c) * 33 + n;
        v4u o; o.x = pk2(s[0 * 33], s[1 * 33]); o.y = pk2(s[2 * 33], s[3 * 33]); o.z = pk2(s[4 * 33], s[5 * 33]); o.w = pk2(s[6 * 33], s[7 * 33]);
        *(GAS v4u*)(WT + (size_t)(n0 + n) * K + k0 + 8 * c) = o; }
    LDS_WAIT(); asm volatile("" ::: "memory");
}
__device__ __forceinline__ int src_win(int n) { return n < 1024 ? n : (n < 2816 ? n + 16 : (n < 2832 ? 1024 + (n - 2816) : (n < 2856 ? n : -1))); }
__device__ __forceinline__ int src_f1(int n) { return ((n >> 7) & 1) * DFF + (n >> 8) * 128 + (n & 127); }

__device__ __forceinline__ void p0_prologue(Frame& F0, const Args& a) { Frame F = launder(F0);
    const float* w_in = (const float*)a.in[13]; const float* w_o = (const float*)a.in[21]; const float* w_f1 = (const float*)a.in[24]; const float* w_f2 = (const float*)a.in[25];
    const float* w1 = (const float*)a.in[18]; const float* b1 = (const float*)a.in[19]; const float* pe = (const float*)a.in[17];
    unsigned char* ws = a.ws;
    {
        LAS float* sl = (LAS float*)(F.lds + RING_OFF);
        const float* cp = (const float*)a.in[7]; const float* cs = (const float*)a.in[8]; const float* w_ada = (const float*)a.in[11];
        float* modp = (float*)(ws + WS_MODP);
        for (int j = blockIdx.x; j < 256; j += F.G) { const int cg = j & 31, kg = j >> 5;
            for (int i = F.tid; i < 40 * 128; i += NTHR) { const int r = i >> 7, k = i & 127; const float c = r < 8 ? cp[r * D + kg * 128 + k] : cs[(r - 8) * D + kg * 128 + k]; sl[i] = silu_f(c); }
            __syncthreads();
            float acc[40];
#pragma unroll
            for (int r = 0; r < 40; ++r) acc[r] = 0.f;
            const int col = F.tid % 192, kh = F.tid / 192;
            if (F.tid < 384) { const float* wp = w_ada + (size_t)(kg * 128 + kh * 64) * 6144 + cg * 192 + col;
                for (int k = 0; k < 64; k += 4) { const float w0 = wp[(size_t)k * 6144], w1 = wp[(size_t)(k + 1) * 6144], w2 = wp[(size_t)(k + 2) * 6144], w3 = wp[(size_t)(k + 3) * 6144];
#pragma unroll
                    for (int r = 0; r < 40; ++r) { const f32x4 s4 = *(const LAS f32x4*)(sl + r * 128 + kh * 64 + k); acc[r] += (s4.x * w0 + s4.y * w1) + (s4.z * w2 + s4.w * w3); } } }
            __syncthreads();
            LAS float* cb = sl + 40 * 128;
            if (F.tid >= 192 && F.tid < 384) {
#pragma unroll
                for (int r = 0; r < 40; ++r) cb[r * 192 + col] = acc[r]; }
            __syncthreads();
            if (F.tid < 192) {
#pragma unroll
                for (int r = 0; r < 40; ++r) modp[((size_t)kg * 40 + r) * 6144 + cg * 192 + col] = acc[r] + cb[r * 192 + col]; }
            __syncthreads();
        }
    }
    LAS float* scr = (LAS float*)(F.lds + RING_OFF + F.wave * 16384);
    const int gw = F.vcu * NWAVES + F.wave, NGW = F.G * NWAVES;
    constexpr int I_IN = 16 * 96, I_O = 16 * 32, I_F1 = 16 * 176, I_F2 = 44 * 32, I_W1 = 4 * 16 * 4;
    constexpr int NITEMS = I_IN + I_O + I_F1 + I_F2 + I_W1;
    for (int it = gw; it < NITEMS; it += NGW) { int r = it;
        if (r < I_IN) { transpose_item(w_in, 1024, 2856, (bf16*)(ws + WS_WT_IN), (r % 96) * 32, (r / 96) * 64, scr, F.lane, [](int n) { return src_win(n); }); continue; } r -= I_IN;
        if (r < I_O) { transpose_item(w_o, 1024, 1024, (bf16*)(ws + WS_WT_O), (r % 32) * 32, (r / 32) * 64, scr, F.lane, [](int n) { return n; }); continue; } r -= I_O;
        if (r < I_F1) { transpose_item(w_f1, 1024, F1N, (bf16*)(ws + WS_WT_F1), (r % 176) * 32, (r / 176) * 64, scr, F.lane, [](int n) { return src_f1(n); }); continue; } r -= I_F1;
        if (r < I_F2) { transpose_item(w_f2, DFF, 1024, (bf16*)(ws + WS_WT_F2), (r % 32) * 32, (r / 32) * 64, scr, F.lane, [](int n) { return n; }); continue; } r -= I_F2;
        { const int cm = r >> 6, q = r & 63;
          transpose_item(w1 + (size_t)cm * 1024 * 128, 1024, 128, (bf16*)(ws + WS_W1R) + (size_t)cm * 128 * 1024, (q % 4) * 32, (q / 4) * 64, scr, F.lane, [](int n) { return n; }); }
    }
    { float* cbias = (float*)(ws + WS_CBIAS);
      for (int o = gw; o < 256; o += NGW) { const int c = o >> 7, hid = o & 127; float s = 0.f;
          for (int k = F.lane; k < 2048; k += 64) s += pe[((k >> 6) * 2 + c) * 64 + (k & 63)] * w1[((size_t)c * 2048 + k) * 128 + hid];
          s = wave_sum(s); if (F.lane == 0) cbias[o] = s + b1[o]; } }
    { const float* w2 = (const float*)a.in[20]; bf16* w2t = (bf16*)(ws + WS_W2T);
      for (int i = gw * 64 + F.lane; i < 16384; i += NGW * 64) { const int c = i >> 13, d = (i >> 7) & 63, hid = i & 127; w2t[i] = (bf16)f2bf(w2[((size_t)c * 128 + hid) * 64 + d]); } }
    { const float* cw = (const float*)a.in[5]; float* ow = a.out + O_WKS;
      for (int it0 = gw; it0 < 32 * 508; it0 += 8 * NGW) { f32x4 v[8];
#pragma unroll
          for (int u = 0; u < 8; ++u) { const int it = it0 + u * NGW; v[u] = (f32x4){0.f, 0.f, 0.f, 0.f}; if (it < 32 * 508) { const int b = it / 508, j = it % 508; v[u] = *(const GAS f32x4*)(cw + ((size_t)b * 512 + j + 4) * 256 + F.lane * 4); } }
#pragma unroll
          for (int u = 0; u < 8; ++u) { const int it = it0 + u * NGW; if (it < 32 * 508) { const int b = it / 508, j = it % 508; *(GAS f32x4*)(ow + ((size_t)b * 512 + j) * 256 + F.lane * 4) = v[u]; } } } }
}
__device__ __forceinline__ void p1_ln_mod(Frame& F0, const Args& a) { Frame F = launder(F0);
    unsigned char* ws = a.ws; const float* modp = (const float*)(ws + WS_MODP); const float* b_ada = (const float*)a.in[12];
    const float* ln_g = (const float*)a.in[9]; const float* ln_b = (const float*)a.in[10];
    const int gw = F.vcu * NWAVES + F.wave, NGW = F.G * NWAVES;
    { float* modf = (float*)(ws + WS_MODF);
      for (int i = blockIdx.x * NTHR + F.tid; i < 40 * 6144; i += F.G * NTHR) { float s = b_ada[i % 6144];
#pragma unroll
          for (int kg = 0; kg < 8; ++kg) s += modp[(size_t)kg * 40 * 6144 + i];
          modf[i] = s; } }
    bf16* U = (bf16*)(ws + WS_U); float* stats = (float*)(ws + WS_STATS);
    LAS float* msc = (LAS float*)(F.lds + RING_OFF); LAS float* msh = msc + 1024;
    auto do_row = [&](int r, auto loadmod) {
        const float* xrow = r < RP ? (const float*)a.in[0] + (size_t)r * D : (const float*)a.in[1] + (size_t)(r - RP) * D;
        const GAS f32x4* xr = (const GAS f32x4*)xrow + F.lane; f32x4 v[4]; float s_ = 0.f;
#pragma unroll
        for (int j = 0; j < 4; ++j) { v[j] = xr[64 * j]; s_ += (v[j].x + v[j].y) + (v[j].z + v[j].w); }
        const float mean = wave_sum(s_) * (1.f / D); float s2 = 0.f;
#pragma unroll
        for (int j = 0; j < 4; ++j) { v[j] = v[j] - mean; s2 += (v[j].x * v[j].x + v[j].y * v[j].y) + (v[j].z * v[j].z + v[j].w * v[j].w); }
        const float rstd = 1.f / sqrtf(wave_sum(s2) * (1.f / D) + 1e-5f);
        if (F.lane == 0) { stats[2 * r] = mean; stats[2 * r + 1] = rstd; }
        GAS unsigned long long* o8 = (GAS unsigned long long*)(U + (size_t)r * D) + F.lane;
#pragma unroll
        for (int j = 0; j < 4; ++j) { const int c = 256 * j + 4 * F.lane; f32x4 sh, sc; loadmod(c, sc, sh);
            const f32x4 g = *(const f32x4*)(ln_g + c), bb = *(const f32x4*)(ln_b + c); const f32x4 y = (v[j] * rstd * g + bb) * sc + sh;
            o8[64 * j] = (unsigned long long)pk2(y.x, y.y) | ((unsigned long long)pk2(y.z, y.w) << 32); } };
    for (int chunk = blockIdx.x; chunk < 256; chunk += F.G) { const int mr = chunk >> 5;
        for (int c = F.tid; c < 1024; c += NTHR) { float sh = b_ada[c], sc = b_ada[1024 + c] + 1.f;
#pragma unroll
            for (int kg = 0; kg < 8; ++kg) { sh += modp[((size_t)kg * 40 + mr) * 6144 + c]; sc += modp[((size_t)kg * 40 + mr) * 6144 + 1024 + c]; }
            msc[c] = sc; msh[c] = sh; }
        __syncthreads();
        for (int i = 0; i < 8; ++i) do_row(chunk * 64 + F.wave * 8 + i, [&](int c, f32x4& sc, f32x4& sh) { sc = *(const LAS f32x4*)(msc + c); sh = *(const LAS f32x4*)(msh + c); });
        __syncthreads();
    }
    for (int sr = gw; sr < RS; sr += NGW) { const int mr = 8 + (sr >> 2);
        do_row(RP + sr, [&](int c, f32x4& sc, f32x4& sh) { sh = *(const f32x4*)(b_ada + c); sc = *(const f32x4*)(b_ada + 1024 + c) + 1.f;
#pragma unroll
            for (int kg = 0; kg < 8; ++kg) { sh += *(const f32x4*)(modp + ((size_t)kg * 40 + mr) * 6144 + c); sc += *(const f32x4*)(modp + ((size_t)kg * 40 + mr) * 6144 + 1024 + c); } }); }
}

template <int WHICH> __device__ __forceinline__ void p_res_ln(Frame& F0, const Args& a, int r_lo, int r_hi) { Frame F = launder(F0);
    unsigned char* ws = a.ws; const float* modf = (const float*)(ws + WS_MODF); const float* stats = (const float*)(ws + WS_STATS);
    const float* mixb = (const float*)(ws + WS_H1); float* X1 = (float*)(ws + WS_X1); bf16* U = (bf16*)(ws + WS_U);
    const float* ln_g = (const float*)a.in[9]; const float* ln_b = (const float*)a.in[10];
    const float* lg = (const float*)a.in[WHICH == 0 ? 22 : 26]; const float* lb = (const float*)a.in[WHICH == 0 ? 23 : 27];
    const int gw = F.vcu * NWAVES + F.wave, NGW = F.G * NWAVES;
    for (int r = r_lo + gw; r < r_hi; r += NGW) {
        const int mr = mod_row(r); const float* mrow = modf + (size_t)mr * 6144;
        f32x4 v[4]; float s = 0.f;
        if (WHICH == 0) { const float* xrow = r < RP ? (const float*)a.in[0] + (size_t)r * D : (const float*)a.in[1] + (size_t)(r - RP) * D;
            const float mean = stats[2 * r], rstd = stats[2 * r + 1];
#pragma unroll
            for (int j = 0; j < 4; ++j) { const int c = 256 * j + 4 * F.lane; const f32x4 x = *(const GAS f32x4*)(xrow + c), m = *(const GAS f32x4*)(mixb + (size_t)r * D + c);
                const f32x4 xp = (x - mean) * rstd * *(const f32x4*)(ln_g + c) + *(const f32x4*)(ln_b + c);
                v[j] = xp * ALPHA + *(const f32x4*)(mrow + 2048 + c) * m; s += (v[j].x + v[j].y) + (v[j].z + v[j].w); } }
        else {
#pragma unroll
            for (int j = 0; j < 4; ++j) { const int c = 256 * j + 4 * F.lane; const f32x4 x1 = *(const GAS f32x4*)(X1 + (size_t)r * D + c), m = *(const GAS f32x4*)(mixb + (size_t)r * D + c);
                v[j] = x1 * ALPHA + *(const f32x4*)(mrow + 5120 + c) * m; s += (v[j].x + v[j].y) + (v[j].z + v[j].w); } }
        const float mean2 = wave_sum(s) * (1.f / D); float s2 = 0.f;
#pragma unroll
        for (int j = 0; j < 4; ++j) { v[j] = v[j] - mean2; s2 += (v[j].x * v[j].x + v[j].y * v[j].y) + (v[j].z * v[j].z + v[j].w * v[j].w); }
        const float rstd2 = 1.f / sqrtf(wave_sum(s2) * (1.f / D) + 1e-5f);
#pragma unroll
        for (int j = 0; j < 4; ++j) { const int c = 256 * j + 4 * F.lane; const f32x4 y = v[j] * rstd2 * *(const f32x4*)(lg + c) + *(const f32x4*)(lb + c);
            if (WHICH == 0) { *(GAS f32x4*)(X1 + (size_t)r * D + c) = y;
                const f32x4 u = y * (*(const f32x4*)(mrow + 4096 + c) + 1.f) + *(const f32x4*)(mrow + 3072 + c);
                *(GAS unsigned long long*)(U + (size_t)r * D + c) = (unsigned long long)pk2(u.x, u.y) | ((unsigned long long)pk2(u.z, u.w) << 32); }
            else { float* o = r < RP ? a.out + O_YP + (size_t)r * D : a.out + O_YS + (size_t)(r - RP) * D; *(GAS f32x4*)(o + c) = y; } }
    }
}


typedef float f32x4_ __attribute__((ext_vector_type(4)));
__device__ __forceinline__ float bf2f(unsigned short h) { return __uint_as_float((unsigned)h << 16); }
__device__ __forceinline__ float gelu_tanh(float x) { const float u = 0.7978845608028654f * (x + 0.044715f * x * x * x); const float e = __expf(2.f * u); return x * (1.f - 1.f / (e + 1.f)); }
__device__ __forceinline__ void cmp_post_sample(Frame& F0, const Args& a) { Frame F = launder(F0);
    unsigned char* ws = a.ws; const bf16* P = (const bf16*)(ws + WS_PCMP); const bf16* w2t = (const bf16*)(ws + WS_W2T); const float* cbias = (const float*)(ws + WS_CBIAS);
    float* kcvs = (float*)(ws + WS_KCVS);
    const int gw = F.vcu * NWAVES + F.wave, NGW = F.G * NWAVES, lr = F.lane & 15, quad = F.lane >> 4;
    for (int c = 0; c < 2; ++c) { bf16x8 wf[4][4];
#pragma unroll
      for (int nt = 0; nt < 4; ++nt)
#pragma unroll
        for (int ks = 0; ks < 4; ++ks) wf[nt][ks] = *(const bf16x8*)(w2t + ((size_t)c * 64 + 16 * nt + lr) * 128 + 32 * ks + 8 * quad);
      f32x4 cb[4][2];
#pragma unroll
      for (int ks = 0; ks < 4; ++ks) { cb[ks][0] = *(const f32x4*)(cbias + c * 128 + 32 * ks + 8 * quad); cb[ks][1] = *(const f32x4*)(cbias + c * 128 + 32 * ks + 8 * quad + 4); }
      for (int tt = gw; tt < 4092; tt += NGW) {
        const int rho = tt * 16 + lr; const bool valid = rho < 65472; const int rc = valid ? rho : 65471;
        const int b = rc / 2046, rem = rc % 2046, n = rem >> 1, g = rem & 1;
        const bf16* p0 = P + (size_t)c * 65536 * 256 + ((size_t)(b * 1024 + n) * 2 + g) * 256; const bf16* p1 = p0 + 2 * 256 + 128;
        bf16x8 x0[4], x1[4];
#pragma unroll
        for (int ks = 0; ks < 4; ++ks) { x0[ks] = *(const bf16x8*)(p0 + 32 * ks + 8 * quad); x1[ks] = *(const bf16x8*)(p1 + 32 * ks + 8 * quad); }
        bf16x8 hf[4];
#pragma unroll
        for (int ks = 0; ks < 4; ++ks) { float h[8];
#pragma unroll
            for (int e = 0; e < 8; ++e) h[e] = gelu_tanh(bf2f((unsigned short)x0[ks][e]) + bf2f((unsigned short)x1[ks][e]) + (e < 4 ? cb[ks][0][e] : cb[ks][1][e - 4]));
            v4u w; w.x = pk2(h[0], h[1]); w.y = pk2(h[2], h[3]); w.z = pk2(h[4], h[5]); w.w = pk2(h[6], h[7]); hf[ks] = __builtin_bit_cast(bf16x8, w); }
#pragma unroll
        for (int nt = 0; nt < 4; ++nt) { f32x4 acc = {0.f, 0.f, 0.f, 0.f};
#pragma unroll
            for (int ks = 0; ks < 4; ++ks) acc = __builtin_amdgcn_mfma_f32_16x16x32_bf16(wf[nt][ks], hf[ks], acc, 0, 0, 0);
            if (valid) *(GAS f32x4*)(kcvs + (((size_t)b * 1023 + n) * 2 + c) * 128 + g * 64 + 16 * nt + 4 * quad) = acc; }
      } }
}
__device__ __forceinline__ void cmp_prompt(Frame& F0, const Args& a) { Frame F = launder(F0);
    unsigned char* ws = a.ws; const bf16* ZB = (const bf16*)(ws + WS_ZB); const bf16* w1r = (const bf16*)(ws + WS_W1R); const bf16* w2t = (const bf16*)(ws + WS_W2T);
    const float* cbias = (const float*)(ws + WS_CBIAS); float* kcvp = (float*)(ws + WS_KCVP);
    LAS float* red = (LAS float*)(F.lds + RING_OFF);
    LAS bf16* H = (LAS bf16*)(F.lds + RING_OFF + 65536);
    const int lr = F.lane & 15, quad = F.lane >> 4;
    for (int unit = blockIdx.x; unit < 2 * 127; unit += F.G) { const int c = unit / 127, tt = unit % 127;
        const int rho = tt * 16 + lr; const int b = rho / 254, rem = rho % 254, n = rem >> 1, g = rem & 1;
        const bf16* arow = ZB + ((size_t)b * 2048 + 16 * n) * ZN + PZ_KVC + c * 128 + g * 64;
        f32x4 acc[8];
#pragma unroll
        for (int nt = 0; nt < 8; ++nt) acc[nt] = (f32x4){0.f, 0.f, 0.f, 0.f};
#pragma unroll 2
        for (int ks = 0; ks < 8; ++ks) { const int k = F.wave * 256 + ks * 32 + quad * 8;
            const bf16x8 af = *(const bf16x8*)(arow + (size_t)(k >> 6) * ZN + (k & 63));
            const bf16* wb = w1r + ((size_t)c * 256 + (k >> 10) * 128 + lr) * 1024 + (k & 1023);
#pragma unroll
            for (int nt = 0; nt < 8; ++nt) { const bf16x8 bf = *(const bf16x8*)(wb + (size_t)nt * 16 * 1024); acc[nt] = __builtin_amdgcn_mfma_f32_16x16x32_bf16(af, bf, acc[nt], 0, 0, 0); } }
#pragma unroll
        for (int nt = 0; nt < 8; ++nt)
#pragma unroll
            for (int e = 0; e < 4; ++e) red[(F.wave * 16 + 4 * quad + e) * 128 + 16 * nt + lr] = acc[nt][e];
        __syncthreads();
        { const int row = F.tid >> 5, h4 = (F.tid & 31) * 4; f32x4 s = *(const f32x4*)(cbias + c * 128 + h4);
#pragma unroll
          for (int w = 0; w < 8; ++w) s += *(const LAS f32x4*)(red + (w * 16 + row) * 128 + h4);
          *(LAS unsigned long long*)(H + row * 136 + h4) = (unsigned long long)pk2(gelu_tanh(s.x), gelu_tanh(s.y)) | ((unsigned long long)pk2(gelu_tanh(s.z), gelu_tanh(s.w)) << 32); }
        __syncthreads();
        if (F.wave < 4) { const int nt = F.wave; f32x4 o = {0.f, 0.f, 0.f, 0.f};
#pragma unroll
            for (int ks = 0; ks < 4; ++ks) { const bf16x8 wf = *(const bf16x8*)(w2t + ((size_t)c * 64 + 16 * nt + lr) * 128 + 32 * ks + 8 * quad);
                const bf16x8 hf = *(const LAS bf16x8*)(H + lr * 136 + 32 * ks + 8 * quad);
                o = __builtin_amdgcn_mfma_f32_16x16x32_bf16(wf, hf, o, 0, 0, 0); }
            *(GAS f32x4*)(kcvp + (((size_t)b * 127 + n) * 2 + c) * 128 + g * 64 + 16 * nt + 4 * quad) = o;
            const int d0 = 16 * nt + 4 * quad;
            if (c == 0) *(GAS unsigned long long*)((bf16*)(ws + WS_KC) + ((size_t)(b * 2 + g) * 128 + n) * 64 + d0) = (unsigned long long)pk2(o.x, o.y) | ((unsigned long long)pk2(o.z, o.w) << 32);
            else { bf16* vt = (bf16*)(ws + WS_VTC) + ((size_t)(b * 2 + g) * 64 + d0) * 128 + n; vt[0] = (bf16)f2bf(o.x); vt[128] = (bf16)f2bf(o.y); vt[256] = (bf16)f2bf(o.z); vt[384] = (bf16)f2bf(o.w); } }
        __syncthreads();
    }
    if (blockIdx.x == 0) for (int i = F.tid; i < 16 * 64; i += NTHR) { const int bg = i >> 6, d = i & 63; ((bf16*)(ws + WS_KC))[((size_t)bg * 128 + 127) * 64 + d] = 0; ((bf16*)(ws + WS_VTC))[((size_t)bg * 64 + d) * 128 + 127] = 0; }
}


__device__ __forceinline__ float logsig_f(float x) { return fminf(x, 0.f) - __logf(1.f + __expf(-fabsf(x))); }
__device__ __forceinline__ void gla_cumsum(Frame& F, const Args& a, int row0, int h, LAS float* Bc, LAS float* seg) {
    const float* narrow = (const float*)(a.ws + WS_NARROW); const float* w_a2 = (const float*)a.in[14]; const float* b_a = (const float*)a.in[15];
    { const int c = F.tid >> 3, dk0 = (F.tid & 7) * 8; const float* ar = narrow + (size_t)(row0 + c) * 64;
      const f32x4 a0 = *(const f32x4*)(ar), a1 = *(const f32x4*)(ar + 4), a2 = *(const f32x4*)(ar + 8), a3 = *(const f32x4*)(ar + 12);
      const float ag[16] = {a0.x, a0.y, a0.z, a0.w, a1.x, a1.y, a1.z, a1.w, a2.x, a2.y, a2.z, a2.w, a3.x, a3.y, a3.z, a3.w};
      f32x4 l0 = *(const f32x4*)(b_a + h * 64 + dk0), l1 = *(const f32x4*)(b_a + h * 64 + dk0 + 4);
#pragma unroll
      for (int r = 0; r < 16; ++r) { l0 += *(const f32x4*)(w_a2 + r * 256 + h * 64 + dk0) * ag[r]; l1 += *(const f32x4*)(w_a2 + r * 256 + h * 64 + dk0 + 4) * ag[r]; }
#pragma unroll
      for (int e = 0; e < 4; ++e) { Bc[c * 65 + dk0 + e] = logsig_f(l0[e]) * 0.0625f; Bc[c * 65 + dk0 + 4 + e] = logsig_f(l1[e]) * 0.0625f; } }
    __syncthreads();
    const int dk = F.tid & 63, sg = F.tid >> 6;
    { float run = 0.f;
#pragma unroll
      for (int i = 0; i < 8; ++i) { run += Bc[(sg * 8 + i) * 65 + dk]; Bc[(sg * 8 + i) * 65 + dk] = run; }
      seg[sg * 64 + dk] = run; }
    __syncthreads();
    { float off = 0.f;
#pragma unroll
      for (int s2 = 0; s2 < 8; ++s2) off += (s2 < sg) ? seg[s2 * 64 + dk] : 0.f;
#pragma unroll
      for (int i = 0; i < 8; ++i) Bc[(sg * 8 + i) * 65 + dk] += off; }
    __syncthreads();
}
__device__ __forceinline__ void gla_load_vt(Frame& F, const bf16* ZB, int row0, int h, LAS bf16* VT) {
#pragma unroll
    for (int q = 0; q < 2; ++q) { const int ch = F.tid + q * NTHR, c = ch >> 4, dv0 = (ch & 15) * 8;
        const bf16x8 vx = *(const bf16x8*)(ZB + (size_t)(row0 + c) * ZN + PZ_VG + h * 128 + dv0);
#pragma unroll
        for (int e = 0; e < 8; ++e) VT[(dv0 + e) * 72 + c] = (bf16)vx[e]; }
}
__device__ __forceinline__ void gla_a(Frame& F0, const Args& a) { Frame F = launder(F0);
    unsigned char* ws = a.ws; const bf16* ZB = (const bf16*)(ws + WS_ZB); float* glas = (float*)(ws + WS_GLAS); float* glad = (float*)(ws + WS_GLAD);
    LAS float* Bc = (LAS float*)(F.lds + RING_OFF); LAS float* seg = (LAS float*)(F.lds + RING_OFF + 16640);
    LAS bf16* KT = (LAS bf16*)(F.lds + RING_OFF + 18688); LAS bf16* VT = (LAS bf16*)(F.lds + RING_OFF + 73984);
    const int lr = F.lane & 15, quad = F.lane >> 4;
    for (int unit = blockIdx.x; unit < 1024; unit += F.G) { const int b = unit >> 7, h = (unit >> 5) & 3, n = unit & 31, row0 = b * 2048 + n * 64;
        gla_cumsum(F, a, row0, h, Bc, seg);
        { const int c = F.tid >> 3, dk0 = (F.tid & 7) * 8; const bf16x8 kx = *(const bf16x8*)(ZB + (size_t)(row0 + c) * ZN + PZ_KG + h * 64 + dk0);
#pragma unroll
          for (int e = 0; e < 8; ++e) KT[(dk0 + e) * 72 + c] = (bf16)f2bf(bf2f((unsigned short)kx[e]) * __expf(Bc[63 * 65 + dk0 + e] - Bc[c * 65 + dk0 + e])); }
        gla_load_vt(F, ZB, row0, h, VT);
        if (F.tid < 64) glad[(size_t)unit * 64 + F.tid] = __expf(Bc[63 * 65 + F.tid]);
        __syncthreads();
#pragma unroll
        for (int it = 0; it < 4; ++it) { f32x4 acc = {0.f, 0.f, 0.f, 0.f};
#pragma unroll
            for (int ks = 0; ks < 2; ++ks) { const bf16x8 af = *(const LAS bf16x8*)(KT + (16 * it + lr) * 72 + 32 * ks + 8 * quad), bf = *(const LAS bf16x8*)(VT + (16 * F.wave + lr) * 72 + 32 * ks + 8 * quad);
                acc = __builtin_amdgcn_mfma_f32_16x16x32_bf16(af, bf, acc, 0, 0, 0); }
            *(GAS f32x4*)(glas + ((size_t)unit * 128 + 16 * F.wave + lr) * 64 + 16 * it + 4 * quad) = acc; }
        __syncthreads();
    }
}
__device__ __forceinline__ void gla_scan(Frame& F0, const Args& a) { Frame F = launder(F0);
    float* glas = (float*)(a.ws + WS_GLAS); const float* glad = (const float*)(a.ws + WS_GLAD);
    for (int idx = blockIdx.x * NTHR + F.tid; idx < 32 * 8192; idx += F.G * NTHR) { const int bh = idx >> 13, rest = idx & 8191, dk = rest & 63, dv = rest >> 6;
        float kv[32], d[32];
#pragma unroll
        for (int n = 0; n < 32; ++n) { kv[n] = glas[((size_t)(bh * 32 + n)) * 8192 + rest]; d[n] = glad[(size_t)(bh * 32 + n) * 64 + dk]; }
        float S = 0.f;
#pragma unroll
        for (int n = 0; n < 32; ++n) { glas[((size_t)(bh * 32 + n)) * 8192 + rest] = S; S = d[n] * S + kv[n]; }
        a.out[O_GSP + ((size_t)bh * 64 + dk) * 128 + dv] = S; }
}
__device__ __forceinline__ void gla_c(Frame& F0, const Args& a) { Frame F = launder(F0);
    unsigned char* ws = a.ws; const bf16* ZB = (const bf16*)(ws + WS_ZB); const float* glas = (const float*)(ws + WS_GLAS); bf16* ATT = (bf16*)(ws + WS_ATT);
    const float* gamma = (const float*)a.in[16];
    LAS float* Bc = (LAS float*)(F.lds + RING_OFF); LAS float* seg = (LAS float*)(F.lds + RING_OFF + 16640);
    LAS bf16* QH = (LAS bf16*)(F.lds + RING_OFF + 18688); LAS bf16* KH = (LAS bf16*)(F.lds + RING_OFF + 27904); LAS bf16* QT = (LAS bf16*)(F.lds + RING_OFF + 37120);
    LAS bf16* AM = (LAS bf16*)(F.lds + RING_OFF + 46336); LAS bf16* ST = (LAS bf16*)(F.lds + RING_OFF + 55552); LAS bf16* VT = (LAS bf16*)(F.lds + RING_OFF + 73984);
    LAS float* ssq = (LAS float*)(F.lds + RING_OFF + 92416);
    const int lr = F.lane & 15, quad = F.lane >> 4;
    for (int unit = blockIdx.x; unit < 1024; unit += F.G) { const int b = unit >> 7, h = (unit >> 5) & 3, n = unit & 31, row0 = b * 2048 + n * 64;
        gla_cumsum(F, a, row0, h, Bc, seg);
        { const int c = F.tid >> 3, dk0 = (F.tid & 7) * 8; const bf16* zr = ZB + (size_t)(row0 + c) * ZN + h * 64 + dk0;
          const bf16x8 qx = *(const bf16x8*)(zr + PZ_QG), kx = *(const bf16x8*)(zr + PZ_KG); float qh[8], kh[8], qt[8];
#pragma unroll
          for (int e = 0; e < 8; ++e) { const float bc = Bc[c * 65 + dk0 + e], bm = Bc[31 * 65 + dk0 + e], q = bf2f((unsigned short)qx[e]), k = bf2f((unsigned short)kx[e]);
              qh[e] = q * __expf(bc - bm); kh[e] = k * __expf(bm - bc); qt[e] = q * __expf(bc); }
          v4u w; w.x = pk2(qh[0], qh[1]); w.y = pk2(qh[2], qh[3]); w.z = pk2(qh[4], qh[5]); w.w = pk2(qh[6], qh[7]); *(LAS v4u*)(QH + c * 72 + dk0) = w;
          w.x = pk2(kh[0], kh[1]); w.y = pk2(kh[2], kh[3]); w.z = pk2(kh[4], kh[5]); w.w = pk2(kh[6], kh[7]); *(LAS v4u*)(KH + c * 72 + dk0) = w;
          w.x = pk2(qt[0], qt[1]); w.y = pk2(qt[2], qt[3]); w.z = pk2(qt[4], qt[5]); w.w = pk2(qt[6], qt[7]); *(LAS v4u*)(QT + c * 72 + dk0) = w; }
#pragma unroll
        for (int q = 0; q < 2; ++q) { const int ch = F.tid + q * NTHR, dv = ch >> 3, dk0 = (ch & 7) * 8; const float* sp = glas + ((size_t)unit * 128 + dv) * 64 + dk0;
            const f32x4 s0 = *(const GAS f32x4*)sp, s1 = *(const GAS f32x4*)(sp + 4);
            v4u w; w.x = pk2(s0.x, s0.y); w.y = pk2(s0.z, s0.w); w.z = pk2(s1.x, s1.y); w.w = pk2(s1.z, s1.w); *(LAS v4u*)(ST + dv * 72 + dk0) = w; }
        gla_load_vt(F, ZB, row0, h, VT);
        __syncthreads();
        { const int it = F.wave >> 1;
#pragma unroll
          for (int jj = 0; jj < 2; ++jj) { const int jt = 2 * (F.wave & 1) + jj; f32x4 acc = {0.f, 0.f, 0.f, 0.f};
#pragma unroll
              for (int ks = 0; ks < 2; ++ks) { const bf16x8 af = *(const LAS bf16x8*)(QH + (16 * it + lr) * 72 + 32 * ks + 8 * quad), bf = *(const LAS bf16x8*)(KH + (16 * jt + lr) * 72 + 32 * ks + 8 * quad);
                  acc = __builtin_amdgcn_mfma_f32_16x16x32_bf16(af, bf, acc, 0, 0, 0); }
#pragma unroll
              for (int e = 0; e < 4; ++e) { const int i = 16 * it + 4 * quad + e, j = 16 * jt + lr; AM[i * 72 + j] = (bf16)f2bf(j <= i ? acc[e] : 0.f); } } }
        __syncthreads();
        { const int it = F.wave >> 1; f32x4 acc[4]; float sq = 0.f;
#pragma unroll
          for (int mm = 0; mm < 4; ++mm) { const int mt = 4 * (F.wave & 1) + mm; acc[mm] = (f32x4){0.f, 0.f, 0.f, 0.f};
#pragma unroll
              for (int ks = 0; ks < 2; ++ks) { const bf16x8 af = *(const LAS bf16x8*)(VT + (16 * mt + lr) * 72 + 32 * ks + 8 * quad), bf = *(const LAS bf16x8*)(AM + (16 * it + lr) * 72 + 32 * ks + 8 * quad);
                  acc[mm] = __builtin_amdgcn_mfma_f32_16x16x32_bf16(af, bf, acc[mm], 0, 0, 0); }
#pragma unroll
              for (int ks = 0; ks < 2; ++ks) { const bf16x8 af = *(const LAS bf16x8*)(ST + (16 * mt + lr) * 72 + 32 * ks + 8 * quad), bf = *(const LAS bf16x8*)(QT + (16 * it + lr) * 72 + 32 * ks + 8 * quad);
                  acc[mm] = __builtin_amdgcn_mfma_f32_16x16x32_bf16(af, bf, acc[mm], 0, 0, 0); }
              sq += (acc[mm].x * acc[mm].x + acc[mm].y * acc[mm].y) + (acc[mm].z * acc[mm].z + acc[mm].w * acc[mm].w); }
          sq += xor_f<16>(sq); sq = swap32_sum(sq);
          if (quad == 0) ssq[(F.wave & 1) * 64 + 16 * it + lr] = sq;
          __syncthreads();
          const int i = 16 * it + lr; const float rs = rsqrtf((ssq[i] + ssq[64 + i]) * (1.f / 128.f) + 1e-6f);
#pragma unroll
          for (int mm = 0; mm < 4; ++mm) { const int dv0 = 16 * (4 * (F.wave & 1) + mm) + 4 * quad; const f32x4 gm = *(const f32x4*)(gamma + dv0);
              const unsigned long long rgw = *(const GAS unsigned long long*)(ZB + (size_t)(row0 + i) * ZN + PZ_RG + h * 128 + dv0); float o[4];
#pragma unroll
              for (int e = 0; e < 4; ++e) { const float rg = bf2f((unsigned short)(rgw >> (16 * e))); o[e] = acc[mm][e] * rs * gm[e] * rg / (1.f + __expf(-rg)); }
              *(GAS unsigned long long*)(ATT + (size_t)(row0 + i) * 1024 + h * 128 + dv0) = (unsigned long long)pk2(o[0], o[1]) | ((unsigned long long)pk2(o[2], o[3]) << 32); } }
        __syncthreads();
    }
}
__device__ __forceinline__ void gla_sample(Frame& F0, const Args& a) { Frame F = launder(F0);
    unsigned char* ws = a.ws; const bf16* ZB = (const bf16*)(ws + WS_ZB); const float* narrow = (const float*)(ws + WS_NARROW); bf16* ATT = (bf16*)(ws + WS_ATT);
    const float* st0 = (const float*)a.in[2]; const float* w_a2 = (const float*)a.in[14]; const float* b_a = (const float*)a.in[15]; const float* gamma = (const float*)a.in[16];
    LAS float* par = (LAS float*)(F.lds + RING_OFF); LAS float* tot = (LAS float*)(F.lds + RING_OFF + 4096); LAS float* gk = (LAS float*)(F.lds + RING_OFF + 8192);
    const int dv = F.tid & 127, dq = F.tid >> 7;
    for (int unit = blockIdx.x; unit < 128; unit += F.G) { const int b = unit >> 2, h = unit & 3;
        float S[16];
#pragma unroll
        for (int e = 0; e < 16; ++e) S[e] = st0[((size_t)unit * 64 + dq * 16 + e) * 128 + dv];
        for (int t = 0; t < 4; ++t) { const size_t row = (size_t)RP + b * 4 + t;
            if (F.tid < 64) { const int dk = h * 64 + F.tid; const float* ar = narrow + row * 64; float lg = b_a[dk];
#pragma unroll
                for (int r = 0; r < 16; ++r) lg += ar[r] * w_a2[r * 256 + dk];
                gk[F.tid] = __expf(logsig_f(lg) * 0.0625f); gk[64 + F.tid] = bf2f(ZB[row * ZN + PZ_KG + dk]); gk[128 + F.tid] = bf2f(ZB[row * ZN + PZ_QG + dk]); }
            __syncthreads();
            const float vv = bf2f(ZB[row * ZN + PZ_VG + h * 128 + dv]); float op = 0.f;
#pragma unroll
            for (int e = 0; e < 16; ++e) { const int dl = dq * 16 + e; S[e] = gk[dl] * S[e] + gk[64 + dl] * vv; op += gk[128 + dl] * S[e]; }
            par[dq * 128 + dv] = op; __syncthreads();
            const float o = (par[dv] + par[128 + dv]) + (par[256 + dv] + par[384 + dv]);
            if (F.tid < 128) { const float q = wave_sum(o * o); if (F.lane == 0) tot[F.wave] = q; }
            __syncthreads();
            if (F.tid < 128) { const float rs = rsqrtf((tot[0] + tot[1]) * (1.f / 128.f) + 1e-6f); const float rg = bf2f(ZB[row * ZN + PZ_RG + h * 128 + dv]);
                ATT[row * 1024 + h * 128 + dv] = (bf16)f2bf(o * rs * gamma[dv] * rg / (1.f + __expf(-rg))); }
            __syncthreads(); }
#pragma unroll
        for (int e = 0; e < 16; ++e) a.out[O_GSS + ((size_t)unit * 64 + dq * 16 + e) * 128 + dv] = S[e];
    }
}


__device__ __forceinline__ void make_vt(Frame& F0, const Args& a) { Frame F = launder(F0);
    unsigned char* ws = a.ws; const bf16* ZB = (const bf16*)(ws + WS_ZB);
    LAS bf16* T = (LAS bf16*)(F.lds + RING_OFF + F.wave * 9216);
    const int gw = F.vcu * NWAVES + F.wave, NGW = F.G * NWAVES;
    for (int it = gw; it < 1024; it += NGW) { const int which = it >> 9, b = (it >> 6) & 7, g = (it >> 5) & 1, tile = it & 31;
        const bf16* src = ZB + ((size_t)b * 2048 + 64 * tile) * ZN + (which ? PZ_KVW : PZ_KVS) + 128 + g * 64;
        bf16* dst = (bf16*)(ws + (which ? WS_VTW : WS_VTS)) + ((size_t)(b * 2 + g) * 64) * 2048 + 64 * tile;
#pragma unroll
        for (int i = 0; i < 8; ++i) { const int ch = i * 64 + F.lane, tok = ch >> 3, c8 = ch & 7; const bf16x8 x = *(const bf16x8*)(src + (size_t)tok * ZN + c8 * 8);
#pragma unroll
            for (int e = 0; e < 8; ++e) T[(c8 * 8 + e) * 72 + tok] = (bf16)x[e]; }
        LDS_WAIT(); asm volatile("" ::: "memory");
#pragma unroll
        for (int i = 0; i < 8; ++i) { const int ch = i * 64 + F.lane, d = ch >> 3, c8 = ch & 7; *(GAS v4u*)(dst + (size_t)d * 2048 + c8 * 8) = *(const LAS v4u*)(T + d * 72 + c8 * 8); }
        LDS_WAIT(); asm volatile("" ::: "memory");
    }
}
typedef float f32x16 __attribute__((ext_vector_type(16)));
constexpr float L2E = 1.4426950408889634f, NEGB = -1.0e30f;
constexpr int A_K0 = 0, A_K1 = 9216, A_V0 = 18432, A_V1 = 27136, A_IMPH = 36864, A_IMPC = 70656, A_SC = 104448, A_MASK = 112896;
struct AttnSt { float m, l; f32x16 o0, o1; };
__device__ __forceinline__ unsigned bfpair(float lo, float hi) { return pk2(lo, hi); }
__device__ __forceinline__ void attn_tile(const LAS bf16* Kb, const LAS bf16* Vb, const bf16x8 (&qr)[4], AttnSt& st, int mode, int itok, bool on, int lane) {
    const int q = lane & 31, hi = lane >> 5;
    f32x16 p0, p1;
#pragma unroll
    for (int r = 0; r < 16; ++r) { p0[r] = 0.f; p1[r] = 0.f; }
#pragma unroll
    for (int ds = 0; ds < 4; ++ds) { const bf16x8 k0 = *(const LAS bf16x8*)(Kb + q * 72 + 16 * ds + 8 * hi), k1 = *(const LAS bf16x8*)(Kb + (q + 32) * 72 + 16 * ds + 8 * hi);
        p0 = __builtin_amdgcn_mfma_f32_32x32x16_bf16(k0, qr[ds], p0, 0, 0, 0); p1 = __builtin_amdgcn_mfma_f32_32x32x16_bf16(k1, qr[ds], p1, 0, 0, 0); __builtin_amdgcn_sched_barrier(0); }
    float mx = NEGB;
#pragma unroll
    for (int r = 0; r < 16; ++r) { const int kv = (r & 3) + 8 * (r >> 2) + 4 * hi;
        const bool ok0 = on && (mode == 0 || (mode == 1 ? kv <= itok : kv > itok)), ok1 = on && (mode == 0 || (mode == 1 ? kv + 32 <= itok : kv + 32 > itok));
        p0[r] = ok0 ? p0[r] * L2E : NEGB; p1[r] = ok1 ? p1[r] * L2E : NEGB; mx = fmaxf(mx, fmaxf(p0[r], p1[r])); }
    mx = swap32_max(mx);
    const float mn = fmaxf(st.m, mx), alpha = __builtin_amdgcn_exp2f(st.m - mn); st.m = mn;
    float sum = 0.f;
#pragma unroll
    for (int r = 0; r < 16; ++r) { p0[r] = __builtin_amdgcn_exp2f(p0[r] - mn); p1[r] = __builtin_amdgcn_exp2f(p1[r] - mn); sum += p0[r] + p1[r]; }
    st.l = st.l * alpha + sum;
    if (__any(alpha != 1.0f)) { st.o0 *= alpha; st.o1 *= alpha; }
    __builtin_amdgcn_sched_barrier(0);
    bf16x8 pf[4];
#pragma unroll
    for (int s = 0; s < 4; ++s) { const f32x16& p = (s < 2) ? p0 : p1; const int o = 8 * (s & 1);
        v4u w; w.x = bfpair(p[o], p[o + 1]); w.y = bfpair(p[o + 2], p[o + 3]); w.z = bfpair(p[o + 4], p[o + 5]); w.w = bfpair(p[o + 6], p[o + 7]); pf[s] = __builtin_bit_cast(bf16x8, w); }
    __builtin_amdgcn_sched_barrier(0);
#pragma unroll
    for (int s = 0; s < 4; ++s) {
        typedef unsigned long long u64; typedef u64 u64x2 __attribute__((ext_vector_type(2)));
        u64x2 va, vb; va.x = *(const LAS u64*)(Vb + q * 68 + 16 * s + 4 * hi); va.y = *(const LAS u64*)(Vb + q * 68 + 16 * s + 8 + 4 * hi);
        vb.x = *(const LAS u64*)(Vb + (q + 32) * 68 + 16 * s + 4 * hi); vb.y = *(const LAS u64*)(Vb + (q + 32) * 68 + 16 * s + 8 + 4 * hi);
        st.o0 = __builtin_amdgcn_mfma_f32_32x32x16_bf16(__builtin_bit_cast(bf16x8, va), pf[s], st.o0, 0, 0, 0);
        st.o1 = __builtin_amdgcn_mfma_f32_32x32x16_bf16(__builtin_bit_cast(bf16x8, vb), pf[s], st.o1, 0, 0, 0); __builtin_amdgcn_sched_barrier(0); }
}
struct TileRegs { v4u k, v; };
__device__ __forceinline__ void tile_fetch(TileRegs& t, const bf16* kbase, size_t kpitch, const bf16* vbase, size_t vpitch, int tid) {
    const int row = tid >> 3, c8 = tid & 7; t.k = *(const GAS v4u*)(kbase + (size_t)row * kpitch + c8 * 8); t.v = *(const GAS v4u*)(vbase + (size_t)row * vpitch + c8 * 8); }
__device__ __forceinline__ void tile_store(const TileRegs& t, LAS bf16* Kb, LAS bf16* Vb, int tid) {
    typedef unsigned long long u64; const int row = tid >> 3, c8 = tid & 7; *(LAS v4u*)(Kb + row * 72 + c8 * 8) = t.k;
    *(LAS u64*)(Vb + row * 68 + c8 * 8) = (u64)t.v.x | ((u64)t.v.y << 32); *(LAS u64*)(Vb + row * 68 + c8 * 8 + 4) = (u64)t.v.z | ((u64)t.v.w << 32); }

__device__ __forceinline__ void nsa_prompt_unit(Frame& F, const Args& a, int b, int g, int qb) {
    unsigned char* ws = a.ws; const bf16* ZB = (const bf16*)(ws + WS_ZB); const float* narrow = (const float*)(ws + WS_NARROW); bf16* ATT = (bf16*)(ws + WS_ATT);
    LAS bf16* KB0 = (LAS bf16*)(F.lds + RING_OFF + A_K0); LAS bf16* KB1 = (LAS bf16*)(F.lds + RING_OFF + A_K1); LAS bf16* VB0 = (LAS bf16*)(F.lds + RING_OFF + A_V0); LAS bf16* VB1 = (LAS bf16*)(F.lds + RING_OFF + A_V1);
    LAS float* IMPH = (LAS float*)(F.lds + RING_OFF + A_IMPH); LAS float* IMPC = (LAS float*)(F.lds + RING_OFF + A_IMPC); LAS float* SC = (LAS float*)(F.lds + RING_OFF + A_SC);
    LAS unsigned* MASK = (LAS unsigned*)(F.lds + RING_OFF + A_MASK);
    const int lane = F.lane, q = lane & 31, hi = lane >> 5, r = F.wave >> 1, th = F.wave & 1, itok = 32 * th + q, t0 = 64 * qb, t = t0 + itok, h = g * 4 + r;
    const size_t row = (size_t)b * 2048 + t;
    bf16x8 qr[4];
#pragma unroll
    for (int ds = 0; ds < 4; ++ds) qr[ds] = *(const bf16x8*)(ZB + row * ZN + PZ_QN + h * 64 + 16 * ds + 8 * hi);
    float gate[3];
#pragma unroll
    for (int br = 0; br < 3; ++br) { const float gx = narrow[row * 64 + 16 + h * 3 + br]; gate[br] = 1.f / (1.f + __expf(-gx)); }
    f32x16 oc0, oc1;
    LAS float* stg = (LAS float*)(F.lds + RING_OFF + A_IMPH) + F.wave * 2048 + lane;
    { const bf16* kc = (const bf16*)(ws + WS_KC) + (size_t)(b * 2 + g) * 128 * 64; const bf16* vtc = (const bf16*)(ws + WS_VTC) + (size_t)(b * 2 + g) * 64 * 128;
      TileRegs ta, tb; tile_fetch(ta, kc, 64, vtc, 128, F.tid); tile_fetch(tb, kc + 64 * 64, 64, vtc + 64, 128, F.tid);
      tile_store(ta, KB0, VB0, F.tid); tile_store(tb, KB1, VB1, F.tid);
      __syncthreads();
      f32x16 pa0, pa1, pb0, pb1;
#pragma unroll
      for (int rr = 0; rr < 16; ++rr) { pa0[rr] = 0.f; pa1[rr] = 0.f; pb0[rr] = 0.f; pb1[rr] = 0.f; }
#pragma unroll
      for (int ds = 0; ds < 4; ++ds) { const int ko = 16 * ds + 8 * hi;
          pa0 = __builtin_amdgcn_mfma_f32_32x32x16_bf16(*(const LAS bf16x8*)(KB0 + q * 72 + ko), qr[ds], pa0, 0, 0, 0); pa1 = __builtin_amdgcn_mfma_f32_32x32x16_bf16(*(const LAS bf16x8*)(KB0 + (q + 32) * 72 + ko), qr[ds], pa1, 0, 0, 0);
          pb0 = __builtin_amdgcn_mfma_f32_32x32x16_bf16(*(const LAS bf16x8*)(KB1 + q * 72 + ko), qr[ds], pb0, 0, 0, 0); pb1 = __builtin_amdgcn_mfma_f32_32x32x16_bf16(*(const LAS bf16x8*)(KB1 + (q + 32) * 72 + ko), qr[ds], pb1, 0, 0, 0); }
      const int nmax = t >= 31 ? ((t - 31) >> 4) : -1; float mx = NEGB;
#pragma unroll
      for (int rr = 0; rr < 16; ++rr) { const int kv = (rr & 3) + 8 * (rr >> 2) + 4 * hi;
          pa0[rr] = (kv <= nmax) ? pa0[rr] * L2E : NEGB; pa1[rr] = (kv + 32 <= nmax) ? pa1[rr] * L2E : NEGB; pb0[rr] = (kv + 64 <= nmax) ? pb0[rr] * L2E : NEGB; pb1[rr] = (kv + 96 <= nmax) ? pb1[rr] * L2E : NEGB;
          mx = fmaxf(fmaxf(mx, fmaxf(pa0[rr], pa1[rr])), fmaxf(pb0[rr], pb1[rr])); }
      mx = swap32_max(mx); float sum = 0.f;
#pragma unroll
      for (int rr = 0; rr < 16; ++rr) { const int kv = (rr & 3) + 8 * (rr >> 2) + 4 * hi;
          pa0[rr] = (kv <= nmax) ? __builtin_amdgcn_exp2f(pa0[rr] - mx) : 0.f; pa1[rr] = (kv + 32 <= nmax) ? __builtin_amdgcn_exp2f(pa1[rr] - mx) : 0.f;
          pb0[rr] = (kv + 64 <= nmax) ? __builtin_amdgcn_exp2f(pb0[rr] - mx) : 0.f; pb1[rr] = (kv + 96 <= nmax) ? __builtin_amdgcn_exp2f(pb1[rr] - mx) : 0.f;
          sum += (pa0[rr] + pa1[rr]) + (pb0[rr] + pb1[rr]); }
      sum = swap32_sum(sum); const float inv = sum > 0.f ? 1.f / sum : 0.f;
#pragma unroll
      for (int rr = 0; rr < 16; ++rr) { pa0[rr] *= inv; pa1[rr] *= inv; pb0[rr] *= inv; pb1[rr] *= inv; }
      { LAS float* ih = IMPH + (r * 64 + itok) * 33; LAS float* ic = IMPC + (r * 64 + itok) * 33;
        if (hi == 0) ic[0] = 0.f;
#pragma unroll
        for (int rg = 0; rg < 4; ++rg) {
            const int j0 = 2 * rg + hi;
            ih[j0] = (pa0[4 * rg] + pa0[4 * rg + 1]) + (pa0[4 * rg + 2] + pa0[4 * rg + 3]); ic[j0 + 1] = pa0[4 * rg + 3];
            ih[j0 + 8] = (pa1[4 * rg] + pa1[4 * rg + 1]) + (pa1[4 * rg + 2] + pa1[4 * rg + 3]); ic[j0 + 9] = pa1[4 * rg + 3];
            ih[j0 + 16] = (pb0[4 * rg] + pb0[4 * rg + 1]) + (pb0[4 * rg + 2] + pb0[4 * rg + 3]); ic[j0 + 17] = pb0[4 * rg + 3];
            ih[j0 + 24] = (pb1[4 * rg] + pb1[4 * rg + 1]) + (pb1[4 * rg + 2] + pb1[4 * rg + 3]); ic[j0 + 25] = pb1[4 * rg + 3]; } }
#pragma unroll
      for (int rr = 0; rr < 16; ++rr) { oc0[rr] = 0.f; oc1[rr] = 0.f; }
#pragma unroll
      for (int s = 0; s < 8; ++s) { const f32x16& p = (s < 2) ? pa0 : (s < 4) ? pa1 : (s < 6) ? pb0 : pb1; const int o = 8 * (s & 1); const LAS bf16* Vb = (s < 4) ? VB0 : VB1; const int sl = s & 3;
          v4u w; w.x = bfpair(p[o], p[o + 1]); w.y = bfpair(p[o + 2], p[o + 3]); w.z = bfpair(p[o + 4], p[o + 5]); w.w = bfpair(p[o + 6], p[o + 7]); const bf16x8 pf = __builtin_bit_cast(bf16x8, w);
          typedef unsigned long long u64; typedef u64 u64x2 __attribute__((ext_vector_type(2)));
          u64x2 va, vb; va.x = *(const LAS u64*)(Vb + q * 68 + 16 * sl + 4 * hi); va.y = *(const LAS u64*)(Vb + q * 68 + 16 * sl + 8 + 4 * hi);
          vb.x = *(const LAS u64*)(Vb + (q + 32) * 68 + 16 * sl + 4 * hi); vb.y = *(const LAS u64*)(Vb + (q + 32) * 68 + 16 * sl + 8 + 4 * hi);
          oc0 = __builtin_amdgcn_mfma_f32_32x32x16_bf16(__builtin_bit_cast(bf16x8, va), pf, oc0, 0, 0, 0); oc1 = __builtin_amdgcn_mfma_f32_32x32x16_bf16(__builtin_bit_cast(bf16x8, vb), pf, oc1, 0, 0, 0); }
      oc0 *= gate[0]; oc1 *= gate[0];
    }
    __syncthreads();
    if (qb >= 16) {
        const int tok = F.tid >> 3, jg = F.tid & 7;
#pragma unroll
        for (int e = 0; e < 4; ++e) { const int j = jg * 4 + e; float im = 0.f;
#pragma unroll
            for (int hh = 0; hh < 4; ++hh) im += IMPH[(hh * 64 + tok) * 33 + j] + IMPC[(hh * 64 + tok) * 33 + j];
            const bool forced = (j == 0) || (j == qb) || (j == qb - 1);
            SC[tok * 33 + j] = (j <= qb) ? im + (forced ? 1.0e4f : 0.f) : -INFINITY; }
        __syncthreads();
        unsigned bits = 0u;
#pragma unroll
        for (int e = 0; e < 4; ++e) { const int j = jg * 4 + e; const float sj = SC[tok * 33 + j]; int cnt = 0;
            for (int k = 0; k < 32; ++k) { const float sk = SC[tok * 33 + k]; cnt += (sk > sj || (sk == sj && k < j)) ? 1 : 0; }
            bits |= (cnt < 16 ? 1u : 0u) << j; }
        MASK[tok * 8 + jg] = bits;
        __syncthreads();
    }
    unsigned selmask = 0xffffffffu;
    if (qb >= 16) { const v4u m0 = *(const LAS v4u*)(MASK + itok * 8), m1 = *(const LAS v4u*)(MASK + itok * 8 + 4); selmask = (m0.x | m0.y) | (m0.z | m0.w) | (m1.x | m1.y) | (m1.z | m1.w); }
#pragma unroll
    for (int rr = 0; rr < 16; ++rr) { stg[rr * 64] = oc0[rr]; stg[(16 + rr) * 64] = oc1[rr]; }
    { AttnSt st; st.m = NEGB; st.l = 0.f;
#pragma unroll
      for (int rr = 0; rr < 16; ++rr) { st.o0[rr] = 0.f; st.o1[rr] = 0.f; }
      const bf16* kb = ZB + (size_t)b * 2048 * ZN + PZ_KVS + g * 64; const bf16* vb = (const bf16*)(ws + WS_VTS) + (size_t)(b * 2 + g) * 64 * 2048;
      TileRegs tr; tile_fetch(tr, kb, ZN, vb, 2048, F.tid);
      for (int j = 0; j <= qb; ++j) { LAS bf16* Kb = (j & 1) ? KB1 : KB0; LAS bf16* Vb = (j & 1) ? VB1 : VB0;
          tile_store(tr, Kb, Vb, F.tid); __syncthreads();
          if (j < qb) tile_fetch(tr, kb + (size_t)(j + 1) * 64 * ZN, ZN, vb + (j + 1) * 64, 2048, F.tid);
          attn_tile(Kb, Vb, qr, st, j == qb ? 1 : 0, itok, (selmask >> j) & 1u, lane); }
      const float l = swap32_sum(st.l), f = gate[1] / l;
#pragma unroll
      for (int rr = 0; rr < 16; ++rr) { stg[rr * 64] += st.o0[rr] * f; stg[(16 + rr) * 64] += st.o1[rr] * f; } }
    __syncthreads();
    { AttnSt st; st.m = NEGB; st.l = 0.f;
#pragma unroll
      for (int rr = 0; rr < 16; ++rr) { st.o0[rr] = 0.f; st.o1[rr] = 0.f; }
      const bf16* kb = ZB + (size_t)b * 2048 * ZN + PZ_KVW + g * 64; const bf16* vb = (const bf16*)(ws + WS_VTW) + (size_t)(b * 2 + g) * 64 * 2048;
      const int jlo = qb >= 8 ? qb - 8 : 0;
      TileRegs tr; tile_fetch(tr, kb + (size_t)qb * 64 * ZN, ZN, vb + qb * 64, 2048, F.tid);
      for (int j = qb, it = 0; j >= jlo; --j, ++it) { LAS bf16* Kb = (it & 1) ? KB1 : KB0; LAS bf16* Vb = (it & 1) ? VB1 : VB0;
          tile_store(tr, Kb, Vb, F.tid); __syncthreads();
          if (j > jlo) tile_fetch(tr, kb + (size_t)(j - 1) * 64 * ZN, ZN, vb + (j - 1) * 64, 2048, F.tid);
          attn_tile(Kb, Vb, qr, st, j == qb ? 1 : (j == qb - 8 ? 2 : 0), itok, true, lane); }
      const float l = swap32_sum(st.l), f = gate[2] / l;
#pragma unroll
      for (int rr = 0; rr < 16; ++rr) { oc0[rr] = stg[rr * 64] + st.o0[rr] * f; oc1[rr] = stg[(16 + rr) * 64] + st.o1[rr] * f; } }
    __syncthreads();
    { const f32x16& tot0 = oc0; const f32x16& tot1 = oc1; bf16* orow = ATT + row * 1024 + 512 + h * 64;
#pragma unroll
      for (int rg = 0; rg < 4; ++rg) { const int d0 = 8 * rg + 4 * hi;
          *(GAS unsigned long long*)(orow + d0) = (unsigned long long)pk2(tot0[4 * rg], tot0[4 * rg + 1]) | ((unsigned long long)pk2(tot0[4 * rg + 2], tot0[4 * rg + 3]) << 32);
          *(GAS unsigned long long*)(orow + 32 + d0) = (unsigned long long)pk2(tot1[4 * rg], tot1[4 * rg + 1]) | ((unsigned long long)pk2(tot1[4 * rg + 2], tot1[4 * rg + 3]) << 32); } }
}
__device__ __forceinline__ void nsa_prompt(Frame& F0, const Args& a) { Frame F = launder(F0);
    for (int v = blockIdx.x; v < 256; v += F.G) { const int bg = v >> 4, s = v & 15;
        nsa_prompt_unit(F, a, bg >> 1, bg & 1, 31 - s);
        nsa_prompt_unit(F, a, bg >> 1, bg & 1, s); }
}


template <class KP> __device__ __forceinline__ float attend512(Frame& F, int NK, KP kp, LAS float* sc, LAS unsigned long long* kptr, const LAS float* qs, const float* dummy, LAS float* po) {
    int i0 = F.tid; asm volatile("" : "+v"(i0));
    for (int i = i0; i < NK; i += NTHR) { const float* k = kp(i); kptr[i] = (unsigned long long)(uintptr_t)(k ? k : dummy);
        float s0 = NEGB, s1 = NEGB, s2 = NEGB, s3 = NEGB;
        if (k) { s0 = 0.f; s1 = 0.f; s2 = 0.f; s3 = 0.f;
#pragma unroll
            for (int c = 0; c < 16; ++c) { const f32x4 kv = *(const GAS f32x4*)(k + 4 * c);
                const f32x4 q0 = *(const LAS f32x4*)(qs + 4 * c), q1 = *(const LAS f32x4*)(qs + 64 + 4 * c), q2 = *(const LAS f32x4*)(qs + 128 + 4 * c), q3 = *(const LAS f32x4*)(qs + 192 + 4 * c);
                s0 += (kv.x * q0.x + kv.y * q0.y) + (kv.z * q0.z + kv.w * q0.w); s1 += (kv.x * q1.x + kv.y * q1.y) + (kv.z * q1.z + kv.w * q1.w);
                s2 += (kv.x * q2.x + kv.y * q2.y) + (kv.z * q2.z + kv.w * q2.w); s3 += (kv.x * q3.x + kv.y * q3.y) + (kv.z * q3.z + kv.w * q3.w); } }
        sc[i] = s0; sc[1024 + i] = s1; sc[2048 + i] = s2; sc[3072 + i] = s3; }
    __syncthreads();
    if (F.wave < 4) { LAS float* row = sc + F.wave * 1024; float m = NEGB;
        for (int i = F.lane; i < NK; i += 64) m = fmaxf(m, row[i]);
        m = wave_max(m);
        float sum = 0.f;
        for (int i = F.lane; i < NK; i += 64) { const float x = row[i]; const float e = (x > -1.0e29f) ? __expf(x - m) : 0.f; row[i] = e; sum += e; }
        sum = wave_sum(sum); const float inv = 1.f / fmaxf(sum, 1.0e-30f);
        for (int i = F.lane; i < NK; i += 64) row[i] *= inv; }
    __syncthreads();
    { const int ks = F.tid >> 4, dq = (F.tid & 15) * 4; f32x4 o0 = {0.f, 0.f, 0.f, 0.f}, o1 = o0, o2 = o0, o3 = o0;
      int i = ks;
      for (; i + 224 < NK; i += 256) { f32x4 v[8];
#pragma unroll
          for (int u = 0; u < 8; ++u) v[u] = *(const GAS f32x4*)((const float*)(uintptr_t)kptr[i + 32 * u] + 128 + dq);
#pragma unroll
          for (int u = 0; u < 8; ++u) { const int k = i + 32 * u; o0 += v[u] * sc[k]; o1 += v[u] * sc[1024 + k]; o2 += v[u] * sc[2048 + k]; o3 += v[u] * sc[3072 + k]; } }
      for (; i < NK; i += 32) { const f32x4 v = *(const GAS f32x4*)((const float*)(uintptr_t)kptr[i] + 128 + dq); o0 += v * sc[i]; o1 += v * sc[1024 + i]; o2 += v * sc[2048 + i]; o3 += v * sc[3072 + i]; }
      *(LAS f32x4*)(po + (ks * 4 + 0) * 64 + dq) = o0; *(LAS f32x4*)(po + (ks * 4 + 1) * 64 + dq) = o1; *(LAS f32x4*)(po + (ks * 4 + 2) * 64 + dq) = o2; *(LAS f32x4*)(po + (ks * 4 + 3) * 64 + dq) = o3; }
    __syncthreads();
    float res = 0.f;
    { const int r = (F.tid >> 6) & 3, d = F.tid & 63;
#pragma unroll 4
      for (int p = 0; p < 32; ++p) res += po[(p * 4 + r) * 64 + d]; }
    return res;
}
__device__ __forceinline__ void nsa_sample(Frame& F0, const Args& a) { Frame F = launder(F0);
    unsigned char* ws = a.ws; const bf16* ZB = (const bf16*)(ws + WS_ZB); const float* narrow = (const float*)(ws + WS_NARROW); bf16* ATT = (bf16*)(ws + WS_ATT);
    const float* kcvs = (const float*)(ws + WS_KCVS); const float* cslc = (const float*)a.in[4]; const float* cwin = (const float*)a.in[5]; const int* table = (const int*)a.in[6];
    LAS float* sc = (LAS float*)(F.lds + RING_OFF); LAS unsigned long long* kptr = (LAS unsigned long long*)(F.lds + RING_OFF + 16384); LAS float* qs = (LAS float*)(F.lds + RING_OFF + 24576);
    LAS float* score = (LAS float*)(F.lds + RING_OFF + 25600); LAS unsigned* flag = (LAS unsigned*)(F.lds + RING_OFF + 26656); LAS int* sel = (LAS int*)(F.lds + RING_OFF + 27712);
    LAS float* red = (LAS float*)(F.lds + RING_OFF + 27776); LAS float* po = (LAS float*)(F.lds + RING_OFF + 32768);
    for (int unit = blockIdx.x; unit < 256; unit += F.G) { const int b = unit >> 3, g = (unit >> 2) & 1, s = unit & 3, tq = 16384 + s; const size_t row = (size_t)RP + b * 4 + s;
        if (F.tid < 256) qs[F.tid] = bf2f(ZB[row * ZN + PZ_QN + (g * 4 + (F.tid >> 6)) * 64 + (F.tid & 63)]);
        __syncthreads();
        const float* kc = kcvs + (size_t)b * 1023 * 256 + g * 64;
        const float oc = attend512(F, 1023, [&](int i) -> const float* { return kc + (size_t)i * 256; }, sc, kptr, qs, kc, po);
        for (int j = F.tid; j < 257; j += NTHR) { float im = 0.f;
            for (int i = 4 * j - 1; i <= 4 * j + 3; ++i) if (i >= 0 && i < 1023) im += (sc[i] + sc[1024 + i]) + (sc[2048 + i] + sc[3072 + i]);
            score[j] = im + ((j == 0 || j >= 255) ? 1.0e4f : 0.f); }
        __syncthreads();
        for (int j = F.tid; j < 257; j += NTHR) { const float sj = score[j]; int cnt = 0;
            for (int k = 0; k < 257; ++k) { const float sk = score[k]; cnt += (sk > sj || (sk == sj && k < j)) ? 1 : 0; }
            flag[j] = cnt < 16 ? 1u : 0u; }
        __syncthreads();
        for (int j = F.tid; j < 257; j += NTHR) if (flag[j]) { int pos = 0; for (int k = 0; k < j; ++k) pos += (int)flag[k]; sel[pos] = j; }
        __syncthreads();
        const float os = attend512(F, 1024, [&](int i) -> const float* { const int pos = sel[i >> 6] * 64 + (i & 63); if (pos > tq) return nullptr;
            if (pos < 16384) return cslc + ((size_t)table[b * 128 + (pos >> 7)] * 128 + (pos & 127)) * 256 + g * 64;
            return a.out + O_SKS + (size_t)(b * 4 + (pos - 16384)) * 256 + g * 64; }, sc, kptr, qs, kc, po);
        const float ow = attend512(F, 516, [&](int i) -> const float* { const int tw = 15872 + i; if (tw > tq || tw <= tq - 512) return nullptr;
            return i < 512 ? cwin + ((size_t)b * 512 + i) * 256 + g * 64 : a.out + O_WKS + ((size_t)b * 512 + 508 + (i - 512)) * 256 + g * 64; }, sc, kptr, qs, kc, po);
        if (F.tid < 256) { const int h = g * 4 + (F.tid >> 6), d = F.tid & 63; const float* gn = narrow + row * 64 + 16 + h * 3;
            const float o = oc / (1.f + __expf(-gn[0])) + os / (1.f + __expf(-gn[1])) + ow / (1.f + __expf(-gn[2]));
            ATT[row * 1024 + 512 + h * 64 + d] = (bf16)f2bf(o); }
        __syncthreads();
    }
}


template <int NB, class BRow, class Epi> __device__ __forceinline__ void mini_gemm(Frame& F, const bf16* A, const bf16* Bt, int K, int nunits, BRow brow, Epi epi) {
    const int lr = F.lane & 15, quad = F.lane >> 4;
    for (int u = blockIdx.x; u < nunits; u += F.G) {
        const bf16* ap = A + (size_t)(16 * F.wave + lr) * K + 8 * quad; const bf16* bp0 = Bt + (size_t)(brow(u, 0) + lr) * K + 8 * quad; const bf16* bp1 = Bt + (size_t)(brow(u, NB - 1) + lr) * K + 8 * quad;
        f32x4 acc0 = {0.f, 0.f, 0.f, 0.f}, acc1 = {0.f, 0.f, 0.f, 0.f};
        for (int k0 = 0; k0 < K; k0 += 256) { bf16x8 af[8], b0[8], b1[8];
#pragma unroll
            for (int j = 0; j < 8; ++j) { af[j] = *(const bf16x8*)(ap + k0 + 32 * j); b0[j] = *(const bf16x8*)(bp0 + k0 + 32 * j); if (NB == 2) b1[j] = *(const bf16x8*)(bp1 + k0 + 32 * j); }
#pragma unroll
            for (int j = 0; j < 8; ++j) { acc0 = __builtin_amdgcn_mfma_f32_16x16x32_bf16(b0[j], af[j], acc0, 0, 0, 0); if (NB == 2) acc1 = __builtin_amdgcn_mfma_f32_16x16x32_bf16(b1[j], af[j], acc1, 0, 0, 0); } }
        epi(u, 16 * F.wave + lr, quad, acc0, acc1);
    }
}


__device__ __forceinline__ void mini_gemm_kq(Frame& F, const bf16* A, const bf16* Bt, int K, float* out) {
    const int lr = F.lane & 15, quad = F.lane >> 4, mt = F.wave & 1, kq = F.wave >> 1, KQ = K / 4;
    LAS float* red = (LAS float*)(F.lds + RING_OFF);
    for (int u = blockIdx.x; u < 256; u += F.G) { const int cg = u & 63, rg = u >> 6;
        const bf16* ap = A + (size_t)(32 * rg + 16 * mt + lr) * K + kq * KQ + 8 * quad; const bf16* bp = Bt + (size_t)(16 * cg + lr) * K + kq * KQ + 8 * quad;
        f32x4 acc = {0.f, 0.f, 0.f, 0.f};
        int k0 = 0;
        for (; k0 + 256 <= KQ; k0 += 256) { bf16x8 af[8], bfr[8];
#pragma unroll
            for (int j = 0; j < 8; ++j) { af[j] = *(const bf16x8*)(ap + k0 + 32 * j); bfr[j] = *(const bf16x8*)(bp + k0 + 32 * j); }
#pragma unroll
            for (int j = 0; j < 8; ++j) acc = __builtin_amdgcn_mfma_f32_16x16x32_bf16(bfr[j], af[j], acc, 0, 0, 0); }
        for (; k0 < KQ; k0 += 32) { const bf16x8 af = *(const bf16x8*)(ap + k0), bfr = *(const bf16x8*)(bp + k0); acc = __builtin_amdgcn_mfma_f32_16x16x32_bf16(bfr, af, acc, 0, 0, 0); }
        *(LAS f32x4*)(red + ((kq * 2 + mt) * 64 + F.lane) * 4) = acc;
        __syncthreads();
        if (kq == 0) { f32x4 t = acc;
#pragma unroll
            for (int q = 1; q < 4; ++q) t += *(const LAS f32x4*)(red + ((q * 2 + mt) * 64 + F.lane) * 4);
            *(GAS f32x4*)(out + (size_t)(32 * rg + 16 * mt + lr) * 1024 + 16 * cg + 4 * quad) = t; }
        __syncthreads();
    }
}


__device__ __forceinline__ void cmp_gemm_fused(Frame& F0, const Args& a) { Frame F = launder(F0);
    unsigned char* ws = a.ws; const float* cc = (const float*)a.in[3]; const int* table = (const int*)a.in[6]; const bf16* w1r = (const bf16*)(ws + WS_W1R); bf16* P = (bf16*)(ws + WS_PCMP);
    LAS bf16* AB = (LAS bf16*)(F.lds + RING_OFF);
    const int q = F.lane & 31, hi = F.lane >> 5, c = F.wave >> 2, nb = (F.wave & 3) * 64;
    const int fi = 4 * (F.tid & 63), sc_ = fi >> 7, sg = (fi >> 6) & 1, sd = fi & 63, tg = F.tid >> 6;
    const int ldst = (sc_ * 128 + (tg * 8) * 2 + sg) * 72 + sd;
    for (int unit = blockIdx.x; unit < 512; unit += F.G) { const int b = unit >> 4, pg0 = (unit & 15) * 8;
        const float* src = cc + (size_t)table[b * 128 + pg0 + tg] * 128 * 256 + fi;
        f32x16 acc[4][2];
#pragma unroll
        for (int mt = 0; mt < 4; ++mt)
#pragma unroll
            for (int nt = 0; nt < 2; ++nt)
#pragma unroll
                for (int r = 0; r < 16; ++r) acc[mt][nt][r] = 0.f;
        f32x4 v[8];
#pragma unroll
        for (int i = 0; i < 8; ++i) v[i] = __builtin_nontemporal_load((const GAS f32x4*)(src + (size_t)(i * 16) * 256));
        for (int s = 0; s < 16; ++s) { LAS bf16* buf = AB + (s & 1) * (2 * 128 * 72);
#pragma unroll
            for (int i = 0; i < 8; ++i) *(LAS unsigned long long*)(buf + ldst + i * 144) = (unsigned long long)pk2(v[i].x, v[i].y) | ((unsigned long long)pk2(v[i].z, v[i].w) << 32);
            bf16x8 wf[2][4];
#pragma unroll
            for (int nt = 0; nt < 2; ++nt)
#pragma unroll
                for (int ks = 0; ks < 4; ++ks) wf[nt][ks] = *(const bf16x8*)(w1r + ((size_t)c * 256 + nb + nt * 32 + q) * 1024 + s * 64 + 16 * ks + 8 * hi);
            __syncthreads();
            if (s < 15) {
#pragma unroll
                for (int i = 0; i < 8; ++i) v[i] = __builtin_nontemporal_load((const GAS f32x4*)(src + (size_t)(i * 16 + s + 1) * 256)); }
#pragma unroll
            for (int ks = 0; ks < 4; ++ks)
#pragma unroll
                for (int mt = 0; mt < 4; ++mt) { const bf16x8 af = *(const LAS bf16x8*)(buf + (c * 128 + mt * 32 + q) * 72 + 16 * ks + 8 * hi);
                    acc[mt][0] = __builtin_amdgcn_mfma_f32_32x32x16_bf16(wf[0][ks], af, acc[mt][0], 0, 0, 0); acc[mt][1] = __builtin_amdgcn_mfma_f32_32x32x16_bf16(wf[1][ks], af, acc[mt][1], 0, 0, 0); } }
        bf16* prow = P + (size_t)c * 65536 * 256 + ((size_t)(b * 1024 + pg0 * 8) * 2) * 256 + nb;
#pragma unroll
        for (int mt = 0; mt < 4; ++mt)
#pragma unroll
            for (int nt = 0; nt < 2; ++nt)
#pragma unroll
                for (int rg = 0; rg < 4; ++rg) { const f32x16& o = acc[mt][nt];
                    *(GAS unsigned long long*)(prow + (size_t)(mt * 32 + q) * 256 + nt * 32 + 8 * rg + 4 * hi) = (unsigned long long)pk2(o[4 * rg], o[4 * rg + 1]) | ((unsigned long long)pk2(o[4 * rg + 2], o[4 * rg + 3]) << 32); }
    }
}

__global__ void __launch_bounds__(NTHR, 2) mega(Args args) {
    extern __shared__ __attribute__((aligned(16))) unsigned char lds[];
    Frame F; F.lds = (LAS unsigned char*)lds; F.tid = threadIdx.x; F.lane = F.tid & 63; F.wave = __builtin_amdgcn_readfirstlane(F.tid >> 6);
    F.G = gridDim.x; { const int bx = blockIdx.x; F.vcu = (F.G % 8 == 0) ? (bx % 8) * (F.G / 8) + bx / 8 : bx; }
    unsigned char* ws = args.ws; F.ctl = (gu32*)(ws + WS_CTL);
    for (int u = F.tid; u < (LDS_BYTES - LDSCTL_OFF) / 4; u += NTHR) ((LAS unsigned*)(F.lds + LDSCTL_OFF))[u] = 0u;
    __syncthreads();
    const int lo = args.ph_lo, hi = args.ph_hi;
    const bool multi = (hi - lo) > 1;
    unsigned* barw = (unsigned*)(F.ctl + CW_BAR) + args.li * XCD_BAR_WORDS;
    XcdBarrier bar; bar.bar = barw; bar.x = 0; bar.st = nullptr;
    if (multi) bar = xcd_barrier_post(barw, (volatile LAS unsigned*)(F.lds + MISC_OFF) + 8);
#ifndef MK_REP
#define MK_REP 0
#endif
#define IN(k) (lo <= (k) && (k) < hi)
#define REP2(k) if constexpr (((MK_REP >> (k)) & 1) != 0)
#define SEAM(k) do { if (IN(k) && IN((k) + 1)) xcd_barrier(bar); } while (0)
    if (IN(0)) { { p0_prologue(F, args); } REP2(0) { p0_prologue(F, args); } } SEAM(0);
    if (IN(1)) { { p1_ln_mod(F, args); cmp_gemm_fused(F, args); } REP2(1) { p1_ln_mod(F, args); cmp_gemm_fused(F, args); } } SEAM(1);
    if (IN(2)) { { pg8::Gemm g{(const pg8::bf16_t*)(ws + WS_U), (const pg8::bf16_t*)(ws + WS_WT_IN), RP, ZN, 1024}; pg8::StaticOrder S; S.init(RP, ZN, F.G, (int)blockIdx.x);
        pg8::EpiZ E{(pg8::bf16_t*)(ws + WS_ZB), args.out, (float*)(ws + WS_NARROW), (pg8::bf16_t*)(ws + WS_PCMP)};
        pg8::gemm_phase<pg8::EpiZ, pg8::StaticOrder, true, true>(F.lds + RING_OFF, g, S, E);
        Frame Fm = launder(F); bf16* ZBs = (bf16*)(ws + WS_ZB) + (size_t)RP * ZN; float* nar = (float*)(ws + WS_NARROW) + (size_t)RP * 64; float* outp = args.out;
        mini_gemm<1>(Fm, (const bf16*)(ws + WS_U) + (size_t)RP * 1024, (const bf16*)(ws + WS_WT_IN), 1024, ZN / 16, [](int u, int) { return 16 * u; },
            [&](int u, int row, int quad, const f32x4& a0, const f32x4&) { const int n0 = 16 * u + 4 * quad, pn = n0 >> 8, cc = n0 & 255; const float sc = (pn == 0 || pn == 6 || pn == 7) ? 0.125f : 1.0f; const f32x4 v = a0 * sc;
                *(GAS unsigned long long*)(ZBs + (size_t)row * ZN + n0) = (unsigned long long)pk2(v.x, v.y) | ((unsigned long long)pk2(v.z, v.w) << 32);
                if (pn == 8) *(GAS f32x4*)(outp + O_CKS + (size_t)row * 256 + cc) = v; else if (pn == 9) *(GAS f32x4*)(outp + O_SKS + (size_t)row * 256 + cc) = v;
                else if (pn == 10) *(GAS f32x4*)(outp + O_WKS + ((size_t)(row >> 2) * 512 + 508 + (row & 3)) * 256 + cc) = v;
                else if (pn == 11 && cc < 64) *(GAS f32x4*)(nar + (size_t)row * 64 + cc) = v; }); } } SEAM(2);
    if (IN(3)) { { cmp_post_sample(F, args); cmp_prompt(F, args); gla_a(F, args); make_vt(F, args); } REP2(3) { cmp_post_sample(F, args); cmp_prompt(F, args); gla_a(F, args); make_vt(F, args); } } SEAM(3);
    if (IN(4)) { { gla_scan(F, args); } REP2(4) { gla_scan(F, args); } } SEAM(4);
    if (IN(5)) { { nsa_prompt(F, args); gla_c(F, args); gla_sample(F, args); nsa_sample(F, args); } REP2(5) { nsa_prompt(F, args); gla_c(F, args); gla_sample(F, args); nsa_sample(F, args); } } SEAM(5);
    if (IN(6)) { { pg8::Gemm g{(const pg8::bf16_t*)(ws + WS_ATT), (const pg8::bf16_t*)(ws + WS_WT_O), RP, 1024, 1024}; pg8::StaticOrder S; S.init(RP, 1024, F.G, (int)blockIdx.x);
        pg8::EpiF32 E{(float*)(ws + WS_H1), 1024};
        pg8::gemm_phase<pg8::EpiF32, pg8::StaticOrder, true, true>(F.lds + RING_OFF, g, S, E);
        Frame Fm = launder(F); float* h1s = (float*)(ws + WS_H1) + (size_t)RP * 1024;
        mini_gemm_kq(Fm, (const bf16*)(ws + WS_ATT) + (size_t)RP * 1024, (const bf16*)(ws + WS_WT_O), 1024, h1s); } } SEAM(6);
    if (IN(7)) { { p_res_ln<0>(F, args, 0, R); } REP2(7) { p_res_ln<0>(F, args, 0, R); } } SEAM(7);
    if (IN(8)) { { pg8::Gemm g{(const pg8::bf16_t*)(ws + WS_U), (const pg8::bf16_t*)(ws + WS_WT_F1), RP, F1N, 1024}; pg8::StaticOrder S; S.init(RP, F1N, F.G, (int)blockIdx.x);
        pg8::EpiSwiglu E{(pg8::bf16_t*)(ws + WS_HM)};
        pg8::gemm_phase<pg8::EpiSwiglu, pg8::StaticOrder, true, true>(F.lds + RING_OFF, g, S, E);
        Frame Fm = launder(F); bf16* hms = (bf16*)(ws + WS_HM) + (size_t)RP * DFF;
        mini_gemm<2>(Fm, (const bf16*)(ws + WS_U) + (size_t)RP * 1024, (const bf16*)(ws + WS_WT_F1), 1024, DFF / 16, [](int u, int which) { const int j0 = 16 * u; return 256 * (j0 >> 7) + (j0 & 127) + 128 * which; },
            [&](int u, int row, int quad, const f32x4& g4, const f32x4& u4) { float o[4];
#pragma unroll
                for (int e = 0; e < 4; ++e) o[e] = g4[e] * __builtin_amdgcn_rcpf(1.0f + __builtin_amdgcn_exp2f(-1.4426950408889634f * g4[e])) * u4[e];
                *(GAS unsigned long long*)(hms + (size_t)row * DFF + 16 * u + 4 * quad) = (unsigned long long)pk2(o[0], o[1]) | ((unsigned long long)pk2(o[2], o[3]) << 32); }); } } SEAM(8);
    if (IN(9)) { { pg8::Gemm g{(const pg8::bf16_t*)(ws + WS_HM), (const pg8::bf16_t*)(ws + WS_WT_F2), RP, 1024, DFF}; pg8::StaticOrder S; S.init(RP, 1024, F.G, (int)blockIdx.x);
        pg8::EpiF32 E{(float*)(ws + WS_H1), 1024};
        pg8::gemm_phase<pg8::EpiF32, pg8::StaticOrder, true, true>(F.lds + RING_OFF, g, S, E);
        Frame Fm = launder(F); float* h1s = (float*)(ws + WS_H1) + (size_t)RP * 1024;
        mini_gemm_kq(Fm, (const bf16*)(ws + WS_HM) + (size_t)RP * DFF, (const bf16*)(ws + WS_WT_F2), DFF, h1s); } } SEAM(9);
    if (IN(10)) { { p_res_ln<1>(F, args, 0, R); } REP2(10) { p_res_ln<1>(F, args, 0, R); } }
#undef IN
#undef SEAM
}


#if defined(MK_EXTRA)
__global__ void __launch_bounds__(NTHR, 2) probe_k(Args args) {
    extern __shared__ __attribute__((aligned(16))) unsigned char lds[];
    Frame F; F.lds = (LAS unsigned char*)lds; F.tid = threadIdx.x; F.lane = F.tid & 63; F.wave = __builtin_amdgcn_readfirstlane(F.tid >> 6);
    F.G = gridDim.x; { const int bx = blockIdx.x; F.vcu = (F.G % 8 == 0) ? (bx % 8) * (F.G / 8) + bx / 8 : bx; }
    F.ctl = (gu32*)(args.ws + WS_CTL);
    if (MK_EXTRA == 11) nsa_prompt(F, args);
    if (MK_EXTRA == 12) gla_c(F, args);
    if (MK_EXTRA == 13) { gla_sample(F, args); nsa_sample(F, args); }
    if (MK_EXTRA == 14) cmp_post_sample(F, args);
    if (MK_EXTRA == 15) cmp_prompt(F, args);
    if (MK_EXTRA == 16) gla_a(F, args);
    if (MK_EXTRA == 17) make_vt(F, args);
    if (MK_EXTRA == 18) p0_prologue(F, args);
    if (MK_EXTRA == 19) p1_ln_mod(F, args);
    if (MK_EXTRA == 20) gla_scan(F, args);
    if (MK_EXTRA == 21) p_res_ln<0>(F, args, 0, R);
    if (MK_EXTRA == 22) p_res_ln<1>(F, args, 0, R);
}
#endif
__global__ void glue_z(const unsigned short* ZB, const float* narrow, float* Z) {
    const int r = blockIdx.x;
    for (int c = threadIdx.x; c < 2856; c += 256) { float v;
        if (c >= 1024 && c < 1040) v = narrow[(size_t)r * 64 + (c - 1024)];
        else if (c >= 2832) v = narrow[(size_t)r * 64 + 16 + (c - 2832)];
        else { const int pc = c < 1024 ? c : c - 16; v = __uint_as_float((unsigned)ZB[(size_t)r * ZN + pc] << 16); if (pc < 256 || (pc >= 1536 && pc < 2048)) v *= 8.f; }
        Z[(size_t)r * 2856 + c] = v; }
}
__global__ void glue_att(const float* ATT, unsigned short* ATTB) {
    const int r = RP + blockIdx.x; for (int c = 512 + threadIdx.x; c < 1024; c += 256) ATTB[(size_t)r * 1024 + c] = (unsigned short)f2bf(ATT[(size_t)r * 1024 + c]);
}
}
#ifndef MK_SPLIT
#define MK_SPLIT 0
#endif
static int g_grid = 0;
extern "C" void kernel_launch(void* const* d_in, const int* in_sizes, int n_in, void* d_out, int out_size, void* d_ws, size_t ws_size, hipStream_t stream) {
    (void)in_sizes; (void)n_in; (void)out_size; (void)ws_size;
    if (!g_grid) { int dev = 0, cus = 0; (void)hipGetDevice(&dev); (void)hipDeviceGetAttribute(&cus, hipDeviceAttributeMultiprocessorCount, dev);
        (void)hipFuncSetAttribute((const void*)fk::mega, hipFuncAttributeMaxDynamicSharedMemorySize, fk::LDS_BYTES); g_grid = cus > 0 ? cus : 256; }
    (void)hipMemsetAsync((char*)d_ws + fk::WS_CTL, 0, fk::CTL_ZERO_BYTES, stream);
    fk::Args a{}; for (int i = 0; i < 28; ++i) a.in[i] = d_in[i]; a.out = (float*)d_out; a.ws = (unsigned char*)d_ws;
#if MK_SPLIT
    for (int p = 0; p <= 10; ++p) { a.ph_lo = p; a.ph_hi = p + 1; a.li = 0; hipLaunchKernelGGL(fk::mega, dim3(g_grid), dim3(fk::NTHR), fk::LDS_BYTES, stream, a); }
#else
    a.ph_lo = 0; a.ph_hi = 11; a.li = 0; hipLaunchKernelGGL(fk::mega, dim3(g_grid), dim3(fk::NTHR), fk::LDS_BYTES, stream, a);
#endif
}
```
